# Optimizing an MI355X kernel written in HIP

```python
import jax, jax.numpy as jnp
from jax import lax
import numpy as np

D_MODEL = 1024
BATCH = 8
SEQ = 4096
DEPTH = 1

CTX_LEN = 256
GRID_W = 64
HEAD_DIM = 64
ATTN_HEADS = 8
ATTN_KV_HEADS = 2
ATTN_GROUP = ATTN_HEADS // ATTN_KV_HEADS
ATTN_WIDTH = ATTN_HEADS * HEAD_DIM
KV_WIDTH = ATTN_KV_HEADS * HEAD_DIM
MLP_HEADS = 8
MLP_WIDTH = MLP_HEADS * HEAD_DIM
MIX_WIDTH = ATTN_WIDTH + MLP_WIDTH
IN_WIDTH = 2 * KV_WIDTH + ATTN_WIDTH + 2 * MLP_WIDTH
WINDOW = 128
BLOCK = 128
CHUNK = 128
FFN_HIDDEN = -(-8 * D_MODEL // (3 * 256)) * 256
AXIS_DIM = HEAD_DIM // 2
ROPE_THETA = 10000.0
EPS = 1e-6
N_MOD = 6

kernel_name = "hymba_style_dit_window_gqa_chunk_gmlp"


def rmsnorm(x, gain):
    xf = x.astype(jnp.float32)
    y = xf * lax.rsqrt(jnp.mean(xf * xf, axis=-1, keepdims=True) + EPS)
    return (y * gain.astype(jnp.float32)).astype(x.dtype)


def adaln(cond, w_mod, b_mod):
    m = jax.nn.silu(cond) @ w_mod + b_mod
    return jnp.split(m[:, None, :], N_MOD, axis=-1)


def modulated_norm(h, gain, shift, scale):
    return rmsnorm(h, gain) * (1.0 + scale) + shift


def rope_tables(pos):
    inv_freq = ROPE_THETA ** (-jnp.arange(0, AXIS_DIM, 2, dtype=jnp.float32) / AXIS_DIM)
    ang = pos.astype(jnp.float32)[:, None] * inv_freq[None, :]
    return jnp.cos(ang), jnp.sin(ang)


def rotate(x, cos, sin):
    x1, x2 = jnp.split(x, 2, axis=-1)
    c = cos[:, None, :]
    s = sin[:, None, :]
    return jnp.concatenate([x1 * c - x2 * s, x1 * s + x2 * c], axis=-1)


def axial_rope(x, cos_r, sin_r, cos_c, sin_c):
    xr, xc = jnp.split(x, 2, axis=-1)
    out = jnp.concatenate([rotate(xr, cos_r, sin_r), rotate(xc, cos_c, sin_c)], axis=-1)
    return out.astype(x.dtype)


def sink_logits(sink, batch, n_q):
    s = sink.astype(jnp.float32).reshape(ATTN_KV_HEADS, ATTN_GROUP)[None, :, :, None, None]
    return jnp.broadcast_to(s, (batch, ATTN_KV_HEADS, ATTN_GROUP, n_q, 1))


def window_attention(q, k, v, k_ctx, v_ctx, sink):
    B, S = q.shape[0], q.shape[1]
    C = k_ctx.shape[1]
    nb = S // BLOCK
    scale = HEAD_DIM ** -0.5
    pad = ((0, 0), (BLOCK, BLOCK), (0, 0), (0, 0))
    kp = jnp.pad(k, pad)
    vp = jnp.pad(v, pad)
    sink_b = sink_logits(sink, B, BLOCK)

    def block(i):
        q_blk = lax.dynamic_slice_in_dim(q, i * BLOCK, BLOCK, axis=1)
        q_blk = q_blk.reshape(B, BLOCK, ATTN_KV_HEADS, ATTN_GROUP, HEAD_DIM)
        k_blk = lax.dynamic_slice_in_dim(kp, i * BLOCK, 3 * BLOCK, axis=1)
        v_blk = lax.dynamic_slice_in_dim(vp, i * BLOCK, 3 * BLOCK, axis=1)
        q_pos = i * BLOCK + jnp.arange(BLOCK)
        k_pos = (i - 1) * BLOCK + jnp.arange(3 * BLOCK)
        mask = (jnp.abs(q_pos[:, None] - k_pos[None, :]) <= WINDOW) & (k_pos >= 0)[None, :] & (k_pos < S)[None, :]
        s_loc = jnp.einsum('bqkgd,bskd->bkgqs', q_blk, k_blk, preferred_element_type=jnp.float32) * scale
        s_loc = jnp.where(mask[None, None, None], s_loc, -jnp.inf)
        s_ctx = jnp.einsum('bqkgd,bckd->bkgqc', q_blk, k_ctx, preferred_element_type=jnp.float32) * scale
        p = jax.nn.softmax(jnp.concatenate([s_loc, s_ctx, sink_b], axis=-1), axis=-1)
        p_loc = p[..., :3 * BLOCK]
        p_ctx = p[..., 3 * BLOCK:3 * BLOCK + C]
        o = (jnp.einsum('bkgqs,bskd->bqkgd', p_loc, v_blk.astype(jnp.float32))
             + jnp.einsum('bkgqc,bckd->bqkgd', p_ctx, v_ctx.astype(jnp.float32)))
        return o.reshape(B, BLOCK, ATTN_WIDTH).astype(q.dtype)

    out = lax.map(block, jnp.arange(nb))
    return jnp.transpose(out, (1, 0, 2, 3)).reshape(B, S, ATTN_WIDTH)


def context_attention(q, k, v, sink):
    B, C = q.shape[0], q.shape[1]
    qg = q.reshape(B, C, ATTN_KV_HEADS, ATTN_GROUP, HEAD_DIM)
    s = jnp.einsum('bqkgd,bskd->bkgqs', qg, k, preferred_element_type=jnp.float32) * HEAD_DIM ** -0.5
    p = jax.nn.softmax(jnp.concatenate([s, sink_logits(sink, B, C)], axis=-1), axis=-1)[..., :C]
    o = jnp.einsum('bkgqs,bskd->bqkgd', p, v.astype(jnp.float32))
    return o.reshape(B, C, ATTN_WIDTH).astype(q.dtype)


def chunk_spatial_gating(u, g, gate_gain, w_s, b_s):
    B, N = u.shape[0], u.shape[1]
    nc = N // CHUNK
    u = jax.nn.gelu(u)
    g = rmsnorm(jax.nn.gelu(g).reshape(B, N, MLP_HEADS, HEAD_DIM), gate_gain)
    gc = g.reshape(B, nc, CHUNK, MLP_HEADS, HEAD_DIM)
    mixed = jnp.einsum('hpq,bnqhd->bnphd', w_s, gc) + jnp.transpose(b_s)[None, None, :, :, None]
    return u * mixed.reshape(B, N, MLP_WIDTH)


def merge_groups(o_attn, o_mlp, attn_out_gain, mlp_out_gain, w_out):
    return jnp.concatenate([rmsnorm(o_attn, attn_out_gain), rmsnorm(o_mlp, mlp_out_gain)], axis=-1) @ w_out


def swiglu_ffn(h, shift, scale, gate, norm_gain, w_gate_up, w_down):
    hn = modulated_norm(h, norm_gain, shift, scale)
    a, b = jnp.split(hn @ w_gate_up, 2, axis=-1)
    return h + gate * ((jax.nn.silu(a) * b) @ w_down)


def setup_inputs(seed: int = 0) -> dict:
    key = jax.random.key(seed)
    ks = jax.random.split(key, 20)
    f32 = jnp.float32
    nrm = lambda k, shape, s: jax.random.normal(k, shape, f32) * s
    return {
        "x": nrm(ks[0], (BATCH, SEQ, D_MODEL), 1.0),
        "c": nrm(ks[1], (BATCH, D_MODEL), 1.0),
        "ctx": nrm(ks[2], (BATCH, CTX_LEN, D_MODEL), 1.0),
        "c_ctx": nrm(ks[3], (D_MODEL,), 1.0),
        "w_mod": nrm(ks[4], (DEPTH, D_MODEL, N_MOD * D_MODEL), 0.5 * D_MODEL ** -0.5),
        "b_mod": nrm(ks[5], (DEPTH, N_MOD * D_MODEL), 0.02),
        "norm_mix": 1.0 + nrm(ks[6], (DEPTH, D_MODEL), 0.02),
        "norm_ffn": 1.0 + nrm(ks[7], (DEPTH, D_MODEL), 0.02),
        "w_in": nrm(ks[8], (DEPTH, D_MODEL, IN_WIDTH), D_MODEL ** -0.5),
        "q_gain": 1.0 + nrm(ks[9], (DEPTH, HEAD_DIM), 0.02),
        "k_gain": 1.0 + nrm(ks[10], (DEPTH, HEAD_DIM), 0.02),
        "attn_sink": nrm(ks[11], (DEPTH, ATTN_HEADS), 0.5),
        "gate_gain": 1.0 + nrm(ks[12], (DEPTH, MLP_HEADS, HEAD_DIM), 0.02),
        "w_spatial": nrm(ks[13], (DEPTH, MLP_HEADS, CHUNK, CHUNK), CHUNK ** -0.5),
        "b_spatial": 1.0 + nrm(ks[14], (DEPTH, MLP_HEADS, CHUNK), 0.02),
        "attn_out_gain": 1.0 + nrm(ks[15], (DEPTH, ATTN_WIDTH), 0.02),
        "mlp_out_gain": 1.0 + nrm(ks[16], (DEPTH, MLP_WIDTH), 0.02),
        "w_out": nrm(ks[17], (DEPTH, MIX_WIDTH, D_MODEL), MIX_WIDTH ** -0.5),
        "w_gate_up": nrm(ks[18], (DEPTH, D_MODEL, 2 * FFN_HIDDEN), D_MODEL ** -0.5),
        "w_down": nrm(ks[19], (DEPTH, FFN_HIDDEN, D_MODEL), FFN_HIDDEN ** -0.5),
    }


def reference(x, c, ctx, c_ctx, w_mod, b_mod, norm_mix, norm_ffn, w_in, q_gain, k_gain,
              attn_sink, gate_gain, w_spatial, b_spatial, attn_out_gain, mlp_out_gain,
              w_out, w_gate_up, w_down):
    B, S = x.shape[0], x.shape[1]
    C = ctx.shape[1]
    rows = S // GRID_W
    row_id = jnp.repeat(jnp.arange(rows), GRID_W)
    col_id = jnp.tile(jnp.arange(GRID_W), rows)
    cos_r, sin_r = rope_tables(row_id)
    cos_c, sin_c = rope_tables(col_id)
    kv_cols = 2 * KV_WIDTH
    h_lat = x
    h_ctx = ctx
    for layer in range(DEPTH):
        sh_m, sc_m, gt_m, sh_f, sc_f, gt_f = adaln(c, w_mod[layer], b_mod[layer])
        csh_m, csc_m, cgt_m, csh_f, csc_f, cgt_f = adaln(c_ctx[None, :], w_mod[layer], b_mod[layer])

        hn_ctx = modulated_norm(h_ctx, norm_mix[layer], csh_m, csc_m)
        kc, vc = jnp.split(hn_ctx @ w_in[layer][:, :kv_cols], 2, axis=-1)
        kc = rmsnorm(kc.reshape(B, C, ATTN_KV_HEADS, HEAD_DIM), k_gain[layer])
        vc = vc.reshape(B, C, ATTN_KV_HEADS, HEAD_DIM)

        hn_lat = modulated_norm(h_lat, norm_mix[layer], sh_m, sc_m)
        kl, vl, ql, ul, gl = jnp.split(
            hn_lat @ w_in[layer],
            [KV_WIDTH, kv_cols, kv_cols + ATTN_WIDTH, kv_cols + ATTN_WIDTH + MLP_WIDTH], axis=-1)
        ql = axial_rope(rmsnorm(ql.reshape(B, S, ATTN_HEADS, HEAD_DIM), q_gain[layer]), cos_r, sin_r, cos_c, sin_c)
        kl = axial_rope(rmsnorm(kl.reshape(B, S, ATTN_KV_HEADS, HEAD_DIM), k_gain[layer]), cos_r, sin_r, cos_c, sin_c)
        vl = vl.reshape(B, S, ATTN_KV_HEADS, HEAD_DIM)

        attn_lat = window_attention(ql, kl, vl, kc, vc, attn_sink[layer])
        mlp_lat = chunk_spatial_gating(ul, gl, gate_gain[layer], w_spatial[layer], b_spatial[layer])
        h_lat = h_lat + gt_m * merge_groups(attn_lat, mlp_lat, attn_out_gain[layer], mlp_out_gain[layer], w_out[layer])
        h_lat = swiglu_ffn(h_lat, sh_f, sc_f, gt_f, norm_ffn[layer], w_gate_up[layer], w_down[layer])

        if layer + 1 < DEPTH:
            qc, uc, gcx = jnp.split(hn_ctx @ w_in[layer][:, kv_cols:], [ATTN_WIDTH, ATTN_WIDTH + MLP_WIDTH], axis=-1)
            qc = rmsnorm(qc.reshape(B, C, ATTN_HEADS, HEAD_DIM), q_gain[layer])
            attn_ctx = context_attention(qc, kc, vc, attn_sink[layer])
            mlp_ctx = chunk_spatial_gating(uc, gcx, gate_gain[layer], w_spatial[layer], b_spatial[layer])
            h_ctx = h_ctx + cgt_m * merge_groups(attn_ctx, mlp_ctx, attn_out_gain[layer], mlp_out_gain[layer], w_out[layer])
            h_ctx = swiglu_ffn(h_ctx, csh_f, csc_f, cgt_f, norm_ffn[layer], w_gate_up[layer], w_down[layer])
    return h_lat
```

```cpp
#include <hip/hip_runtime.h>
#include <cstdio>
#include <cstdint>
#include <cmath>
namespace pg8 {
#define PG8_LAS __attribute__((address_space(3)))
typedef unsigned short bf16_t;
typedef short bf16x8 __attribute__((ext_vector_type(8)));
typedef float f32x4 __attribute__((ext_vector_type(4)));
typedef unsigned u32x4 __attribute__((ext_vector_type(4)));
constexpr int BM = 256, BK = 64, HALF = 128, HTB = HALF * BK * 2  , STAGE_BYTES = 8 * HTB, NXCD = 8, WGM = 8;

__host__ __device__ __forceinline__ int lds_byte(int r, int c) { const int st = (r >> 4) * 2 + (c >> 5), rr = r & 15, cc = c & 31, ob = rr * 64 + cc * 2; return st * 1024 + (ob ^ (((ob >> 9) & 1) << 5)); }
__host__ __device__ __forceinline__ void stage_rc(int b, int& R, int& C) { const int st = b / 1024, sb = b % 1024, swz = sb ^ (((sb >> 9) & 1) << 5); R = (st >> 1) * 16 + swz / 64; C = (st & 1) * 32 + (swz % 64) / 2; }
__host__ __device__ __forceinline__ int perm32(int rho) { const int n = rho >> 4, i = rho & 15; return 8 * (i >> 2) + 4 * n + (i & 3); }

struct Unit { int pm, pn; };
struct Gemm { const bf16_t* A; const bf16_t* Bt; int M, N, K; };

struct StaticOrder {
    int nM, nN, nwg, G, c;
    __host__ __device__ void init(int M, int N, int G_, int c_) { nM = M / BM; nN = N / BM; nwg = nM * nN; G = G_; c = c_; }
    __host__ __device__ bool next(int i, Unit& u) const {
        const long L = (long)i * G + c; if (L >= nwg) return false;
        int wgid = (int)L; { const int q = nwg / NXCD, r = nwg % NXCD, xcd = wgid % NXCD, off = wgid / NXCD; wgid = (xcd < r ? xcd * (q + 1) : r * (q + 1) + (xcd - r) * q) + off; }
        const int nig = WGM * nN, gid = wgid / nig, fm = gid * WGM, gsz = (nM - fm) < WGM ? (nM - fm) : WGM;
        u.pm = fm + ((wgid % nig) % gsz); u.pn = (wgid % nig) / gsz; return true;
    }
    __device__ __forceinline__ void a_ready(const Unit&) const {}
    __device__ __forceinline__ void done(const Unit&) const {}
};
__device__ __forceinline__ unsigned cvt_pk_bf16(float lo, float hi) { unsigned r; asm volatile("v_cvt_pk_bf16_f32 %0, %1, %2" : "=v"(r) : "v"(lo), "v"(hi)); return r; }
typedef float f32x2 __attribute__((ext_vector_type(2)));
typedef unsigned u32x2 __attribute__((ext_vector_type(2)));
constexpr float C2Q = 0.125f * 1.4426950408889634f;
constexpr float RMS_EPS = 1e-6f;
__device__ __forceinline__ float gelu_tanh(float x) {
    const float z2 = x * (1.5957691216057308f + 0.07135481627244473f * x * x);
    const float e = __builtin_amdgcn_exp2f(-1.4426950408889634f * z2);
    return x * __builtin_amdgcn_rcpf(1.0f + e);
}
__device__ __forceinline__ float silu_f(float x) { return x * __builtin_amdgcn_rcpf(1.0f + __builtin_amdgcn_exp2f(-1.4426950408889634f * x)); }

struct EpiInProj {
    static constexpr bool PERM = true, AFTER_DRAIN = false;
    bf16_t* Y; bf16_t* Yc; const float* q_gain; const float* k_gain; const float* gate_gain; const float* rope;
    __device__ __forceinline__ void operator()(const f32x4 (&acc)[2][2][4][2], const Unit& u, int wr, int wc, int fr, int fq) const {
        const bool ctx = u.pm >= 128;
        const int head = __builtin_amdgcn_readfirstlane(4 * u.pn + wc);
        const int type = head < 2 ? 0 : head < 4 ? 1 : head < 12 ? 2 : head < 20 ? 3 : 4;
        bf16_t* base; int ld, rowb;
        if (ctx) { base = Yc; ld = 256; rowb = (u.pm - 128) * 256; } else { base = Y; ld = 1792; rowb = u.pm * 256; }
        const int colb = head * 64 + 8 * fq;
        f32x4 g[2][2];
#pragma unroll
        for (int bj = 0; bj < 2; ++bj)
#pragma unroll
            for (int n = 0; n < 2; ++n) {
                if (type == 0) g[bj][n] = *(const f32x4*)(k_gain + 32 * bj + 16 * n + 4 * fq);
                else if (type == 2) g[bj][n] = *(const f32x4*)(q_gain + 32 * bj + 16 * n + 4 * fq) * C2Q;
                else if (type == 4) g[bj][n] = *(const f32x4*)(gate_gain + (head - 20) * 64 + 32 * bj + 8 * fq + 4 * n);
                else g[bj][n] = (f32x4){1.f, 1.f, 1.f, 1.f};
            }
        const bool do_norm = (type == 0 || type == 2 || type == 4), do_rope = (type == 2) || (type == 0 && !ctx), do_gelu = type >= 3;
#pragma unroll
        for (int ai = 0; ai < 2; ++ai)
#pragma unroll
            for (int m = 0; m < 4; ++m) {
                const int row = rowb + ai * HALF + wr * 64 + m * 16 + fr;
                f32x4 v[2][2];
#pragma unroll
                for (int bj = 0; bj < 2; ++bj)
#pragma unroll
                    for (int n = 0; n < 2; ++n) v[bj][n] = acc[ai][bj][m][n];
                if (do_gelu) {
#pragma unroll
                    for (int bj = 0; bj < 2; ++bj)
#pragma unroll
                        for (int n = 0; n < 2; ++n)
#pragma unroll
                            for (int e = 0; e < 4; ++e) v[bj][n][e] = gelu_tanh(v[bj][n][e]);
                }
                if (do_norm) {
                    float ss = 0.f;
#pragma unroll
                    for (int bj = 0; bj < 2; ++bj)
#pragma unroll
                        for (int n = 0; n < 2; ++n) { const f32x4 t = v[bj][n]; ss += (t[0] * t[0] + t[1] * t[1]) + (t[2] * t[2] + t[3] * t[3]); }
                    ss += __shfl_xor(ss, 16); ss += __shfl_xor(ss, 32);
                    const float rstd = 1.0f / sqrtf(ss * (1.0f / 64.0f) + RMS_EPS);
#pragma unroll
                    for (int bj = 0; bj < 2; ++bj)
#pragma unroll
                        for (int n = 0; n < 2; ++n) v[bj][n] = v[bj][n] * rstd * g[bj][n];
                }
                if (do_rope) {
                    const int t = row & 4095;
#pragma unroll
                    for (int bj = 0; bj < 2; ++bj) {
                        const int pos = bj ? (t & 63) : (t >> 6);
                        const f32x4 cs0 = *(const f32x4*)(rope + (pos * 16 + 4 * fq) * 2), cs1 = *(const f32x4*)(rope + (pos * 16 + 4 * fq) * 2 + 4);
                        const float c[4] = {cs0[0], cs0[2], cs1[0], cs1[2]}, s[4] = {cs0[1], cs0[3], cs1[1], cs1[3]};
#pragma unroll
                        for (int e = 0; e < 4; ++e) { const float x1 = v[bj][0][e], x2 = v[bj][1][e]; v[bj][0][e] = x1 * c[e] - x2 * s[e]; v[bj][1][e] = x1 * s[e] + x2 * c[e]; }
                    }
                }
                bf16_t* rowp = base + (size_t)row * ld + colb;
#pragma unroll
                for (int bj = 0; bj < 2; ++bj) { u32x4 w; w.x = cvt_pk_bf16(v[bj][0][0], v[bj][0][1]); w.y = cvt_pk_bf16(v[bj][0][2], v[bj][0][3]); w.z = cvt_pk_bf16(v[bj][1][0], v[bj][1][1]); w.w = cvt_pk_bf16(v[bj][1][2], v[bj][1][3]);
                    *(u32x4*)(rowp + 32 * bj) = w; }
            }
    }
};

struct EpiOutProj {
    static constexpr bool PERM = false, AFTER_DRAIN = false;
    const float* x; float* out; bf16_t* A3; float* ssq3; const float* mod; const float* norm_ffn;
    __device__ __forceinline__ void operator()(const f32x4 (&acc)[2][2][4][2], const Unit& u, int wr, int wc, int fr, int fq) const {
        const int b = u.pm >> 4;
        const float* gt = mod + b * 6144 + 2 * 1024; const float* scf = mod + b * 6144 + 4 * 1024;
        const int col0 = u.pn * BM + wc * 32 + 4 * fq;
        f32x4 gtv[2][2], gfv[2][2];
#pragma unroll
        for (int bj = 0; bj < 2; ++bj)
#pragma unroll
            for (int n = 0; n < 2; ++n) { const int c = col0 + bj * HALF + n * 16; gtv[bj][n] = *(const f32x4*)(gt + c); gfv[bj][n] = *(const f32x4*)(norm_ffn + c) * (*(const f32x4*)(scf + c) + 1.0f); }
#pragma unroll
        for (int ai = 0; ai < 2; ++ai)
#pragma unroll
            for (int m = 0; m < 4; ++m) {
                const int row = u.pm * BM + ai * HALF + wr * 64 + m * 16 + fr; float ss = 0.f;
#pragma unroll
                for (int bj = 0; bj < 2; ++bj)
#pragma unroll
                    for (int n = 0; n < 2; ++n) { const size_t off = (size_t)row * 1024 + col0 + bj * HALF + n * 16;
                        const f32x4 h = *(const f32x4*)(x + off) + gtv[bj][n] * acc[ai][bj][m][n]; *(f32x4*)(out + off) = h;
                        ss += (h[0] * h[0] + h[1] * h[1]) + (h[2] * h[2] + h[3] * h[3]);
                        const f32x4 a = h * gfv[bj][n]; u32x2 w; w.x = cvt_pk_bf16(a[0], a[1]); w.y = cvt_pk_bf16(a[2], a[3]); *(u32x2*)(A3 + off) = w; }
                ss += __shfl_xor(ss, 16); ss += __shfl_xor(ss, 32);
                if (fq == 0) ssq3[(size_t)row * 16 + u.pn * 4 + wc] = ss;
            }
    }
};

struct EpiGateUp {
    static constexpr bool PERM = true, AFTER_DRAIN = false;
    bf16_t* H; const float* ssq3; const float* bias_t;
    __device__ __forceinline__ void operator()(const f32x4 (&acc)[2][2][4][2], const Unit& u, int wr, int wc, int fr, int fq) const {
        const int b = u.pm >> 4;
        const float* bp = bias_t + b * 5632 + u.pn * BM + wc * 32 + 8 * fq;
        f32x4 ba[2], bb[2];
#pragma unroll
        for (int n = 0; n < 2; ++n) { ba[n] = *(const f32x4*)(bp + 4 * n); bb[n] = *(const f32x4*)(bp + HALF + 4 * n); }
        const int hc0 = u.pn * HALF + wc * 32 + 8 * fq;
#pragma unroll
        for (int ai = 0; ai < 2; ++ai)
#pragma unroll
            for (int m = 0; m < 4; ++m) {
                const int row = u.pm * BM + ai * HALF + wr * 64 + m * 16 + fr;
                const f32x4* sp = (const f32x4*)(ssq3 + (size_t)row * 16);
                const f32x4 s0 = sp[0], s1 = sp[1], s2 = sp[2], s3 = sp[3];
                const float ss = (((s0[0] + s0[1]) + (s0[2] + s0[3])) + ((s1[0] + s1[1]) + (s1[2] + s1[3]))) + (((s2[0] + s2[1]) + (s2[2] + s2[3])) + ((s3[0] + s3[1]) + (s3[2] + s3[3])));
                const float rstd = 1.0f / sqrtf(ss * (1.0f / 1024.0f) + RMS_EPS);
                float hv[2][4];
#pragma unroll
                for (int n = 0; n < 2; ++n) { const f32x4 a = acc[ai][0][m][n] * rstd + ba[n], bq = acc[ai][1][m][n] * rstd + bb[n];
#pragma unroll
                    for (int e = 0; e < 4; ++e) hv[n][e] = silu_f(a[e]) * bq[e]; }
                u32x4 w; w.x = cvt_pk_bf16(hv[0][0], hv[0][1]); w.y = cvt_pk_bf16(hv[0][2], hv[0][3]); w.z = cvt_pk_bf16(hv[1][0], hv[1][1]); w.w = cvt_pk_bf16(hv[1][2], hv[1][3]);
                *(u32x4*)(H + (size_t)row * 2816 + hc0) = w;
            }
    }
};

struct EpiDown {
    static constexpr bool PERM = false, AFTER_DRAIN = false;
    float* out; const float* mod;
    __device__ __forceinline__ void operator()(const f32x4 (&acc)[2][2][4][2], const Unit& u, int wr, int wc, int fr, int fq) const {
        const int b = u.pm >> 4;
        const float* gt = mod + b * 6144 + 5 * 1024;
        const int col0 = u.pn * BM + wc * 32 + 4 * fq;
        f32x4 gtv[2][2];
#pragma unroll
        for (int bj = 0; bj < 2; ++bj)
#pragma unroll
            for (int n = 0; n < 2; ++n) gtv[bj][n] = *(const f32x4*)(gt + col0 + bj * HALF + n * 16);
#pragma unroll
        for (int ai = 0; ai < 2; ++ai)
#pragma unroll
            for (int m = 0; m < 4; ++m) {
                const int row = u.pm * BM + ai * HALF + wr * 64 + m * 16 + fr;
#pragma unroll
                for (int bj = 0; bj < 2; ++bj)
#pragma unroll
                    for (int n = 0; n < 2; ++n) { const size_t off = (size_t)row * 1024 + col0 + bj * HALF + n * 16;
                        *(f32x4*)(out + off) = *(const f32x4*)(out + off) + gtv[bj][n] * acc[ai][bj][m][n]; }
            }
    }
};

struct InProjOrder {
    StaticOrder so;
    __device__ __forceinline__ bool next(int i, Unit& u) const {
        const long L = (long)i * so.G + so.c;
        if (L < so.nwg) return so.next(i, u);
        const long r = L - so.nwg; if (r >= 8) return false;
        u.pm = 128 + (int)r; u.pn = 0; return true;
    }
    __device__ __forceinline__ void a_ready(const Unit&) const {}
    __device__ __forceinline__ void done(const Unit&) const {}
};
template <class Epi, class Sched, bool ALIGN_EPI = false, bool SP2 = false>
__device__ __forceinline__ void gemm_phase(PG8_LAS unsigned char* lds, const Gemm g, const Sched& S, const Epi& E) {
    const int tid = threadIdx.x, wid = __builtin_amdgcn_readfirstlane(tid >> 6), lane = tid & 63, wr = wid >> 2, wc = wid & 3, fr = lane & 15, fq = lane >> 4;
    const int K = g.K, nt = K / BK;
    unsigned voffA[2], voffB[2];
#pragma unroll
    for (int i = 0; i < 2; ++i) { int R, C; stage_rc(tid * 16 + i * 8192, R, C); const int Rb = Epi::PERM ? ((R & ~31) + perm32(R & 31)) : R;
        voffA[i] = (unsigned)(R * K + C) * 2u; voffB[i] = (unsigned)(Rb * K + C) * 2u; }
    const size_t kstep = (size_t)(BK * 2);
    const size_t hstep = (size_t)HALF * K * 2;
    const size_t tstep = 2 * hstep;
    const unsigned ldsw = (unsigned)wid * 1024u;
    const int aoff = lds_byte(wr * 64 + fr, fq * 8), boff = lds_byte(wc * 32 + fr, fq * 8);
#define PG8_SA(b, h) (((b) * 2 + (h)) * HTB)
#define PG8_SB(b, h) ((4 + (b) * 2 + (h)) * HTB)
#define PG8_STAGE(bufoff, gbase, voff) do { _Pragma("unroll") for (int _i = 0; _i < 2; ++_i) \
        __builtin_amdgcn_global_load_lds((const unsigned*)((const char*)(gbase) + (voff)[_i]), (PG8_LAS unsigned*)(lds + (bufoff) + ldsw + _i * 8192), 16, 0, 0); } while (0)
#define PG8_LDA(dst, b, h) do { _Pragma("unroll") for (int m = 0; m < 4; ++m) _Pragma("unroll") for (int k = 0; k < 2; ++k) dst[m][k] = *(const PG8_LAS bf16x8*)(lds + PG8_SA(b, h) + aoff + m * 2048 + k * 1024); } while (0)
#define PG8_LDB(dst, b, h) do { _Pragma("unroll") for (int n = 0; n < 2; ++n) _Pragma("unroll") for (int k = 0; k < 2; ++k) dst[n][k] = *(const PG8_LAS bf16x8*)(lds + PG8_SB(b, h) + boff + n * 2048 + k * 1024); } while (0)
#define PG8_MMA(ai, bj, At, Bt) do { __builtin_amdgcn_s_setprio(1); _Pragma("unroll") for (int m = 0; m < 4; ++m) _Pragma("unroll") for (int n = 0; n < 2; ++n) _Pragma("unroll") for (int k = 0; k < 2; ++k) \
        acc[ai][bj][m][n] = __builtin_amdgcn_mfma_f32_16x16x32_bf16(Bt[n][k], At[m][k], acc[ai][bj][m][n], 0, 0, 0); __builtin_amdgcn_s_setprio(0); } while (0)
#define PG8_WAIT_V(n) asm volatile("s_waitcnt vmcnt(" #n ")" ::: "memory")
#define PG8_WAIT_L(n) asm volatile("s_waitcnt lgkmcnt(" #n ")" ::: "memory")
#define PG8_BAR __builtin_amdgcn_s_barrier()
#define PG8_SCHED __builtin_amdgcn_sched_barrier(0)
    Unit cur, nxt; int ui = 0;
    if (!S.next(0, cur)) return;
    f32x4 acc[2][2][4][2];
#pragma unroll
    for (int a = 0; a < 2; ++a)
#pragma unroll
        for (int b = 0; b < 2; ++b)
#pragma unroll
            for (int m = 0; m < 4; ++m)
#pragma unroll
                for (int n = 0; n < 2; ++n) acc[a][b][m][n] = (f32x4){0.f, 0.f, 0.f, 0.f};
    bf16x8 At[4][2], B0[2][2], B1[2][2];
    const char* cA = (const char*)g.A + (size_t)cur.pm * tstep; const char* cB = (const char*)g.Bt + (size_t)cur.pn * tstep;
    S.a_ready(cur);
    if constexpr (SP2) {
        PG8_STAGE(PG8_SB(0, 0), cB, voffB); PG8_STAGE(PG8_SB(0, 1), cB + hstep, voffB); PG8_STAGE(PG8_SA(0, 0), cA, voffA); PG8_STAGE(PG8_SA(0, 1), cA + hstep, voffA);
        if (wr == 1) PG8_BAR;
        PG8_WAIT_V(2); PG8_BAR;
        PG8_STAGE(PG8_SB(1, 0), cB + kstep, voffB); PG8_STAGE(PG8_SA(1, 0), cA + kstep, voffA); PG8_STAGE(PG8_SB(1, 1), cB + hstep + kstep, voffB);
        PG8_WAIT_V(6); PG8_BAR;
    } else {
        PG8_STAGE(PG8_SB(0, 0), cB, voffB); PG8_STAGE(PG8_SA(0, 0), cA, voffA); PG8_STAGE(PG8_SB(0, 1), cB + hstep, voffB); PG8_STAGE(PG8_SA(0, 1), cA + hstep, voffA);
        if (wr == 1) PG8_BAR;
        PG8_WAIT_V(4); PG8_BAR;
        PG8_STAGE(PG8_SB(1, 0), cB + kstep, voffB); PG8_STAGE(PG8_SA(1, 0), cA + kstep, voffA); PG8_STAGE(PG8_SB(1, 1), cB + hstep + kstep, voffB);
        PG8_WAIT_V(6); PG8_BAR;
    }
    for (;;) {
        const bool has_next = S.next(ui + 1, nxt);
        const char* nA = has_next ? (const char*)g.A + (size_t)nxt.pm * tstep : cA; const char* nB = has_next ? (const char*)g.Bt + (size_t)nxt.pn * tstep : cB;
        for (int t = 0; t < nt; t += 2) {
            const bool last = (t == nt - 2);
            const char* a1 = cA + (size_t)(t + 1) * kstep;
            const char* a2 = last ? nA : cA + (size_t)(t + 2) * kstep; const char* b2 = last ? nB : cB + (size_t)(t + 2) * kstep;
            const char* a3 = a2 + kstep; const char* b3 = b2 + kstep;
            if (last && has_next) S.a_ready(nxt);
            if constexpr (SP2) {
            PG8_LDB(B0, 0, 0); PG8_LDB(B1, 0, 1); PG8_SCHED; PG8_LDA(At, 0, 0); PG8_STAGE(PG8_SA(1, 1), a1 + hstep, voffA);
            PG8_WAIT_V(8); PG8_WAIT_L(0); PG8_BAR; PG8_MMA(0, 0, At, B0); PG8_MMA(0, 1, At, B1); PG8_BAR; PG8_SCHED;
            PG8_LDA(At, 0, 1); PG8_STAGE(PG8_SB(0, 0), b2, voffB); PG8_STAGE(PG8_SB(0, 1), b2 + hstep, voffB); PG8_STAGE(PG8_SA(0, 0), a2, voffA);
            PG8_WAIT_V(8); PG8_WAIT_L(0); PG8_BAR; PG8_MMA(1, 0, At, B0); PG8_MMA(1, 1, At, B1); PG8_BAR; PG8_SCHED;
            PG8_LDB(B0, 1, 0); PG8_LDB(B1, 1, 1); PG8_SCHED; PG8_LDA(At, 1, 0); PG8_STAGE(PG8_SA(0, 1), a2 + hstep, voffA);
            PG8_WAIT_V(8); PG8_WAIT_L(0); PG8_BAR; PG8_MMA(0, 0, At, B0); PG8_MMA(0, 1, At, B1); PG8_BAR; PG8_SCHED;
            PG8_LDA(At, 1, 1); PG8_STAGE(PG8_SB(1, 0), b3, voffB); PG8_STAGE(PG8_SB(1, 1), b3 + hstep, voffB); PG8_STAGE(PG8_SA(1, 0), a3, voffA);
            PG8_WAIT_V(8); PG8_WAIT_L(0); PG8_BAR; PG8_MMA(1, 0, At, B0); PG8_MMA(1, 1, At, B1); PG8_BAR; PG8_SCHED;
            } else {
            PG8_LDB(B0, 0, 0); PG8_SCHED; PG8_LDA(At, 0, 0); PG8_STAGE(PG8_SA(1, 1), a1 + hstep, voffA);
            PG8_WAIT_L(8); PG8_BAR; PG8_WAIT_L(0); PG8_MMA(0, 0, At, B0); PG8_BAR; PG8_SCHED;
            PG8_LDB(B1, 0, 1); PG8_STAGE(PG8_SB(0, 0), b2, voffB);
            PG8_BAR; PG8_WAIT_L(0); PG8_MMA(0, 1, At, B1); PG8_BAR;
            PG8_LDA(At, 0, 1); PG8_STAGE(PG8_SA(0, 0), a2, voffA);
            PG8_BAR; PG8_WAIT_L(0); PG8_MMA(1, 0, At, B0); PG8_BAR; PG8_SCHED;
            PG8_STAGE(PG8_SB(0, 1), b2 + hstep, voffB);
            PG8_WAIT_V(6); PG8_BAR; PG8_MMA(1, 1, At, B1); PG8_BAR;
            PG8_LDB(B0, 1, 0); PG8_SCHED; PG8_LDA(At, 1, 0); PG8_STAGE(PG8_SA(0, 1), a2 + hstep, voffA);
            PG8_WAIT_L(8); PG8_BAR; PG8_WAIT_L(0); PG8_MMA(0, 0, At, B0); PG8_BAR; PG8_SCHED;
            PG8_LDB(B1, 1, 1); PG8_STAGE(PG8_SB(1, 0), b3, voffB);
            PG8_BAR; PG8_WAIT_L(0); PG8_MMA(0, 1, At, B1); PG8_BAR;
            PG8_LDA(At, 1, 1); PG8_STAGE(PG8_SA(1, 0), a3, voffA);
            PG8_BAR; PG8_WAIT_L(0); PG8_MMA(1, 0, At, B0); PG8_BAR; PG8_SCHED;
            PG8_STAGE(PG8_SB(1, 1), b3 + hstep, voffB);
            PG8_WAIT_V(6); PG8_BAR; PG8_MMA(1, 1, At, B1); PG8_BAR;
            }
        }
        if constexpr (ALIGN_EPI) { if (wr == 0) PG8_BAR; }
        if constexpr (!Epi::AFTER_DRAIN) { E(acc, cur, wr, wc, fr, fq); S.done(cur); }
        if (!has_next) break;
#pragma unroll
        for (int a = 0; a < 2; ++a)
#pragma unroll
            for (int b = 0; b < 2; ++b)
#pragma unroll
                for (int m = 0; m < 4; ++m)
#pragma unroll
                    for (int n = 0; n < 2; ++n) acc[a][b][m][n] = (f32x4){0.f, 0.f, 0.f, 0.f};
        cur = nxt; cA = nA; cB = nB; ++ui;
        if constexpr (ALIGN_EPI) { if (wr == 1) PG8_BAR; }
    }
    PG8_WAIT_V(0);
    if constexpr (!ALIGN_EPI) { if (wr == 0) PG8_BAR; }
    PG8_BAR;
    if constexpr (Epi::AFTER_DRAIN) { E.fused(acc, cur, wr, wc, fr, fq, lds, wid, lane); S.done(cur); }
#undef PG8_SA
#undef PG8_SB
#undef PG8_STAGE
#undef PG8_LDA
#undef PG8_LDB
#undef PG8_MMA
#undef PG8_WAIT_V
#undef PG8_WAIT_L
#undef PG8_BAR
#undef PG8_SCHED
}
}
constexpr int NWAVES = 8;
#ifndef MK_CUTS
#define MK_CUTS 0
#endif
constexpr int N_PHASES = 7;

constexpr int BATCH = 8, SEQ = 4096, DM = 1024, CTXL = 256;
constexpr int MROWS = BATCH * SEQ;
constexpr int CROWS = BATCH * CTXL;
constexpr int INW = 1792, FFH = 2816, NMOD = 6 * DM;
constexpr float LOG2E = 1.4426950408889634f;

constexpr size_t MiB = 1u << 20;
constexpr size_t WS_CTL = 0, CTL_ZERO_BYTES = 1 * MiB;
constexpr size_t WS_MOD = 1 * MiB;
constexpr size_t WS_ROPE = WS_MOD + 256 * 1024;
constexpr size_t WS_BIAS = WS_ROPE + 64 * 1024;
constexpr size_t WS_SSQ3 = 2 * MiB;
constexpr size_t WS_WIN = 4 * MiB, WS_WOUT = 8 * MiB, WS_WGU = 10 * MiB, WS_WDN = 21 * MiB;
constexpr size_t WS_XN = 32 * MiB;
constexpr size_t WS_Y = 100 * MiB;
constexpr size_t WS_YC = 212 * MiB;
constexpr size_t WS_H = 32 * MiB;
constexpr size_t WS_A2 = 216 * MiB;
constexpr size_t WS_A3 = 280 * MiB;
constexpr size_t WS_END = 344 * MiB;
static_assert(WS_BIAS + 8 * 5632 * 4 <= WS_SSQ3 && WS_WDN + (size_t)1024 * 2816 * 2 <= WS_XN && WS_XN + (size_t)34816 * 2048 <= WS_Y && WS_Y + (size_t)MROWS * INW * 2 <= WS_YC && WS_H + (size_t)MROWS * FFH * 2 <= WS_YC && WS_YC + (size_t)CROWS * 512 <= WS_A2, "d_ws map");
constexpr int CW_TMO = 0, CW_CODE = 1;
constexpr int CW_BAR = 4096;

constexpr int RING_OFF = 0, RING_BYTES = 131072;
constexpr int LDSCTL_OFF = RING_BYTES, MISC_OFF = LDSCTL_OFF + 320;
constexpr int LDS_BYTES = 147456;

#define GAS __attribute__((address_space(1)))
#define LAS __attribute__((address_space(3)))
typedef unsigned short bf16;
typedef unsigned v4u __attribute__((ext_vector_type(4)));
typedef float f32x4 __attribute__((ext_vector_type(4)));
typedef short bf16x8 __attribute__((ext_vector_type(8)));
typedef GAS unsigned gu32;
typedef GAS unsigned long long gu64;
#define RLX_AGENT __ATOMIC_RELAXED, __HIP_MEMORY_SCOPE_AGENT
#define LDS_WAIT() asm volatile("s_waitcnt lgkmcnt(0)" ::: "memory")
#define VM_WAIT() asm volatile("s_waitcnt vmcnt(0)" ::: "memory")
__device__ __forceinline__ unsigned long long rt() { return __builtin_amdgcn_s_memrealtime(); }
__device__ __forceinline__ unsigned f2bf(float f) { unsigned u = __builtin_bit_cast(unsigned, f); return (u + 0x7fffu + ((u >> 16) & 1u)) >> 16; }
__device__ __forceinline__ unsigned pk2(float lo, float hi) { return f2bf(lo) | (f2bf(hi) << 16); }
#define XB_TMO      128
#define XB_XCNT(j)  (256  + 64 * (j))
#define XB_XSUB(j)  (1280 + 64 * (j))
#define XB_XGEN(j)  (2304 + 64 * (j))
#define XB_TOP      3328
#define XB_TOPGEN   3392
#define XCD_BAR_WORDS 3456
#define XB_SPIN_CAP (1u << 22)

__device__ __forceinline__ unsigned xb_ld(unsigned* p)              { return __hip_atomic_load(p, __ATOMIC_RELAXED, __HIP_MEMORY_SCOPE_AGENT); }
__device__ __forceinline__ unsigned xb_add(unsigned* p, unsigned v) { return __hip_atomic_fetch_add(p, v, __ATOMIC_RELAXED, __HIP_MEMORY_SCOPE_AGENT); }
__device__ __forceinline__ unsigned xb_xcc_id() { return (unsigned)__builtin_amdgcn_s_getreg((3 << 11) | 20) & 0xFu; }
#define XB_SPIN(cond, bar) do { unsigned _sp = 0; while (cond) { __builtin_amdgcn_s_sleep(1); \
    if ((++_sp & 255u) == 0u) { if (xb_ld(&(bar)[XB_TMO])) break; if (_sp > XB_SPIN_CAP) { atomicAdd(&(bar)[XB_TMO], 1u); break; } } } } while (0)

struct XcdBarrier {
    unsigned* bar; unsigned x;
    volatile LAS unsigned* st;
};

__device__ __forceinline__ XcdBarrier xcd_barrier_post(unsigned* bar, volatile LAS unsigned* st) {
    XcdBarrier b; b.bar = bar; b.x = xb_xcc_id(); b.st = st;
    if (threadIdx.x == 0) (void)xb_add(&bar[XB_XCNT(b.x)], 1u);
    return b;
}
__device__ __forceinline__ void xcd_barrier_complete(unsigned* bar, unsigned x, unsigned& nloc, unsigned& nx) {
    const unsigned G = gridDim.x * gridDim.y * gridDim.z;
    unsigned sum, cnt, mine, sp = 0u;
    for (;;) {
        sum = 0u; cnt = 0u; mine = 0u;
#pragma unroll
        for (unsigned j = 0; j < 16; ++j) { const unsigned c = xb_ld(&bar[XB_XCNT(j)]); sum += c; cnt += (c > 0u) ? 1u : 0u; mine = (j == x) ? c : mine; }
        if (sum == G) break;
        __builtin_amdgcn_s_sleep(1);
        if ((++sp & 255u) == 0u) { if (xb_ld(&bar[XB_TMO])) break; if (sp > XB_SPIN_CAP) { atomicAdd(&bar[XB_TMO], 1u); break; } }
    }
    nloc = mine > 0u ? mine : 1u; nx = cnt > 0u ? cnt : 1u;
}

__device__ __forceinline__ void xcd_barrier(const XcdBarrier& b) {
    asm volatile("s_waitcnt vmcnt(0)" ::: "memory");
    __syncthreads();
    if (threadIdx.x == 0) {
        unsigned* bar = b.bar;
        __builtin_amdgcn_s_waitcnt(0);
        unsigned nloc = b.st[0], nx = b.st[1];
        if (nloc == 0u) { xcd_barrier_complete(bar, b.x, nloc, nx); b.st[0] = nloc; b.st[1] = nx; }
        const unsigned old = xb_add(&bar[XB_XSUB(b.x)], 1u);
        const unsigned gen = old / nloc;
        if (old + 1u == (gen + 1u) * nloc) {
            __builtin_amdgcn_fence(__ATOMIC_RELEASE, "agent");
            asm volatile("s_waitcnt vmcnt(0)" ::: "memory");
            const unsigned og = xb_add(&bar[XB_TOP], 1u);
            const unsigned tg = og / nx;
            if (og + 1u == (tg + 1u) * nx) xb_add(&bar[XB_TOPGEN], 1u);
            else XB_SPIN(xb_ld(&bar[XB_TOPGEN]) == tg, bar);
            __builtin_amdgcn_fence(__ATOMIC_ACQUIRE, "agent");
            xb_add(&bar[XB_XGEN(b.x)], 1u);
            asm volatile("s_waitcnt vmcnt(0)" ::: "memory");
        } else {
            XB_SPIN(xb_ld(&bar[XB_XGEN(b.x)]) == gen, bar);
            __builtin_amdgcn_fence(__ATOMIC_ACQUIRE, "agent");
            asm volatile("s_waitcnt vmcnt(0)" ::: "memory");
        }
    }
    __syncthreads();
}
struct Frame {
    LAS unsigned char* lds;
    volatile LAS unsigned* MISC;
    gu32* ctl;
    int tid, lane, wave;
    int vcu, G;
    const float *x, *c, *ctx, *c_ctx, *w_mod, *b_mod, *norm_mix, *norm_ffn, *w_in, *q_gain, *k_gain, *attn_sink, *gate_gain, *w_spatial, *b_spatial, *attn_out_gain, *mlp_out_gain, *w_out, *w_gate_up, *w_down;
    float* out;
    float *mod, *rope, *bias_t, *ssq3;
    bf16 *Win_t, *Wout_t, *Wgu_t, *Wdn_t, *XN, *Y, *Yc, *H, *A2, *A3;
};
__device__ __forceinline__ float bf2f(unsigned h) { return __builtin_bit_cast(float, h << 16); }
__device__ __forceinline__ float wave_sum(float v) {
#pragma unroll
    for (int o = 1; o < 64; o <<= 1) v += __shfl_xor(v, o);
    return v;
}
__device__ __forceinline__ float wave_max(float v) {
#pragma unroll
    for (int o = 1; o < 64; o <<= 1) v = fmaxf(v, __shfl_xor(v, o));
    return v;
}

__device__ __forceinline__ int dst_row(int mat, int n) {
    if (mat == 0) {
        const int head = n >> 6, d = n & 63, bj = d >> 5, l = d & 31;
        const bool rp = head < 2 || (head >= 4 && head < 12);
        const int p = rp ? (8 * ((l >> 2) & 3) + 4 * (l >> 4) + (l & 3)) : l;
        return 256 * (head >> 2) + 128 * bj + 32 * (head & 3) + p;
    }
    if (mat == 2) { const int bj = n >= FFH ? 1 : 0, j = n - FFH * bj; return 256 * (j >> 7) + 128 * bj + (j & 127); }
    return n;
}
__device__ __forceinline__ void p0_transpose_item(const float* W, int K, int N, bf16* WT, int mat, const float* g0, const float* g1, LAS float* scr, int item, int lane) {
    const int nblk = N / 32, kb = item / nblk, nb = item % nblk, k0 = 64 * kb, n0 = 32 * nb;
#pragma unroll 8
    for (int i = 0; i < 32; ++i) { const int kk = 2 * i + (lane >> 5); scr[kk * 33 + (lane & 31)] = W[(size_t)(k0 + kk) * N + n0 + (lane & 31)]; }
    LDS_WAIT(); asm volatile("" ::: "memory");
    const int c = lane & 7;
    float gk[8];
#pragma unroll
    for (int i = 0; i < 8; ++i) { const int k = k0 + 8 * c + i; gk[i] = (mat == 1) ? (k < 512 ? g0[k] : g1[k - 512]) : 1.0f; }
#pragma unroll
    for (int j = 0; j < 4; ++j) { const int n = (lane >> 3) + 8 * j; const LAS float* s = scr + (8 * c) * 33 + n;
        v4u o; o.x = pk2(s[0 * 33] * gk[0], s[1 * 33] * gk[1]); o.y = pk2(s[2 * 33] * gk[2], s[3 * 33] * gk[3]); o.z = pk2(s[4 * 33] * gk[4], s[5 * 33] * gk[5]); o.w = pk2(s[6 * 33] * gk[6], s[7 * 33] * gk[7]);
        *(GAS v4u*)(WT + (size_t)dst_row(mat, n0 + n) * K + k0 + 8 * c) = o; }
    LDS_WAIT(); asm volatile("" ::: "memory");
}
__device__ __forceinline__ void p0_prologue(Frame& F) {
    if (F.vcu < NMOD / 32) {
        LAS float* sc = (LAS float*)(F.lds);
        LAS float* red = (LAS float*)(F.lds + 36864);
        for (int i = F.tid; i < 9 * DM; i += NWAVES * 64) { const int n = i >> 10, k = i & 1023; const float v = n < 8 ? F.c[n * DM + k] : F.c_ctx[k]; sc[i] = v / (1.0f + __expf(-v)); }
        __syncthreads();
        for (int item = F.vcu; item < NMOD / 32; item += F.G) {
            const int col = item * 32 + (F.tid & 31), kg = F.tid >> 5;
            float a[9];
#pragma unroll
            for (int n = 0; n < 9; ++n) a[n] = 0.f;
#pragma unroll 8
            for (int k = kg; k < DM; k += 16) { const float w = F.w_mod[(size_t)k * NMOD + col];
#pragma unroll
                for (int n = 0; n < 9; ++n) a[n] += sc[n * DM + k] * w; }
#pragma unroll
            for (int n = 0; n < 9; ++n) red[(kg * 9 + n) * 32 + (F.tid & 31)] = a[n];
            __syncthreads();
            if (F.tid < 288) { const int n = F.tid >> 5, cc = F.tid & 31; float s = 0.f;
#pragma unroll
                for (int g = 0; g < 16; ++g) s += red[(g * 9 + n) * 32 + cc];
                F.mod[n * NMOD + item * 32 + cc] = s + F.b_mod[item * 32 + cc]; }
            __syncthreads();
        }
    }
    { const int gt = F.vcu * NWAVES * 64 + F.tid;
      if (gt < 1024) { const int pos = gt >> 4, f = gt & 15; const float inv = powf(10000.0f, -(float)(2 * f) / 32.0f); const float ang = (float)pos * inv; F.rope[2 * gt] = cosf(ang); F.rope[2 * gt + 1] = sinf(ang); } }
    __syncthreads();
    LAS float* scr = (LAS float*)(F.lds + RING_OFF + F.wave * 16384);
    const int gw = F.vcu * NWAVES + F.wave, NGW = F.G * NWAVES;
    constexpr int I_IN = (DM / 64) * (INW / 32), I_OUT = (DM / 64) * (DM / 32), I_GU = (DM / 64) * (2 * FFH / 32), I_DN = (FFH / 64) * (DM / 32);
    constexpr int NITEMS = I_IN + I_OUT + I_GU + I_DN;
    for (int it = gw; it < NITEMS; it += NGW) {
        int r = it;
        if (r < I_IN) { p0_transpose_item(F.w_in, DM, INW, F.Win_t, 0, nullptr, nullptr, scr, r, F.lane); continue; } r -= I_IN;
        if (r < I_OUT) { p0_transpose_item(F.w_out, DM, DM, F.Wout_t, 1, F.attn_out_gain, F.mlp_out_gain, scr, r, F.lane); continue; } r -= I_OUT;
        if (r < I_GU) { p0_transpose_item(F.w_gate_up, DM, 2 * FFH, F.Wgu_t, 2, nullptr, nullptr, scr, r, F.lane); continue; } r -= I_GU;
        p0_transpose_item(F.w_down, FFH, DM, F.Wdn_t, 3, nullptr, nullptr, scr, r, F.lane);
    }
}
__device__ __forceinline__ void p1_norm_rows(Frame& F) {
    const int gw = F.vcu * NWAVES + F.wave, NGW = F.G * NWAVES;
    for (int r = gw; r < MROWS + CROWS; r += NGW) {
        const float* src = r < MROWS ? F.x + (size_t)r * DM : F.ctx + (size_t)(r - MROWS) * DM;
        const float* md = F.mod + (r < MROWS ? (r >> 12) : 8) * NMOD;
        const GAS f32x4* xr = (const GAS f32x4*)src + F.lane;
        f32x4 v[4]; float s = 0.f;
#pragma unroll
        for (int j = 0; j < 4; ++j) { v[j] = xr[64 * j]; s += (v[j].x * v[j].x + v[j].y * v[j].y) + (v[j].z * v[j].z + v[j].w * v[j].w); }
        const float rstd = 1.0f / sqrtf(wave_sum(s) * (1.0f / DM) + 1e-6f);
        GAS unsigned long long* o8 = (GAS unsigned long long*)(F.XN + (size_t)r * DM) + F.lane;
#pragma unroll
        for (int j = 0; j < 4; ++j) { const int cidx = 4 * F.lane + 256 * j;
            const f32x4 g = *(const f32x4*)(F.norm_mix + cidx), sh = *(const f32x4*)(md + cidx), sc = *(const f32x4*)(md + DM + cidx);
            const f32x4 y = (v[j] * rstd) * g * (sc + 1.0f) + sh;
            o8[64 * j] = (unsigned long long)pk2(y.x, y.y) | ((unsigned long long)pk2(y.z, y.w) << 32); }
    }
    for (int R = gw; R < 2 * FFH; R += NGW) {
        const v4u w0 = *(const GAS v4u*)(F.Wgu_t + (size_t)R * DM + 16 * F.lane), w1 = *(const GAS v4u*)(F.Wgu_t + (size_t)R * DM + 16 * F.lane + 8);
        float wf[16];
#pragma unroll
        for (int i = 0; i < 4; ++i) { wf[2 * i] = bf2f(w0[i] & 0xffffu); wf[2 * i + 1] = bf2f(w0[i] >> 16); wf[8 + 2 * i] = bf2f(w1[i] & 0xffffu); wf[8 + 2 * i + 1] = bf2f(w1[i] >> 16); }
#pragma unroll
        for (int b = 0; b < BATCH; ++b) { const float* sh = F.mod + b * NMOD + 3 * DM + 16 * F.lane; float s = 0.f;
#pragma unroll
            for (int i = 0; i < 4; ++i) { const f32x4 t = *(const f32x4*)(sh + 4 * i); s += (t[0] * wf[4 * i] + t[1] * wf[4 * i + 1]) + (t[2] * wf[4 * i + 2] + t[3] * wf[4 * i + 3]); }
            s = wave_sum(s); if (F.lane == 0) F.bias_t[b * 2 * FFH + R] = s; }
    }
}

__device__ __forceinline__ void p3_mixer_naive(Frame& F) {
    LAS float* qs = (LAS float*)(F.lds) + F.wave * 64;
    LAS float* ps = (LAS float*)(F.lds + 2048) + F.wave * 576;
    LAS float* ssqs = (LAS float*)(F.lds + 20480);
    const int h = F.wave, kvh = h >> 2, lane = F.lane;
    for (int item = F.vcu; item < BATCH * 32; item += F.G) {
        const int b = item >> 5, blk = item & 31; const size_t row0 = (size_t)b * SEQ + blk * 128;
        const float sinkl = F.attn_sink[h] * LOG2E;
        for (int tl = 0; tl < 128; ++tl) {
            const int t = blk * 128 + tl; const size_t row = row0 + tl;
            qs[lane] = bf2f(F.Y[row * INW + 256 + 64 * h + lane]);
            LDS_WAIT(); asm volatile("" ::: "memory");
            float sc[9];
#pragma unroll
            for (int i = 0; i < 9; ++i) {
                const int idx = lane + 64 * i; const bf16* kp = nullptr;
                if (idx < 257) { const int j = t - 128 + idx; if (j >= 0 && j < SEQ) kp = F.Y + ((size_t)b * SEQ + j) * INW + 64 * kvh; }
                else if (idx < 513) kp = F.Yc + ((size_t)b * CTXL + (idx - 257)) * 256 + 64 * kvh;
                float s = -INFINITY;
                if (kp) { s = 0.f;
#pragma unroll
                    for (int d8 = 0; d8 < 8; ++d8) { const v4u kk = *(const GAS v4u*)(kp + 8 * d8);
#pragma unroll
                        for (int e = 0; e < 4; ++e) { s += qs[8 * d8 + 2 * e] * bf2f(kk[e] & 0xffffu); s += qs[8 * d8 + 2 * e + 1] * bf2f(kk[e] >> 16); } } }
                sc[i] = s;
            }
            float m = sc[0];
#pragma unroll
            for (int i = 1; i < 9; ++i) m = fmaxf(m, sc[i]);
            m = fmaxf(wave_max(m), sinkl);
            float ls = 0.f;
#pragma unroll
            for (int i = 0; i < 9; ++i) { const float p = exp2f(sc[i] - m); ls += p; ps[lane + 64 * i] = p; }
            const float l = wave_sum(ls) + exp2f(sinkl - m);
            LDS_WAIT(); asm volatile("" ::: "memory");
            float o = 0.f;
            for (int idx = 0; idx < 257; ++idx) { int j = t - 128 + idx; j = j < 0 ? 0 : (j >= SEQ ? SEQ - 1 : j);
                o += ps[idx] * bf2f(F.Y[((size_t)b * SEQ + j) * INW + 128 + 64 * kvh + lane]); }
            for (int cidx = 0; cidx < CTXL; ++cidx) o += ps[257 + cidx] * bf2f(F.Yc[((size_t)b * CTXL + cidx) * 256 + 128 + 64 * kvh + lane]);
            o = o / l;
            const float sq = wave_sum(o * o);
            if (lane == 0) ssqs[tl * 16 + h] = sq;
            F.A2[row * DM + 64 * h + lane] = (bf16)f2bf(o);
            LDS_WAIT(); asm volatile("" ::: "memory");
        }
        for (int p = 0; p < 128; ++p) {
            float mix = F.b_spatial[h * 128 + p];
            const float* wrow = F.w_spatial + ((size_t)h * 128 + p) * 128;
            for (int q = 0; q < 128; ++q) mix += wrow[q] * bf2f(F.Y[(row0 + q) * INW + 1280 + 64 * h + lane]);
            const float o = bf2f(F.Y[(row0 + p) * INW + 768 + 64 * h + lane]) * mix;
            const float sq = wave_sum(o * o);
            if (lane == 0) ssqs[p * 16 + 8 + h] = sq;
            F.A2[(row0 + p) * DM + 512 + 64 * h + lane] = (bf16)f2bf(o);
        }
        VM_WAIT(); LDS_WAIT(); __syncthreads();
        for (int ch = F.tid; ch < 128 * 128; ch += NWAVES * 64) {
            const int tl = ch >> 7, col = (ch & 127) * 8; const int hb = col < 512 ? 0 : 8; float s = 0.f;
#pragma unroll
            for (int hh = 0; hh < 8; ++hh) s += ssqs[tl * 16 + hb + hh];
            const float rstd = 1.0f / sqrtf(s * (1.0f / 512.0f) + 1e-6f);
            GAS v4u* p = (GAS v4u*)(F.A2 + (row0 + tl) * DM + col); const v4u w = *p; v4u o;
#pragma unroll
            for (int e = 0; e < 4; ++e) o[e] = pk2(bf2f(w[e] & 0xffffu) * rstd, bf2f(w[e] >> 16) * rstd);
            *p = o;
        }
        VM_WAIT(); __syncthreads();
    }
}

struct Args { const float* in[20]; float* out; unsigned char* ws; int ph_lo, ph_hi, li, pad; };
__global__ void __launch_bounds__(NWAVES * 64, 2) fwd_mega(Args args) {
    extern __shared__ __attribute__((aligned(16))) unsigned char lds[];
    Frame F;
    F.lds = (LAS unsigned char*)lds;
    F.MISC = (volatile LAS unsigned*)(F.lds + MISC_OFF);
    F.tid = threadIdx.x; F.lane = F.tid & 63; F.wave = __builtin_amdgcn_readfirstlane(F.tid >> 6);
    F.G = gridDim.x; { const int bx = blockIdx.x; F.vcu = (F.G % 8 == 0) ? (bx % 8) * (F.G / 8) + bx / 8 : bx; }
    unsigned char* ws = args.ws;
    F.ctl = (gu32*)(ws + WS_CTL);
    F.x = args.in[0]; F.c = args.in[1]; F.ctx = args.in[2]; F.c_ctx = args.in[3]; F.w_mod = args.in[4]; F.b_mod = args.in[5]; F.norm_mix = args.in[6]; F.norm_ffn = args.in[7];
    F.w_in = args.in[8]; F.q_gain = args.in[9]; F.k_gain = args.in[10]; F.attn_sink = args.in[11]; F.gate_gain = args.in[12]; F.w_spatial = args.in[13]; F.b_spatial = args.in[14];
    F.attn_out_gain = args.in[15]; F.mlp_out_gain = args.in[16]; F.w_out = args.in[17]; F.w_gate_up = args.in[18]; F.w_down = args.in[19]; F.out = args.out;
    F.mod = (float*)(ws + WS_MOD); F.rope = (float*)(ws + WS_ROPE); F.bias_t = (float*)(ws + WS_BIAS); F.ssq3 = (float*)(ws + WS_SSQ3);
    F.Win_t = (bf16*)(ws + WS_WIN); F.Wout_t = (bf16*)(ws + WS_WOUT); F.Wgu_t = (bf16*)(ws + WS_WGU); F.Wdn_t = (bf16*)(ws + WS_WDN);
    F.XN = (bf16*)(ws + WS_XN); F.Y = (bf16*)(ws + WS_Y); F.Yc = (bf16*)(ws + WS_YC); F.H = (bf16*)(ws + WS_H); F.A2 = (bf16*)(ws + WS_A2); F.A3 = (bf16*)(ws + WS_A3);
    for (int u = F.tid; u < (LDS_BYTES - LDSCTL_OFF) / 4; u += NWAVES * 64) ((LAS unsigned*)(F.lds + LDSCTL_OFF))[u] = 0u;
    __syncthreads();
    XcdBarrier bar = xcd_barrier_post((unsigned*)(F.ctl + CW_BAR) + args.li * XCD_BAR_WORDS, F.MISC + 8);
    const int lo = args.ph_lo, hi = args.ph_hi;
#define IN(k) (lo <= (k) && (k) < hi)
#define SEAM(k) do { if (IN(k) && IN((k) + 1)) xcd_barrier(bar); } while (0)

    if (IN(0)) { p0_prologue(F); SEAM(0); }
    if (IN(1)) { p1_norm_rows(F); SEAM(1); }
    if (IN(2)) {
        pg8::Gemm g{F.XN, F.Win_t, MROWS, INW, DM}; pg8::InProjOrder S; S.so.init(MROWS, INW, F.G, (int)blockIdx.x);
        pg8::EpiInProj E{F.Y, F.Yc, F.q_gain, F.k_gain, F.gate_gain, F.rope};
        pg8::gemm_phase<pg8::EpiInProj, pg8::InProjOrder, true, true>(F.lds + RING_OFF, g, S, E);
        SEAM(2);
    }
    if (IN(3)) { p3_mixer_naive(F); SEAM(3); }
    if (IN(4)) {
        pg8::Gemm g{F.A2, F.Wout_t, MROWS, DM, DM}; pg8::StaticOrder S; S.init(MROWS, DM, F.G, (int)blockIdx.x);
        pg8::EpiOutProj E{F.x, F.out, F.A3, F.ssq3, F.mod, F.norm_ffn};
        pg8::gemm_phase<pg8::EpiOutProj, pg8::StaticOrder, true, true>(F.lds + RING_OFF, g, S, E);
        SEAM(4);
    }
    if (IN(5)) {
        pg8::Gemm g{F.A3, F.Wgu_t, MROWS, 2 * FFH, DM}; pg8::StaticOrder S; S.init(MROWS, 2 * FFH, F.G, (int)blockIdx.x);
        pg8::EpiGateUp E{F.H, F.ssq3, F.bias_t};
        pg8::gemm_phase<pg8::EpiGateUp, pg8::StaticOrder, true, true>(F.lds + RING_OFF, g, S, E);
        SEAM(5);
    }
    if (IN(6)) {
        pg8::Gemm g{F.H, F.Wdn_t, MROWS, DM, FFH}; pg8::StaticOrder S; S.init(MROWS, DM, F.G, (int)blockIdx.x);
        pg8::EpiDown E{F.out, F.mod};
        pg8::gemm_phase<pg8::EpiDown, pg8::StaticOrder, true, true>(F.lds + RING_OFF, g, S, E);
    }
#undef IN
#undef SEAM
}

extern "C" void kernel_launch(void* const* d_in, const int* in_sizes, int n_in, void* d_out, int out_size, void* d_ws, size_t ws_size, hipStream_t stream) {
    static int grid = 0;
    if (grid == 0) {
        if (n_in != 20 || in_sizes[0] != MROWS * DM || out_size != MROWS * DM || ws_size < WS_END) { fprintf(stderr, "kernel_launch: unexpected shapes: n_in %d in0 %d out %d ws %zu\n", n_in, n_in > 0 ? in_sizes[0] : -1, out_size, ws_size); grid = -1; return; }
        int dev = 0, cus = 0, per_cu = 0;
        if (hipGetDevice(&dev) != hipSuccess || hipDeviceGetAttribute(&cus, hipDeviceAttributeMultiprocessorCount, dev) != hipSuccess) { grid = -1; return; }
        if (hipFuncSetAttribute((const void*)fwd_mega, hipFuncAttributeMaxDynamicSharedMemorySize, LDS_BYTES) != hipSuccess) { fprintf(stderr, "kernel_launch: hipFuncSetAttribute failed\n"); grid = -1; return; }
        if (hipOccupancyMaxActiveBlocksPerMultiprocessor(&per_cu, (const void*)fwd_mega, NWAVES * 64, LDS_BYTES) != hipSuccess || per_cu < 1) fprintf(stderr, "kernel_launch: occupancy query says %d\n", per_cu);
        (void)hipGetLastError();
        grid = cus - (cus % 8);
        if (grid < 8) grid = cus;
    }
    if (grid < 0) return;
    if (hipMemsetAsync((char*)d_ws + WS_CTL, 0, CTL_ZERO_BYTES, stream) != hipSuccess) return;
    Args a{};
    for (int i = 0; i < 20; ++i) a.in[i] = (const float*)d_in[i];
    a.out = (float*)d_out; a.ws = (unsigned char*)d_ws;
    int lo = 0, li = 0;
    for (int k = 0; k < N_PHASES; ++k) {
        const bool cut = (k == N_PHASES - 1) || ((MK_CUTS >> k) & 1);
        if (!cut) continue;
        a.ph_lo = lo; a.ph_hi = k + 1; a.li = li++;
        hipLaunchKernelGGL(fwd_mega, dim3(grid), dim3(NWAVES * 64), LDS_BYTES, stream, a);
        lo = k + 1;
    }
}
```

```cpp
#define MK_NA 15
#include <hip/hip_runtime.h>
#include <cstdio>
#include <cstdint>
#include <cmath>
namespace pg8 {
#define PG8_LAS __attribute__((address_space(3)))
typedef unsigned short bf16_t;
typedef short bf16x8 __attribute__((ext_vector_type(8)));
typedef float f32x4 __attribute__((ext_vector_type(4)));
typedef unsigned u32x4 __attribute__((ext_vector_type(4)));
constexpr int BM = 256, BK = 64, HALF = 128, HTB = HALF * BK * 2  , STAGE_BYTES = 8 * HTB, NXCD = 8, WGM = 4;

__host__ __device__ __forceinline__ int lds_byte(int r, int c) { const int st = (r >> 4) * 2 + (c >> 5), rr = r & 15, cc = c & 31, ob = rr * 64 + cc * 2; return st * 1024 + (ob ^ (((ob >> 9) & 1) << 5)); }
__host__ __device__ __forceinline__ void stage_rc(int b, int& R, int& C) { const int st = b / 1024, sb = b % 1024, swz = sb ^ (((sb >> 9) & 1) << 5); R = (st >> 1) * 16 + swz / 64; C = (st & 1) * 32 + (swz % 64) / 2; }
__host__ __device__ __forceinline__ int perm32(int rho) { const int n = rho >> 4, i = rho & 15; return 8 * (i >> 2) + 4 * n + (i & 3); }

__host__ __device__ __forceinline__ size_t tiled_off(int row, int col, int nt) { return (((size_t)(row >> 8) * nt + (col >> 6)) * 256 + (row & 255)) * 64 + (col & 63); }
struct Unit { int pm, pn; };
struct Gemm { const bf16_t* A; const bf16_t* Bt; int M, N, K; };

struct StaticOrder {
    int nM, nN, nwg, G, c;
    __host__ __device__ void init(int M, int N, int G_, int c_) { nM = M / BM; nN = N / BM; nwg = nM * nN; G = G_; c = c_; }
    __host__ __device__ bool next(int i, Unit& u) const {
        const long L = (long)i * G + c; if (L >= nwg) return false;
        int wgid = (int)L; { const int q = nwg / NXCD, r = nwg % NXCD, xcd = wgid % NXCD, off = wgid / NXCD; wgid = (xcd < r ? xcd * (q + 1) : r * (q + 1) + (xcd - r) * q) + off; }
        const int nig = WGM * nN, gid = wgid / nig, fm = gid * WGM, gsz = (nM - fm) < WGM ? (nM - fm) : WGM;
        u.pm = fm + ((wgid % nig) % gsz); u.pn = (wgid % nig) / gsz; return true;
    }
    __device__ __forceinline__ void a_ready(const Unit&, int) const {}
    __device__ __forceinline__ void a_poll(const Unit&) const {}
    __device__ __forceinline__ void done(const Unit&) const {}
};
typedef float cvt_f32x2_t __attribute__((ext_vector_type(2))); typedef __bf16 cvt_bf16x2_t __attribute__((ext_vector_type(2)));
__device__ __forceinline__ unsigned cvt_pk_bf16(float lo, float hi) { cvt_f32x2_t v = {lo, hi}; cvt_bf16x2_t b = __builtin_convertvector(v, cvt_bf16x2_t); return __builtin_bit_cast(unsigned, b); }
typedef float f32x2 __attribute__((ext_vector_type(2)));
typedef unsigned u32x2 __attribute__((ext_vector_type(2)));
constexpr float C2Q = 0.125f * 1.4426950408889634f;
constexpr float RMS_EPS = 1e-6f;
__device__ __forceinline__ float gelu_tanh(float x) {
    const float z2 = x * (1.5957691216057308f + 0.07135481627244473f * x * x);
    const float e = __builtin_amdgcn_exp2f(-1.4426950408889634f * z2);
    return x * __builtin_amdgcn_rcpf(1.0f + e);
}
__device__ __forceinline__ float silu_f(float x) { return x * __builtin_amdgcn_rcpf(1.0f + __builtin_amdgcn_exp2f(-1.4426950408889634f * x)); }

struct EpiInProj {
    static constexpr bool PERM = true, AFTER_DRAIN = false, MIDSCALE = false; static constexpr int A_AUX = 0;
    bf16_t* Y; bf16_t* Yc; bf16_t* KV; PG8_LAS const float* ropeL; PG8_LAS const float* gainL;
    __device__ __forceinline__ void operator()(const f32x4 (&acc)[2][2][4][2], const Unit& u, int wr, int wc, int fr, int fq, int) const {
        const bool ctx = u.pm >= 128;
        const int head = __builtin_amdgcn_readfirstlane(4 * u.pn + wc);
        const int type = head < 2 ? 0 : head < 4 ? 1 : head < 12 ? 2 : head < 20 ? 3 : 4;
        bf16_t* base; int ld, rowb;
        if (ctx) { base = Yc; ld = 256; rowb = (u.pm - 128) * 256; } else if (head < 4) { base = KV; ld = 256; rowb = u.pm * 256; }
        else { base = Y; ld = 1792; rowb = u.pm * 256; }
        const int colb = head * 64 + 8 * fq;
        f32x4 g[2][2];
#pragma unroll
        for (int bj = 0; bj < 2; ++bj)
#pragma unroll
            for (int n = 0; n < 2; ++n) {
                if (type == 0) g[bj][n] = *(PG8_LAS const f32x4*)(gainL + 64 + 32 * bj + 16 * n + 4 * fq);
                else if (type == 2) g[bj][n] = *(PG8_LAS const f32x4*)(gainL + 32 * bj + 16 * n + 4 * fq);
                else if (type == 4) g[bj][n] = *(PG8_LAS const f32x4*)(gainL + 128 + (head - 20) * 64 + 32 * bj + 8 * fq + 4 * n);
                else g[bj][n] = (f32x4){1.f, 1.f, 1.f, 1.f};
            }
        const bool do_norm = (type == 0 || type == 2 || type == 4), do_rope = (type == 2) || (type == 0 && !ctx), do_gelu = type >= 3;
#pragma unroll
        for (int ai = 0; ai < 2; ++ai)
#pragma unroll
            for (int m = 0; m < 4; ++m) {
                const int row = rowb + ai * HALF + wr * 64 + m * 16 + fr;
                f32x4 v[2][2];
#pragma unroll
                for (int bj = 0; bj < 2; ++bj)
#pragma unroll
                    for (int n = 0; n < 2; ++n) v[bj][n] = acc[ai][bj][m][n];
                if (do_gelu) {
#pragma unroll
                    for (int bj = 0; bj < 2; ++bj)
#pragma unroll
                        for (int n = 0; n < 2; ++n) { const f32x4 xx = v[bj][n]; const f32x4 t = xx * ((xx * xx) * (-1.4426950408889634f * 0.07135481627244473f) + (-1.4426950408889634f * 1.5957691216057308f)); f32x4 d;
#pragma unroll
                            for (int e = 0; e < 4; ++e) d[e] = __builtin_amdgcn_exp2f(t[e]);
                            d = d + 1.0f; f32x4 r;
#pragma unroll
                            for (int e = 0; e < 4; ++e) r[e] = __builtin_amdgcn_rcpf(d[e]);
                            v[bj][n] = xx * r; }
                }
                if (do_norm) {
                    float ss = 0.f;
#pragma unroll
                    for (int bj = 0; bj < 2; ++bj)
#pragma unroll
                        for (int n = 0; n < 2; ++n) { const f32x4 t = v[bj][n]; ss += (t[0] * t[0] + t[1] * t[1]) + (t[2] * t[2] + t[3] * t[3]); }
                    ss += __shfl_xor(ss, 16); ss += __shfl_xor(ss, 32);
                    const float rstd = __builtin_amdgcn_rsqf(ss * (1.0f / 64.0f) + RMS_EPS);
#pragma unroll
                    for (int bj = 0; bj < 2; ++bj)
#pragma unroll
                        for (int n = 0; n < 2; ++n) v[bj][n] = v[bj][n] * rstd * g[bj][n];
                }
                if (do_rope) {
                    const int t = row & 4095;
#pragma unroll
                    for (int bj = 0; bj < 2; ++bj) {
                        const int pos = bj ? (t & 63) : (t >> 6);
                        const f32x4 cs0 = *(PG8_LAS const f32x4*)(ropeL + (pos * 16 + 4 * fq) * 2), cs1 = *(PG8_LAS const f32x4*)(ropeL + (pos * 16 + 4 * fq) * 2 + 4);
                        const f32x4 c = {cs0[0], cs0[2], cs1[0], cs1[2]}, s = {cs0[1], cs0[3], cs1[1], cs1[3]};
                        const f32x4 x1 = v[bj][0], x2 = v[bj][1]; v[bj][0] = x1 * c - x2 * s; v[bj][1] = x1 * s + x2 * c;
                    }
                }
                bf16_t* rowp = base + (size_t)row * ld + colb;
#pragma unroll
                for (int bj = 0; bj < 2; ++bj) { u32x4 w; w.x = cvt_pk_bf16(v[bj][0][0], v[bj][0][1]); w.y = cvt_pk_bf16(v[bj][0][2], v[bj][0][3]); w.z = cvt_pk_bf16(v[bj][1][0], v[bj][1][1]); w.w = cvt_pk_bf16(v[bj][1][2], v[bj][1][3]);
                    *(u32x4*)(rowp + 32 * bj) = w; }
            }
    }
};

__device__ __forceinline__ f32x4 gf_eff(f32x4 g) {
#pragma unroll
    for (int e = 0; e < 4; ++e) g[e] = (__builtin_fabsf(g[e]) < 1e-30f) ? 1e-30f : g[e];
    return g; }
struct EpiOutProj {
    static constexpr bool PERM = true, AFTER_DRAIN = false, MIDSCALE = true; static constexpr int A_AUX = 0;
    const float* x; bf16_t* A3; float* ssq3; PG8_LAS const float* tab;
    __device__ __forceinline__ void midscale(f32x4 (&acc)[2][2][4][2], int wr, int fr, int ui) const {
        PG8_LAS const float* t = tab + (ui & 1) * 1024;
#pragma unroll
        for (int ai = 0; ai < 2; ++ai)
#pragma unroll
            for (int m = 0; m < 4; ++m) { const float f = t[ai * HALF + wr * 64 + m * 16 + fr];
#pragma unroll
                for (int bj = 0; bj < 2; ++bj)
#pragma unroll
                    for (int n = 0; n < 2; ++n) acc[ai][bj][m][n] = acc[ai][bj][m][n] * f; }
    }
    __device__ __forceinline__ void operator()(const f32x4 (&acc)[2][2][4][2], const Unit& u, int wr, int wc, int fr, int fq, int ui) const {
        PG8_LAS const float* t = tab + (ui & 1) * 1024;
        const int col0 = u.pn * BM + wc * 32 + 8 * fq, cl0 = wc * 32 + 8 * fq;
#pragma unroll
        for (int ai = 0; ai < 2; ++ai) {
            f32x4 xv[4][2][2];
#pragma unroll
            for (int m = 0; m < 4; ++m)
#pragma unroll
                for (int bj = 0; bj < 2; ++bj)
#pragma unroll
                    for (int n = 0; n < 2; ++n) xv[m][bj][n] = *(const f32x4*)(x + (size_t)(u.pm * BM + ai * HALF + wr * 64 + m * 16 + fr) * 1024 + col0 + bj * HALF + n * 4);
#pragma unroll
            for (int m = 0; m < 4; ++m) {
                const int rl = ai * HALF + wr * 64 + m * 16 + fr, row = u.pm * BM + rl; float ss = 0.f; const float f2 = t[256 + rl];
#pragma unroll
                for (int bj = 0; bj < 2; ++bj) { u32x4 w;
#pragma unroll
                    for (int n = 0; n < 2; ++n) {
                        const f32x4 gtv = *(PG8_LAS const f32x4*)(t + 512 + cl0 + bj * HALF + n * 4), gfv = *(PG8_LAS const f32x4*)(t + 768 + cl0 + bj * HALF + n * 4);
                        const f32x4 h = xv[m][bj][n] + gtv * (acc[ai][bj][m][n] * f2);
                        ss += (h[0] * h[0] + h[1] * h[1]) + (h[2] * h[2] + h[3] * h[3]);
                        const f32x4 a = h * gfv; if (n == 0) { w.x = cvt_pk_bf16(a[0], a[1]); w.y = cvt_pk_bf16(a[2], a[3]); } else { w.z = cvt_pk_bf16(a[0], a[1]); w.w = cvt_pk_bf16(a[2], a[3]); } }
                    *(u32x4*)(A3 + tiled_off(row, col0 + bj * HALF, 16)) = w; }
                ss += __shfl_xor(ss, 16); ss += __shfl_xor(ss, 32);
                if (fq == 0) ssq3[(size_t)row * 16 + u.pn * 4 + wc] = ss;
            }
        }
    }
};
struct OutProjOrder : StaticOrder {
    const float* ssq2; const float* mod; const float* norm_ffn; PG8_LAS float* tab;
    __device__ __forceinline__ void a_ready(const Unit& u, int ui) const {
        int tid = threadIdx.x; asm volatile("" : "+v"(tid));
        PG8_LAS float* t = tab + (ui & 1) * 1024;
        const int r = tid >> 1, hf = tid & 1;
        const f32x4* sp = (const f32x4*)(ssq2 + ((size_t)u.pm * BM + r) * 16 + hf * 8);
        const f32x4 s0 = sp[0], s1 = sp[1];
        const float ss = ((s0[0] + s0[1]) + (s0[2] + s0[3])) + ((s1[0] + s1[1]) + (s1[2] + s1[3]));
        const float rs = 1.0f / sqrtf(ss * (1.0f / 512.0f) + RMS_EPS);
        const float ro = __shfl_xor(rs, 1);
        if (hf == 0) { t[r] = rs / ro; t[256 + r] = ro; }
        if (tid < 256) { const int b = u.pm >> 4, c = u.pn * BM + tid; t[512 + tid] = mod[b * 6144 + 2 * 1024 + c];
            const float g = norm_ffn[c] * (mod[b * 6144 + 4 * 1024 + c] + 1.0f); t[768 + tid] = (__builtin_fabsf(g) < 1e-30f) ? 1e-30f : g; }
    }
};

struct EpiGateUp {
    static constexpr bool PERM = true, AFTER_DRAIN = false, MIDSCALE = false; static constexpr int A_AUX = 0;
    bf16_t* H; PG8_LAS const float* tab;
    __device__ __forceinline__ void operator()(const f32x4 (&acc)[2][2][4][2], const Unit& u, int wr, int wc, int fr, int fq, int ui) const {
        PG8_LAS const float* t = tab + (ui & 1) * 512;
        f32x4 ba[2], bb[2];
#pragma unroll
        for (int n = 0; n < 2; ++n) { ba[n] = *(PG8_LAS const f32x4*)(t + 256 + wc * 32 + 8 * fq + 4 * n); bb[n] = *(PG8_LAS const f32x4*)(t + 256 + HALF + wc * 32 + 8 * fq + 4 * n); }
        const int hc0 = u.pn * HALF + wc * 32 + 8 * fq;
#pragma unroll
        for (int ai = 0; ai < 2; ++ai)
#pragma unroll
            for (int m = 0; m < 4; ++m) {
                const int rl = ai * HALF + wr * 64 + m * 16 + fr;
                const float rstd = t[rl];
                f32x4 hv[2];
#pragma unroll
                for (int n = 0; n < 2; ++n) { const f32x4 a = acc[ai][0][m][n] * rstd + ba[n], bq = acc[ai][1][m][n] * rstd + bb[n];
                    const f32x4 t = a * (-1.4426950408889634f); f32x4 d;
#pragma unroll
                    for (int e = 0; e < 4; ++e) d[e] = __builtin_amdgcn_exp2f(t[e]);
                    d = d + 1.0f; f32x4 r;
#pragma unroll
                    for (int e = 0; e < 4; ++e) r[e] = __builtin_amdgcn_rcpf(d[e]);
                    hv[n] = (a * bq) * r; }
                u32x4 w; w.x = cvt_pk_bf16(hv[0][0], hv[0][1]); w.y = cvt_pk_bf16(hv[0][2], hv[0][3]); w.z = cvt_pk_bf16(hv[1][0], hv[1][1]); w.w = cvt_pk_bf16(hv[1][2], hv[1][3]);

#ifdef MK_NT_H
                __builtin_nontemporal_store(w, (u32x4*)(H + tiled_off(u.pm * BM + rl, hc0, 44)));
#else
                *(u32x4*)(H + tiled_off(u.pm * BM + rl, hc0, 44)) = w;
#endif

            }
    }
};
__device__ __forceinline__ void pg8_glds16(const void* gsrc, unsigned lds_dst) { unsigned keep;
    asm volatile("s_mov_b32 %0, m0\n\ts_mov_b32 m0, %2\n\ts_nop 0\n\tglobal_load_lds_dwordx4 %1, off\n\ts_mov_b32 m0, %0" : "=&s"(keep) : "v"(gsrc), "s"(lds_dst) : "memory"); }
struct GateUpOrder : StaticOrder {
    const float* rstd3; const float* bias_t; PG8_LAS float* tab;
    __device__ __forceinline__ void a_ready(const Unit& u, int ui) const {
        if (__builtin_amdgcn_readfirstlane((int)threadIdx.x) < 64) {
            int lane = threadIdx.x; asm volatile("" : "+v"(lane));
            const unsigned dst = (unsigned)(uintptr_t)(tab + (ui & 1) * 512);
            pg8_glds16(rstd3 + (size_t)u.pm * BM + 4 * lane, (unsigned)__builtin_amdgcn_readfirstlane(dst));
            pg8_glds16(bias_t + (u.pm >> 4) * 5632 + u.pn * BM + 4 * lane, (unsigned)__builtin_amdgcn_readfirstlane(dst + 1024));
        }
    }
};

#ifndef MK_DOWN_AAUX
#define MK_DOWN_AAUX 0
#endif
struct EpiDown {
    static constexpr bool PERM = true, AFTER_DRAIN = false, MIDSCALE = false; static constexpr int A_AUX = MK_DOWN_AAUX;
    const bf16_t* A3; float* out; PG8_LAS const float* tab;
    __device__ __forceinline__ void operator()(const f32x4 (&acc)[2][2][4][2], const Unit& u, int wr, int wc, int fr, int fq, int ui) const {
        PG8_LAS const float* t = tab + (ui & 1) * 512;
        const int col0 = u.pn * BM + wc * 32 + 8 * fq, cl0 = wc * 32 + 8 * fq;
#pragma unroll
        for (int ai = 0; ai < 2; ++ai) {
            u32x4 hv[4][2];
#pragma unroll
            for (int m = 0; m < 4; ++m)
#pragma unroll
                for (int bj = 0; bj < 2; ++bj) hv[m][bj] = *(const u32x4*)(A3 + tiled_off(u.pm * BM + ai * HALF + wr * 64 + m * 16 + fr, col0 + bj * HALF, 16));
#pragma unroll
            for (int m = 0; m < 4; ++m) {
                const int row = u.pm * BM + ai * HALF + wr * 64 + m * 16 + fr;
#pragma unroll
                for (int bj = 0; bj < 2; ++bj)
#pragma unroll
                    for (int n = 0; n < 2; ++n) { const size_t off = (size_t)row * 1024 + col0 + bj * HALF + n * 4; const unsigned w0 = n ? hv[m][bj].z : hv[m][bj].x, w1 = n ? hv[m][bj].w : hv[m][bj].y;
                        const f32x4 gtv = *(PG8_LAS const f32x4*)(t + cl0 + bj * HALF + n * 4), giv = *(PG8_LAS const f32x4*)(t + 256 + cl0 + bj * HALF + n * 4);
                        const f32x4 h1 = (f32x4){__builtin_bit_cast(float, w0 << 16), __builtin_bit_cast(float, w0 & 0xffff0000u), __builtin_bit_cast(float, w1 << 16), __builtin_bit_cast(float, w1 & 0xffff0000u)} * giv;
                        { const f32x4 ov = h1 + gtv * acc[ai][bj][m][n];
#ifdef MK_NT_OUT
                        __builtin_nontemporal_store(ov, (f32x4*)(out + off));
#else
                        *(f32x4*)(out + off) = ov;
#endif
                        } }
            }
        }
    }
};
struct DownOrder : StaticOrder {
    const float* mod; const float* norm_ffn; PG8_LAS float* tab;
    __device__ __forceinline__ bool next(int i, Unit& u) const { const int nc = c < nwg ? (nwg - 1 - c) / G + 1 : 0; if (i >= nc) return false; return StaticOrder::next(nc - 1 - i, u); }
    __device__ __forceinline__ void a_ready(const Unit& u, int ui) const {
        int tid = threadIdx.x; asm volatile("" : "+v"(tid));
        PG8_LAS float* t = tab + (ui & 1) * 512;
        if (tid < 256) { const int b = u.pm >> 4, c = u.pn * BM + tid; t[tid] = mod[b * 6144 + 5 * 1024 + c];
            const float g = norm_ffn[c] * (mod[b * 6144 + 4 * 1024 + c] + 1.0f); t[256 + tid] = 1.0f / ((__builtin_fabsf(g) < 1e-30f) ? 1e-30f : g); }
    }
};

__device__ __forceinline__ void pg8_glds4_sc1(const void* gsrc, unsigned lds_dst) { unsigned keep;
    asm volatile("s_mov_b32 %0, m0\n\ts_mov_b32 m0, %2\n\ts_nop 0\n\tglobal_load_lds_dword %1, off sc1\n\ts_mov_b32 m0, %0" : "=&s"(keep) : "v"(gsrc), "s"(lds_dst) : "memory"); }
struct InProjOrder {
    StaticOrder so;
    const unsigned* cnt; PG8_LAS unsigned* flagp; int na; unsigned nb;
    __device__ __forceinline__ bool next(int i, Unit& u) const {
        const long L = (long)i * so.G + so.c;
        if (L < so.nwg) return so.next(i, u);
        const long r = L - so.nwg; if (r >= 8) return false;
        u.pm = 128 + (int)r; u.pn = 0; return true;
    }
    __device__ __forceinline__ int stage_of(const Unit& u) const { return (u.pm < 128 && (u.pm & 15) < na) ? 0 : 1; }
    __device__ __forceinline__ void spin(const Unit& u) const {
        const int st = stage_of(u); const unsigned* p = cnt + st; const unsigned want = st ? nb : 256u;
        for (unsigned sp = 0; __hip_atomic_load(p, __ATOMIC_RELAXED, __HIP_MEMORY_SCOPE_AGENT) < want && sp < (1u << 22); ++sp) __builtin_amdgcn_s_sleep(1);
    }
    __device__ __forceinline__ void a_poll(const Unit& u) const {
        if (cnt == nullptr) return;
        if (__builtin_amdgcn_readfirstlane((int)threadIdx.x) < 64) { int lane = threadIdx.x; asm volatile("" : "+v"(lane));
            if (lane == 0) pg8_glds4_sc1(cnt + stage_of(u), (unsigned)__builtin_amdgcn_readfirstlane((unsigned)(uintptr_t)flagp)); }
    }
    __device__ __forceinline__ void a_ready(const Unit& u, int ui) const {
        if (cnt == nullptr) return;
        if (ui == 0) { spin(u); return; }
        const unsigned seen = *(volatile PG8_LAS const unsigned*)flagp;
        if ((unsigned)__builtin_amdgcn_readfirstlane(seen) < (stage_of(u) ? nb : 256u)) spin(u);
    }
    __device__ __forceinline__ void done(const Unit&) const {}
};
template <class Epi, class Sched, bool ALIGN_EPI = false, bool SP2 = false>
__device__ __forceinline__ void gemm_phase(PG8_LAS unsigned char* lds, const Gemm g, const Sched& S, const Epi& E) {
    const int tid = threadIdx.x, wid = __builtin_amdgcn_readfirstlane(tid >> 6), lane = tid & 63, wr = wid >> 2, wc = wid & 3, fr = lane & 15, fq = lane >> 4;
    const int K = g.K, nt = K / BK;
    unsigned voffA[2], voffB[2];
#pragma unroll
    for (int i = 0; i < 2; ++i) { int R, C; stage_rc(tid * 16 + i * 8192, R, C); const int Rb = Epi::PERM ? ((R & ~31) + perm32(R & 31)) : R;
        voffA[i] = (unsigned)(R * BK + C) * 2u; voffB[i] = (unsigned)(Rb * BK + C) * 2u; }
    const size_t kstep = (size_t)(BM * BK * 2);
    const size_t hstep = (size_t)HALF * BK * 2;
    const size_t tstep = (size_t)BM * K * 2;
    const unsigned ldsw = (unsigned)wid * 1024u;
    const int aoff = lds_byte(wr * 64 + fr, fq * 8), boff = lds_byte(wc * 32 + fr, fq * 8);
#define PG8_SA(b, h) (((b) * 2 + (h)) * HTB)
#define PG8_SB(b, h) ((4 + (b) * 2 + (h)) * HTB)
#define PG8_STAGE(bufoff, gbase, voff) do { _Pragma("unroll") for (int _i = 0; _i < 2; ++_i) \
        __builtin_amdgcn_global_load_lds((const unsigned*)((const char*)(gbase) + (voff)[_i]), (PG8_LAS unsigned*)(lds + (bufoff) + ldsw + _i * 8192), 16, 0, 0); } while (0)
#define PG8_STAGE_A(bufoff, gbase, voff) do { _Pragma("unroll") for (int _i = 0; _i < 2; ++_i) \
        __builtin_amdgcn_global_load_lds((const unsigned*)((const char*)(gbase) + (voff)[_i]), (PG8_LAS unsigned*)(lds + (bufoff) + ldsw + _i * 8192), 16, 0, Epi::A_AUX); } while (0)
#define PG8_LDA(dst, b, h) do { _Pragma("unroll") for (int m = 0; m < 4; ++m) _Pragma("unroll") for (int k = 0; k < 2; ++k) dst[m][k] = *(const PG8_LAS bf16x8*)(lds + PG8_SA(b, h) + aoff + m * 2048 + k * 1024); } while (0)
#define PG8_LDB(dst, b, h) do { _Pragma("unroll") for (int n = 0; n < 2; ++n) _Pragma("unroll") for (int k = 0; k < 2; ++k) dst[n][k] = *(const PG8_LAS bf16x8*)(lds + PG8_SB(b, h) + boff + n * 2048 + k * 1024); } while (0)
#define PG8_MMA(ai, bj, At, Bt) do { __builtin_amdgcn_s_setprio(1); _Pragma("unroll") for (int m = 0; m < 4; ++m) _Pragma("unroll") for (int n = 0; n < 2; ++n) _Pragma("unroll") for (int k = 0; k < 2; ++k) \
        acc[ai][bj][m][n] = __builtin_amdgcn_mfma_f32_16x16x32_bf16(Bt[n][k], At[m][k], acc[ai][bj][m][n], 0, 0, 0); __builtin_amdgcn_s_setprio(0); } while (0)
#define PG8_WAIT_V(n) asm volatile("s_waitcnt vmcnt(" #n ")" ::: "memory")
#define PG8_WAIT_L(n) asm volatile("s_waitcnt lgkmcnt(" #n ")" ::: "memory")
#define PG8_BAR __builtin_amdgcn_s_barrier()
#define PG8_SCHED __builtin_amdgcn_sched_barrier(0)
    Unit cur, nxt; int ui = 0;
    if (!S.next(0, cur)) return;
    f32x4 acc[2][2][4][2];
#pragma unroll
    for (int a = 0; a < 2; ++a)
#pragma unroll
        for (int b = 0; b < 2; ++b)
#pragma unroll
            for (int m = 0; m < 4; ++m)
#pragma unroll
                for (int n = 0; n < 2; ++n) acc[a][b][m][n] = (f32x4){0.f, 0.f, 0.f, 0.f};
    bf16x8 At[4][2], B0[2][2], B1[2][2];
    const char* cA = (const char*)g.A + (size_t)cur.pm * tstep; const char* cB = (const char*)g.Bt + (size_t)cur.pn * tstep;
    S.a_ready(cur, 0);
    if constexpr (SP2) {
        PG8_STAGE(PG8_SB(0, 0), cB, voffB); PG8_STAGE(PG8_SB(0, 1), cB + hstep, voffB); PG8_STAGE_A(PG8_SA(0, 0), cA, voffA); PG8_STAGE_A(PG8_SA(0, 1), cA + hstep, voffA);
        if (wr == 1) PG8_BAR;
        PG8_WAIT_V(2); PG8_BAR;
        PG8_STAGE(PG8_SB(1, 0), cB + kstep, voffB); PG8_STAGE_A(PG8_SA(1, 0), cA + kstep, voffA); PG8_STAGE(PG8_SB(1, 1), cB + hstep + kstep, voffB);
        PG8_WAIT_V(6); PG8_BAR;
    } else {
        PG8_STAGE(PG8_SB(0, 0), cB, voffB); PG8_STAGE_A(PG8_SA(0, 0), cA, voffA); PG8_STAGE(PG8_SB(0, 1), cB + hstep, voffB); PG8_STAGE_A(PG8_SA(0, 1), cA + hstep, voffA);
        if (wr == 1) PG8_BAR;
        PG8_WAIT_V(4); PG8_BAR;
        PG8_STAGE(PG8_SB(1, 0), cB + kstep, voffB); PG8_STAGE_A(PG8_SA(1, 0), cA + kstep, voffA); PG8_STAGE(PG8_SB(1, 1), cB + hstep + kstep, voffB);
        PG8_WAIT_V(6); PG8_BAR;
    }
    for (;;) {
        const bool has_next = S.next(ui + 1, nxt);
        const char* nA = has_next ? (const char*)g.A + (size_t)nxt.pm * tstep : cA; const char* nB = has_next ? (const char*)g.Bt + (size_t)nxt.pn * tstep : cB;
        for (int t = 0; t < nt; t += 2) {
            if constexpr (Epi::MIDSCALE) { if (t == (nt >> 1)) E.midscale(acc, wr, fr, ui); }
            if (t == nt - 4 && has_next) S.a_poll(nxt);
            const bool last = (t == nt - 2);
            const char* a1 = cA + (size_t)(t + 1) * kstep;
            const char* a2 = last ? nA : cA + (size_t)(t + 2) * kstep; const char* b2 = last ? nB : cB + (size_t)(t + 2) * kstep;
            const char* a3 = a2 + kstep; const char* b3 = b2 + kstep;
            if (last && has_next) { S.a_ready(nxt, ui + 1);
#ifdef MK_HOOK_TWICE
            S.a_ready(nxt, ui + 1);
#endif
            }
            if constexpr (SP2) {
            PG8_LDB(B0, 0, 0); PG8_LDB(B1, 0, 1); PG8_SCHED; PG8_LDA(At, 0, 0); PG8_STAGE_A(PG8_SA(1, 1), a1 + hstep, voffA);
            PG8_WAIT_V(8); PG8_WAIT_L(0); PG8_BAR; PG8_MMA(0, 0, At, B0); PG8_MMA(0, 1, At, B1); PG8_BAR; PG8_SCHED;
            PG8_LDA(At, 0, 1); PG8_STAGE(PG8_SB(0, 0), b2, voffB); PG8_STAGE(PG8_SB(0, 1), b2 + hstep, voffB); PG8_STAGE_A(PG8_SA(0, 0), a2, voffA);
            PG8_WAIT_V(8); PG8_WAIT_L(0); PG8_BAR; PG8_MMA(1, 0, At, B0); PG8_MMA(1, 1, At, B1); PG8_BAR; PG8_SCHED;
            PG8_LDB(B0, 1, 0); PG8_LDB(B1, 1, 1); PG8_SCHED; PG8_LDA(At, 1, 0); PG8_STAGE_A(PG8_SA(0, 1), a2 + hstep, voffA);
            PG8_WAIT_V(8); PG8_WAIT_L(0); PG8_BAR; PG8_MMA(0, 0, At, B0); PG8_MMA(0, 1, At, B1); PG8_BAR; PG8_SCHED;
            PG8_LDA(At, 1, 1); PG8_STAGE(PG8_SB(1, 0), b3, voffB); PG8_STAGE(PG8_SB(1, 1), b3 + hstep, voffB); PG8_STAGE_A(PG8_SA(1, 0), a3, voffA);
            PG8_WAIT_V(8); PG8_WAIT_L(0); PG8_BAR; PG8_MMA(1, 0, At, B0); PG8_MMA(1, 1, At, B1); PG8_BAR; PG8_SCHED;
            } else {
            PG8_LDB(B0, 0, 0); PG8_SCHED; PG8_LDA(At, 0, 0); PG8_STAGE_A(PG8_SA(1, 1), a1 + hstep, voffA);
            PG8_WAIT_L(8); PG8_BAR; PG8_WAIT_L(0); PG8_MMA(0, 0, At, B0); PG8_BAR; PG8_SCHED;
            PG8_LDB(B1, 0, 1); PG8_STAGE(PG8_SB(0, 0), b2, voffB);
            PG8_BAR; PG8_WAIT_L(0); PG8_MMA(0, 1, At, B1); PG8_BAR;
            PG8_LDA(At, 0, 1); PG8_STAGE_A(PG8_SA(0, 0), a2, voffA);
            PG8_BAR; PG8_WAIT_L(0); PG8_MMA(1, 0, At, B0); PG8_BAR; PG8_SCHED;
            PG8_STAGE(PG8_SB(0, 1), b2 + hstep, voffB);
            PG8_WAIT_V(6); PG8_BAR; PG8_MMA(1, 1, At, B1); PG8_BAR;
            PG8_LDB(B0, 1, 0); PG8_SCHED; PG8_LDA(At, 1, 0); PG8_STAGE_A(PG8_SA(0, 1), a2 + hstep, voffA);
            PG8_WAIT_L(8); PG8_BAR; PG8_WAIT_L(0); PG8_MMA(0, 0, At, B0); PG8_BAR; PG8_SCHED;
            PG8_LDB(B1, 1, 1); PG8_STAGE(PG8_SB(1, 0), b3, voffB);
            PG8_BAR; PG8_WAIT_L(0); PG8_MMA(0, 1, At, B1); PG8_BAR;
            PG8_LDA(At, 1, 1); PG8_STAGE_A(PG8_SA(1, 0), a3, voffA);
            PG8_BAR; PG8_WAIT_L(0); PG8_MMA(1, 0, At, B0); PG8_BAR; PG8_SCHED;
            PG8_STAGE(PG8_SB(1, 1), b3 + hstep, voffB);
            PG8_WAIT_V(6); PG8_BAR; PG8_MMA(1, 1, At, B1); PG8_BAR;
            }
        }
        if constexpr (ALIGN_EPI) { if (wr == 0) PG8_BAR; }
        if constexpr (!Epi::AFTER_DRAIN) { E(acc, cur, wr, wc, fr, fq, ui); S.done(cur); }
        if (!has_next) break;
#pragma unroll
        for (int a = 0; a < 2; ++a)
#pragma unroll
            for (int b = 0; b < 2; ++b)
#pragma unroll
                for (int m = 0; m < 4; ++m)
#pragma unroll
                    for (int n = 0; n < 2; ++n) acc[a][b][m][n] = (f32x4){0.f, 0.f, 0.f, 0.f};
        cur = nxt; cA = nA; cB = nB; ++ui;
        if constexpr (ALIGN_EPI) { if (wr == 1) PG8_BAR; }
    }
    PG8_WAIT_V(0);
    if constexpr (!ALIGN_EPI) { if (wr == 0) PG8_BAR; }
    PG8_BAR;
    if constexpr (Epi::AFTER_DRAIN) { E.fused(acc, cur, wr, wc, fr, fq, lds, wid, lane); S.done(cur); }
#undef PG8_SA
#undef PG8_SB
#undef PG8_STAGE
#undef PG8_STAGE_A
#undef PG8_LDA
#undef PG8_LDB
#undef PG8_MMA
#undef PG8_WAIT_V
#undef PG8_WAIT_L
#undef PG8_BAR
#undef PG8_SCHED
}
}
constexpr int NWAVES = 8;
#ifndef MK_CUTS
#define MK_CUTS 0
#endif
constexpr int N_PHASES = 7;

constexpr int BATCH = 8, SEQ = 4096, DM = 1024, CTXL = 256;
constexpr int MROWS = BATCH * SEQ;
constexpr int CROWS = BATCH * CTXL;
constexpr int INW = 1792, FFH = 2816, NMOD = 6 * DM;
constexpr float LOG2E = 1.4426950408889634f;

constexpr size_t MiB = 1u << 20;
constexpr size_t WS_CTL = 0, CTL_ZERO_BYTES = 128 * 1024;
constexpr size_t WS_MOD = 1 * MiB;
constexpr size_t WS_ROPE = WS_MOD + 256 * 1024;
constexpr size_t WS_BIAS = WS_ROPE + 64 * 1024;
constexpr size_t WS_SSQ3 = 2 * MiB;
constexpr size_t WS_WIN = 4 * MiB, WS_WOUT = 8 * MiB, WS_WGU = 10 * MiB, WS_WDN = 21 * MiB;
constexpr size_t WS_SSQ2 = 27 * MiB;
constexpr size_t WS_WSP = 29 * MiB;
constexpr size_t WS_RSTD3 = 30 * MiB;
constexpr size_t WS_XN = 32 * MiB;
constexpr size_t WS_A2 = WS_XN;
constexpr size_t WS_Y = 100 * MiB;
constexpr size_t WS_YC = 212 * MiB;
constexpr size_t WS_A3 = 216 * MiB;
constexpr size_t WS_H = 280 * MiB;
constexpr size_t WS_KV = 456 * MiB;
constexpr size_t WS_END = 472 * MiB;
static_assert(WS_BIAS + 8 * 5632 * 4 <= WS_SSQ3 && WS_WDN + (size_t)1024 * 2816 * 2 <= WS_SSQ2 && WS_SSQ2 + 2 * MiB <= WS_WSP && WS_WSP + 262144 <= WS_XN && WS_XN + (size_t)34816 * 2048 <= WS_Y && WS_Y + (size_t)MROWS * INW * 2 <= WS_YC && WS_YC + (size_t)CROWS * 512 <= WS_A3 && WS_A3 + (size_t)MROWS * 2048 <= WS_H && WS_H + (size_t)MROWS * FFH * 2 <= WS_END, "d_ws map");
constexpr int CW_TMO = 0, CW_CODE = 1;
constexpr int CW_BIASF = 28800;
constexpr int CW_RT = 28928;
constexpr int CW_BAR = 4096;

constexpr int RING_OFF = 0, RING_BYTES = 131072;
constexpr int LDSCTL_OFF = RING_BYTES, MISC_OFF = LDSCTL_OFF + 320;
constexpr int LDS_BYTES = 147456;

#define GAS __attribute__((address_space(1)))
#define LAS __attribute__((address_space(3)))
typedef unsigned short bf16;
typedef unsigned v4u __attribute__((ext_vector_type(4)));
typedef float f32x4 __attribute__((ext_vector_type(4)));
typedef short bf16x8 __attribute__((ext_vector_type(8)));
typedef GAS unsigned gu32;
typedef GAS unsigned long long gu64;
#define RLX_AGENT __ATOMIC_RELAXED, __HIP_MEMORY_SCOPE_AGENT
#define LDS_WAIT() asm volatile("s_waitcnt lgkmcnt(0)" ::: "memory")
#define VM_WAIT() asm volatile("s_waitcnt vmcnt(0)" ::: "memory")
__device__ __forceinline__ unsigned long long rt() { return __builtin_amdgcn_s_memrealtime(); }
__device__ __forceinline__ unsigned f2bf(float f) { unsigned u = __builtin_bit_cast(unsigned, f); return (u + 0x7fffu + ((u >> 16) & 1u)) >> 16; }
__device__ __forceinline__ unsigned pk2(float lo, float hi) { return f2bf(lo) | (f2bf(hi) << 16); }
#define XB_TMO      128
#define XB_XCNT(j)  (256  + 64 * (j))
#define XB_XSUB(j)  (1280 + 64 * (j))
#define XB_XGEN(j)  (2304 + 64 * (j))
#define XB_TOP      3328
#define XB_TOPGEN   3392
#define XCD_BAR_WORDS 3456
#define XB_SPIN_CAP (1u << 22)

__device__ __forceinline__ unsigned xb_ld(unsigned* p)              { return __hip_atomic_load(p, __ATOMIC_RELAXED, __HIP_MEMORY_SCOPE_AGENT); }
__device__ __forceinline__ unsigned xb_add(unsigned* p, unsigned v) { return __hip_atomic_fetch_add(p, v, __ATOMIC_RELAXED, __HIP_MEMORY_SCOPE_AGENT); }
__device__ __forceinline__ unsigned xb_xcc_id() { return (unsigned)__builtin_amdgcn_s_getreg((3 << 11) | 20) & 0xFu; }
#define XB_SPIN(cond, bar) do { unsigned _sp = 0; while (cond) { __builtin_amdgcn_s_sleep(1); \
    if ((++_sp & 255u) == 0u) { if (xb_ld(&(bar)[XB_TMO])) break; if (_sp > XB_SPIN_CAP) { atomicAdd(&(bar)[XB_TMO], 1u); break; } } } } while (0)

struct XcdBarrier {
    unsigned* bar; unsigned x;
    volatile LAS unsigned* st;
};

__device__ __forceinline__ XcdBarrier xcd_barrier_post(unsigned* bar, volatile LAS unsigned* st) {
    XcdBarrier b; b.bar = bar; b.x = xb_xcc_id(); b.st = st;
    if (threadIdx.x == 0) st[3] = xb_add(&bar[XB_XCNT(b.x)], 1u);
    return b;
}
__device__ __forceinline__ void xcd_barrier_complete(unsigned* bar, unsigned x, unsigned& nloc, unsigned& nx, unsigned& uni) {
    const unsigned G = gridDim.x * gridDim.y * gridDim.z;
    unsigned sum, cnt, mine, even, sp = 0u;
    for (;;) {
        sum = 0u; cnt = 0u; mine = 0u; even = 1u;
#pragma unroll
        for (unsigned j = 0; j < 16; ++j) { const unsigned c = xb_ld(&bar[XB_XCNT(j)]); sum += c; cnt += (c > 0u) ? 1u : 0u; mine = (j == x) ? c : mine; even &= (c == ((j < 8u) ? (G >> 3) : 0u)) ? 1u : 0u; }
        if (sum == G) break;
        __builtin_amdgcn_s_sleep(1);
        if ((++sp & 255u) == 0u) { if (xb_ld(&bar[XB_TMO])) break; if (sp > XB_SPIN_CAP) { atomicAdd(&bar[XB_TMO], 1u); break; } }
    }
    nloc = mine > 0u ? mine : 1u; nx = cnt > 0u ? cnt : 1u; uni = (sum == G && (G & 7u) == 0u && even) ? 1u : 2u;
}

__device__ __forceinline__ void xcd_barrier(const XcdBarrier& b, bool local = false) {
    asm volatile("s_waitcnt vmcnt(0)" ::: "memory");
    __syncthreads();
    if (threadIdx.x == 0) {
        unsigned* bar = b.bar;
        __builtin_amdgcn_s_waitcnt(0);
        unsigned nloc = b.st[0], nx = b.st[1];
        if (nloc == 0u) { unsigned uni; xcd_barrier_complete(bar, b.x, nloc, nx, uni); b.st[0] = nloc; b.st[1] = nx; b.st[2] = uni; }
        const unsigned old = xb_add(&bar[XB_XSUB(b.x)], 1u);
        const unsigned gen = old / nloc;
        if (old + 1u == (gen + 1u) * nloc && local) {
            __builtin_amdgcn_fence(__ATOMIC_ACQUIRE, "agent");
            xb_add(&bar[XB_XGEN(b.x)], 1u);
            asm volatile("s_waitcnt vmcnt(0)" ::: "memory");
        } else if (old + 1u == (gen + 1u) * nloc) {
            __builtin_amdgcn_fence(__ATOMIC_RELEASE, "agent");
            asm volatile("s_waitcnt vmcnt(0)" ::: "memory");
            const unsigned og = xb_add(&bar[XB_TOP], 1u);
            const unsigned tg = og / nx;
            if (og + 1u == (tg + 1u) * nx) xb_add(&bar[XB_TOPGEN], 1u);
            else XB_SPIN(xb_ld(&bar[XB_TOPGEN]) == tg, bar);
            __builtin_amdgcn_fence(__ATOMIC_ACQUIRE, "agent");
            xb_add(&bar[XB_XGEN(b.x)], 1u);
            asm volatile("s_waitcnt vmcnt(0)" ::: "memory");
        } else {
            XB_SPIN(xb_ld(&bar[XB_XGEN(b.x)]) == gen, bar);
            __builtin_amdgcn_fence(__ATOMIC_ACQUIRE, "agent");
            asm volatile("s_waitcnt vmcnt(0)" ::: "memory");
        }
    }
    __syncthreads();
}
struct Frame {
    LAS unsigned char* lds;
    volatile LAS unsigned* MISC;
    gu32* ctl;
    int tid, lane, wave;
    int vcu, G, cid, xcc, uni;
    const float *x, *c, *ctx, *c_ctx, *w_mod, *b_mod, *norm_mix, *norm_ffn, *w_in, *q_gain, *k_gain, *attn_sink, *gate_gain, *w_spatial, *b_spatial, *attn_out_gain, *mlp_out_gain, *w_out, *w_gate_up, *w_down;
    float* out;
    float *mod, *rope, *bias_t, *ssq3, *ssq2, *rstd3;
    bf16 *Win_t, *Wout_t, *Wgu_t, *Wdn_t, *XN, *Y, *Yc, *H, *A2, *A3, *Wsp, *KV;
};
__device__ __forceinline__ float bf2f(unsigned h) { return __builtin_bit_cast(float, h << 16); }
__device__ __forceinline__ float wave_sum(float v) {
#pragma unroll
    for (int o = 1; o < 64; o <<= 1) v += __shfl_xor(v, o);
    return v;
}
__device__ __forceinline__ float wave_max(float v) {
#pragma unroll
    for (int o = 1; o < 64; o <<= 1) v = fmaxf(v, __shfl_xor(v, o));
    return v;
}

__device__ __forceinline__ int dst_row(int mat, int n) {
    if (mat == 0) {
        const int head = n >> 6, d = n & 63, bj = d >> 5, l = d & 31;
        const bool rp = head < 2 || (head >= 4 && head < 12);
        const int p = rp ? (8 * ((l >> 2) & 3) + 4 * (l >> 4) + (l & 3)) : l;
        return 256 * (head >> 2) + 128 * bj + 32 * (head & 3) + p;
    }
    if (mat == 2) { const int bj = n >= FFH ? 1 : 0, j = n - FFH * bj; return 256 * (j >> 7) + 128 * bj + (j & 127); }
    return n;
}
__device__ __forceinline__ void p0_transpose_item(const float* W, int K, int N, bf16* WT, int mat, const float* g0, const float* g1, LAS float* scr, int item, int lane) {
    const int nblk = N / 32, kb = item / nblk, nb = item % nblk, k0 = 64 * kb, n0 = 32 * nb;
    const unsigned loff = (unsigned)((lane >> 5) * N + (lane & 31)); const float* wb = W + (size_t)k0 * N + n0;
#pragma unroll
    for (int i0 = 0; i0 < 32; i0 += 16) {
        float v[16];
#pragma unroll
        for (int i = 0; i < 16; ++i) v[i] = __builtin_nontemporal_load(wb + (size_t)(2 * (i0 + i)) * N + loff);
        __builtin_amdgcn_sched_barrier(0);
#pragma unroll
        for (int i = 0; i < 16; ++i) scr[(2 * (i0 + i) + (lane >> 5)) * 33 + (lane & 31)] = v[i];
        __builtin_amdgcn_sched_barrier(0);
    }
    LDS_WAIT(); asm volatile("" ::: "memory");
    const int c = lane & 7;
    float gk[8];
#pragma unroll
    for (int i = 0; i < 8; ++i) { const int k = k0 + 8 * c + i; gk[i] = (mat == 1) ? (k < 512 ? g0[k] : g1[k - 512]) : 1.0f; }
#pragma unroll
    for (int j = 0; j < 4; ++j) { const int n = (lane >> 3) + 8 * j; const LAS float* s = scr + (8 * c) * 33 + n;
        v4u o; o.x = pk2(s[0 * 33] * gk[0], s[1 * 33] * gk[1]); o.y = pk2(s[2 * 33] * gk[2], s[3 * 33] * gk[3]); o.z = pk2(s[4 * 33] * gk[4], s[5 * 33] * gk[5]); o.w = pk2(s[6 * 33] * gk[6], s[7 * 33] * gk[7]);
        *(GAS v4u*)(WT + pg8::tiled_off(dst_row(mat, n0 + n), k0 + 8 * c, K / 64)) = o; }
    LDS_WAIT(); asm volatile("" ::: "memory");
}
__device__ __forceinline__ void p0_prologue(Frame& F) {
#ifdef MK_P0A_TWICE
    for (int repa = 0; repa < 2; ++repa)
#endif
    if (F.vcu < NMOD / 32) {
        LAS float* sc = (LAS float*)(F.lds);
        LAS float* red = (LAS float*)(F.lds + 36864);
        { float cv[18];
#pragma unroll
          for (int j = 0; j < 18; ++j) { const int k = 512 * (j & 1) + F.tid; cv[j] = (j < 16) ? F.c[(j >> 1) * DM + k] : F.c_ctx[k]; }
          __builtin_amdgcn_sched_barrier(0);
#pragma unroll
          for (int j = 0; j < 18; ++j) { const float v = cv[j]; sc[512 * j + F.tid] = v / (1.0f + __expf(-v)); } }
        __syncthreads();
        for (int item = F.vcu; item < NMOD / 32; item += F.G) {
            const int kg = F.tid >> 5; const unsigned loff = (unsigned)(kg * NMOD + (F.tid & 31));
            const float* wb = F.w_mod + item * 32;
            float a[9];
#pragma unroll
            for (int n = 0; n < 9; ++n) a[n] = 0.f;
#pragma unroll
            for (int i0 = 0; i0 < DM / 16; i0 += 16) {
                float w[16];
#pragma unroll
                for (int i = 0; i < 16; ++i) w[i] = __builtin_nontemporal_load(wb + (size_t)(i0 + i) * 16 * NMOD + loff);
                __builtin_amdgcn_sched_barrier(0);
#pragma unroll
                for (int i = 0; i < 16; ++i) { const int k = 16 * (i0 + i) + kg;
#pragma unroll
                    for (int n = 0; n < 9; ++n) a[n] += sc[n * DM + k] * w[i]; }
                __builtin_amdgcn_sched_barrier(0);
            }
#pragma unroll
            for (int n = 0; n < 9; ++n) red[(kg * 9 + n) * 32 + (F.tid & 31)] = a[n];
            __syncthreads();
            if (F.tid < 288) { const int n = F.tid >> 5, cc = F.tid & 31; float s = 0.f;
#pragma unroll
                for (int g = 0; g < 16; ++g) s += red[(g * 9 + n) * 32 + cc];
                F.mod[n * NMOD + item * 32 + cc] = s + F.b_mod[item * 32 + cc]; }
            __syncthreads();
        }
    }
    { const int gt = F.vcu * NWAVES * 64 + F.tid;
      if (gt < 1024) { const int pos = gt >> 4, f = gt & 15; const float inv = powf(10000.0f, -(float)(2 * f) / 32.0f); const float ang = (float)pos * inv; F.rope[2 * gt] = cosf(ang); F.rope[2 * gt + 1] = sinf(ang); } }
    for (int it = F.vcu * NWAVES * 64 + F.tid; it < 8 * 128 * 16; it += F.G * NWAVES * 64) {
        const int hp = it >> 4, ks = (it >> 1) & 7, hi = it & 1;
        const float* srcp = F.w_spatial + (size_t)hp * 128 + 16 * ks + 4 * hi;
        const f32x4 a0 = *(const f32x4*)srcp, a1 = *(const f32x4*)(srcp + 8);
        v4u o; o.x = pk2(a0[0], a0[1]); o.y = pk2(a0[2], a0[3]); o.z = pk2(a1[0], a1[1]); o.w = pk2(a1[2], a1[3]);
        *(GAS v4u*)(F.Wsp + (size_t)hp * 128 + 16 * ks + 8 * hi) = o; }
    __syncthreads();
    LAS float* scr = (LAS float*)(F.lds + RING_OFF + F.wave * 16384);
    const int gw = F.vcu * NWAVES + F.wave, NGW = F.G * NWAVES;
    constexpr int I_IN = (DM / 64) * (INW / 32), I_OUT = (DM / 64) * (DM / 32), I_GU = (DM / 64) * (2 * FFH / 32), I_DN = (FFH / 64) * (DM / 32);
    constexpr int NITEMS = I_IN + I_OUT + I_GU + I_DN;
#ifdef MK_P0C_TWICE
    for (int repc = 0; repc < 2; ++repc)
#endif
    for (int it = gw; it < NITEMS; it += NGW) {
        int r = it;
        if (r < I_IN) { p0_transpose_item(F.w_in, DM, INW, F.Win_t, 0, nullptr, nullptr, scr, r, F.lane); continue; } r -= I_IN;
        if (r < I_OUT) { p0_transpose_item(F.w_out, DM, DM, F.Wout_t, 1, F.attn_out_gain, F.mlp_out_gain, scr, r, F.lane); continue; } r -= I_OUT;
        if (r < I_GU) { p0_transpose_item(F.w_gate_up, DM, 2 * FFH, F.Wgu_t, 2, nullptr, nullptr, scr, r, F.lane); continue; } r -= I_GU;
        p0_transpose_item(F.w_down, FFH, DM, F.Wdn_t, 3, nullptr, nullptr, scr, r, F.lane);
    }
}
#ifndef MK_NA
#define MK_NA 14
#endif
constexpr int P12_NA = MK_NA;
constexpr int P12_RANK_L = 17, P12_NWL = (32 - P12_RANK_L) * NWAVES;
constexpr int P12_NB = (17 - P12_NA) * 256;
__device__ __forceinline__ void p1_two_rows(Frame& F, int r0, int r1, bool has1) {
    const float* src0 = r0 < MROWS ? F.x + (size_t)r0 * DM : F.ctx + (size_t)(r0 - MROWS) * DM;
    const float* src1 = r1 < MROWS ? F.x + (size_t)r1 * DM : F.ctx + (size_t)(r1 - MROWS) * DM;
    f32x4 v0[4], v1[4]; float s0 = 0.f, s1 = 0.f;
#pragma unroll
    for (int j = 0; j < 4; ++j) { v0[j] = __builtin_nontemporal_load((const GAS f32x4*)src0 + F.lane + 64 * j); v1[j] = __builtin_nontemporal_load((const GAS f32x4*)src1 + F.lane + 64 * j); }
#pragma unroll
    for (int j = 0; j < 4; ++j) { s0 += (v0[j].x * v0[j].x + v0[j].y * v0[j].y) + (v0[j].z * v0[j].z + v0[j].w * v0[j].w); s1 += (v1[j].x * v1[j].x + v1[j].y * v1[j].y) + (v1[j].z * v1[j].z + v1[j].w * v1[j].w); }
    const float rstd0 = 1.0f / sqrtf(wave_sum(s0) * (1.0f / DM) + 1e-6f), rstd1 = 1.0f / sqrtf(wave_sum(s1) * (1.0f / DM) + 1e-6f);
#pragma unroll
    for (int rr = 0; rr < 2; ++rr) { if (rr == 1 && !has1) break;
        const int r = rr ? r1 : r0; const float rstd = rr ? rstd1 : rstd0;
        const float* md = F.mod + (r < MROWS ? (r >> 12) : 8) * NMOD;
#pragma unroll
        for (int j = 0; j < 4; ++j) { const int cidx = 4 * F.lane + 256 * j;
            const f32x4 g = *(const f32x4*)(F.norm_mix + cidx), sh = *(const f32x4*)(md + cidx), sc = *(const f32x4*)(md + DM + cidx);
            const f32x4 y = ((rr ? v1[j] : v0[j]) * rstd) * g * (sc + 1.0f) + sh;
            *(GAS unsigned long long*)(F.XN + pg8::tiled_off(r, cidx, 16)) = (unsigned long long)pk2(y.x, y.y) | ((unsigned long long)pk2(y.z, y.w) << 32); } }
}
__device__ __forceinline__ void p1_norm_rows(Frame& F) {
    const int gw = F.vcu * NWAVES + F.wave, NGW = F.G * NWAVES;
    if (F.uni) {
        const int rank = F.vcu & 31, wl = rank * NWAVES + F.wave;
        unsigned* cnt = (unsigned*)F.ctl + CW_RT + F.xcc * 32;
#pragma unroll 1
        for (int k0 = 0; k0 < P12_NA; k0 += 2) { const bool has1 = k0 + 1 < P12_NA; p1_two_rows(F, F.xcc * SEQ + wl + 256 * k0, F.xcc * SEQ + wl + 256 * (has1 ? k0 + 1 : k0), has1); }
        asm volatile("s_waitcnt vmcnt(0)" ::: "memory");
        if (F.lane == 0) __hip_atomic_fetch_add(cnt, 1u, __ATOMIC_RELAXED, __HIP_MEMORY_SCOPE_AGENT);
        if (rank >= P12_RANK_L) {
            const int wlL = (rank - P12_RANK_L) * NWAVES + F.wave;
#pragma unroll 1
            for (int j0 = wlL; j0 < P12_NB; j0 += 2 * P12_NWL) {
                const int j1 = j0 + P12_NWL; const bool has1 = j1 < P12_NB; const int jc = has1 ? j1 : j0;
                const int r0 = j0 < (16 - P12_NA) * 256 ? F.xcc * SEQ + P12_NA * 256 + j0 : MROWS + F.xcc * CTXL + (j0 - (16 - P12_NA) * 256);
                const int r1 = jc < (16 - P12_NA) * 256 ? F.xcc * SEQ + P12_NA * 256 + jc : MROWS + F.xcc * CTXL + (jc - (16 - P12_NA) * 256);
                p1_two_rows(F, r0, r1, has1);
            }
            asm volatile("s_waitcnt vmcnt(0)" ::: "memory");
            if (F.lane == 0) __hip_atomic_fetch_add(cnt + 1, 1u, __ATOMIC_RELAXED, __HIP_MEMORY_SCOPE_AGENT);
        }
    } else {
        const int nk = (MROWS + CROWS - gw + NGW - 1) / NGW;
#pragma unroll 1
        for (int k0 = 0; k0 < nk; k0 += 2) { const bool has1 = k0 + 1 < nk; p1_two_rows(F, gw + NGW * k0, has1 ? gw + NGW * (k0 + 1) : gw + NGW * k0, has1); }
    }
#ifdef MK_BIAS_TWICE
    for (int brep = 0; brep < 2; ++brep)
#endif
#pragma unroll 1
    for (int R0 = gw; R0 < 2 * FFH; R0 += 3 * NGW) {
        v4u w0[3], w1[3]; f32x4 shv[BATCH][4];
#pragma unroll
        for (int k = 0; k < 3; ++k) { const int R = R0 + NGW * k, Rc = R < 2 * FFH ? R : R0;
            w0[k] = *(const GAS v4u*)(F.Wgu_t + pg8::tiled_off(Rc, 16 * F.lane, 16)); w1[k] = *(const GAS v4u*)(F.Wgu_t + pg8::tiled_off(Rc, 16 * F.lane, 16) + 8); }
#pragma unroll
        for (int b = 0; b < BATCH; ++b)
#pragma unroll
            for (int i = 0; i < 4; ++i) shv[b][i] = *(const f32x4*)(F.mod + b * NMOD + 3 * DM + 16 * F.lane + 4 * i);
        __builtin_amdgcn_sched_barrier(0);
#pragma unroll
        for (int k = 0; k < 3; ++k) { float wf[16]; const int R = R0 + NGW * k;
#pragma unroll
            for (int i = 0; i < 4; ++i) { wf[2 * i] = bf2f(w0[k][i] & 0xffffu); wf[2 * i + 1] = bf2f(w0[k][i] >> 16); wf[8 + 2 * i] = bf2f(w1[k][i] & 0xffffu); wf[8 + 2 * i + 1] = bf2f(w1[k][i] >> 16); }
            float s[BATCH];
#pragma unroll
            for (int b = 0; b < BATCH; ++b) { s[b] = 0.f;
#pragma unroll
                for (int i = 0; i < 4; ++i) { const f32x4 t = shv[b][i]; s[b] += (t[0] * wf[4 * i] + t[1] * wf[4 * i + 1]) + (t[2] * wf[4 * i + 2] + t[3] * wf[4 * i + 3]); } }
#pragma unroll
            for (int o = 1; o < 64; o <<= 1) {
#pragma unroll
                for (int b = 0; b < BATCH; ++b) s[b] += __shfl_xor(s[b], o); }
            if (F.lane == 0 && R < 2 * FFH) {
#pragma unroll
                for (int b = 0; b < BATCH; ++b) __hip_atomic_store(F.bias_t + b * 2 * FFH + R, s[b], __ATOMIC_RELAXED, __HIP_MEMORY_SCOPE_AGENT); } }
    }
    asm volatile("s_waitcnt vmcnt(0)" ::: "memory");
    if (F.lane == 0) __hip_atomic_fetch_add((unsigned*)F.ctl + CW_BIASF, 1u, __ATOMIC_RELAXED, __HIP_MEMORY_SCOPE_AGENT);
}

namespace mix {
typedef short bf16x8 __attribute__((ext_vector_type(8)));
typedef short s16x4 __attribute__((ext_vector_type(4)));
typedef float f32x16 __attribute__((ext_vector_type(16)));
typedef LAS const char* lcp;
constexpr int SLOT = 32768;
constexpr int L_OST = 98304, L_WSF = LDSCTL_OFF + 1024;
constexpr int L_GT = 0;
__device__ __forceinline__ int crow(int r, int hi) { return (r & 3) + 8 * (r >> 2) + 4 * hi; }
__device__ __forceinline__ void glds16(const void* gsrc, unsigned lds_dst) { unsigned keep;
    asm volatile("s_mov_b32 %0, m0\n\ts_mov_b32 m0, %2\n\ts_nop 0\n\tglobal_load_lds_dwordx4 %1, off\n\ts_mov_b32 m0, %0" : "=&s"(keep) : "v"(gsrc), "s"(lds_dst) : "memory"); }
typedef float f32x2_t __attribute__((ext_vector_type(2))); typedef __bf16 bf16x2_t __attribute__((ext_vector_type(2)));
__device__ __forceinline__ unsigned cvtpk_s(float lo, float hi) { f32x2_t v = {lo, hi}; bf16x2_t b = __builtin_convertvector(v, bf16x2_t); return __builtin_bit_cast(unsigned, b); }
#define MIX_SBAR() __builtin_amdgcn_sched_barrier(0)
#define MIX_WAIT_BAR() asm volatile("s_waitcnt vmcnt(0) lgkmcnt(0)\n\ts_barrier" ::: "memory")
__device__ __forceinline__ void qkt(f32x16& p0, f32x16& p1, lcp Kslot, const bf16x8* qr, int r32, int hi) {
    lcp kb = Kslot + hi * 1024 + r32 * 16;
    f32x16 z0 = {}, z1 = {};
#pragma unroll
    for (int d0 = 0; d0 < 4; ++d0) {
        const bf16x8 b0 = *(LAS const bf16x8*)(kb + d0 * 2048), b1 = *(LAS const bf16x8*)(kb + d0 * 2048 + 512);
        z0 = __builtin_amdgcn_mfma_f32_32x32x16_bf16(b0, qr[d0], z0, 0, 0, 0); z1 = __builtin_amdgcn_mfma_f32_32x32x16_bf16(b1, qr[d0], z1, 0, 0, 0); }
    p0 = z0; p1 = z1;
}
__device__ __forceinline__ void pv(f32x16* o, int vb, bf16x8 pa0, bf16x8 pa1, bf16x8 pa2, bf16x8 pa3) {
#pragma unroll
    for (int d0 = 0; d0 < 2; ++d0) { s16x4 lo[4], hi[4];
#pragma unroll
        for (int ks = 0; ks < 4; ++ks) {
            asm volatile("ds_read_b64_tr_b16 %0,%1 offset:%c2" : "=&v"(lo[ks]) : "v"(vb), "i"(d0 * 4096 + ks * 1024) : "memory");
            asm volatile("ds_read_b64_tr_b16 %0,%1 offset:%c2" : "=&v"(hi[ks]) : "v"(vb), "i"(d0 * 4096 + ks * 1024 + 512) : "memory"); }
        asm volatile("s_waitcnt lgkmcnt(0)" ::: "memory"); MIX_SBAR();
#define MIX_PK(k) (bf16x8){lo[k][0], lo[k][1], lo[k][2], lo[k][3], hi[k][0], hi[k][1], hi[k][2], hi[k][3]}
        o[d0] = __builtin_amdgcn_mfma_f32_32x32x16_bf16(pa0, MIX_PK(0), o[d0], 0, 0, 0);
        o[d0] = __builtin_amdgcn_mfma_f32_32x32x16_bf16(pa1, MIX_PK(1), o[d0], 0, 0, 0);
        o[d0] = __builtin_amdgcn_mfma_f32_32x32x16_bf16(pa2, MIX_PK(2), o[d0], 0, 0, 0);
        o[d0] = __builtin_amdgcn_mfma_f32_32x32x16_bf16(pa3, MIX_PK(3), o[d0], 0, 0, 0);
#undef MIX_PK
    }
}
__device__ __forceinline__ void store_pair16(bf16* p, unsigned (&wa)[2], unsigned (&wb)[2]) {
    auto r0 = __builtin_amdgcn_permlane32_swap(wa[0], wb[0], false, false); auto r1 = __builtin_amdgcn_permlane32_swap(wa[1], wb[1], false, false);
    v4u w; w.x = r0[0]; w.y = r1[0]; w.z = r0[1]; w.w = r1[1];
    *(GAS v4u*)p = w;
}
typedef short v4i16_t __attribute__((ext_vector_type(4)));
__device__ __forceinline__ s16x4 vtr(lcp p) { return __builtin_bit_cast(s16x4, __builtin_amdgcn_ds_read_tr16_b64_v4i16((LAS v4i16_t*)p)); }
__device__ __forceinline__ bf16x8 pack8(const f32x16& p, int b0) {
    v4u w; w.x = cvtpk_s(p[b0], p[b0 + 1]); w.y = cvtpk_s(p[b0 + 2], p[b0 + 3]); w.z = cvtpk_s(p[b0 + 4], p[b0 + 5]); w.w = cvtpk_s(p[b0 + 6], p[b0 + 7]); return __builtin_bit_cast(bf16x8, w); }

__device__ __forceinline__ void gmlp_dma(Frame& F, int b, int blk) {
    unsigned ln = (unsigned)F.lane; asm volatile("" : "+v"(ln));
    const int h = F.wave; const size_t row0 = (size_t)b * SEQ + blk * 128;
    const unsigned gslot = (unsigned)(uintptr_t)F.lds + L_GT + h * 16384;
    const bf16* base = F.Y + row0 * INW + 1280 + 64 * h + ((ln >> 2) * (unsigned)INW + (ln & 3u) * 8u);
#pragma unroll
    for (int qt = 0; qt < 2; ++qt)
#pragma unroll
        for (int w = 0; w < 8; ++w)
            glds16(base + (size_t)(64 * qt + 16 * (w & 3)) * INW + (w >> 2) * 32, (unsigned)__builtin_amdgcn_readfirstlane(gslot + qt * 8192 + w * 1024));
}
template <bool DO_DMA> __device__ __forceinline__ void gmlp_unit(Frame& F, int b, int blk) {
    const int lane = F.lane, r32 = lane & 31, hi = lane >> 5, h = F.wave;
    const size_t row0 = (size_t)b * SEQ + blk * 128;
    const unsigned lds0 = (unsigned)(uintptr_t)F.lds;
    const unsigned gslot = lds0 + L_GT + h * 16384;
    const int vb0 = (int)gslot + ((lane >> 4) & 1) * 32 + (lane & 3) * 8 + (4 * hi + ((lane & 15) >> 2)) * 64;
    if (DO_DMA) gmlp_dma(F, b, blk);
#pragma unroll 1
    for (int half = 0; half < 2; ++half) {
        int p0 = 64 * half + r32; asm volatile("" : "+v"(p0));
        const bf16* wp = F.Wsp + ((size_t)h * 128 + p0) * 128 + 8 * hi;
        bf16x8 wf[2][2][4];
#pragma unroll
        for (int qt = 0; qt < 2; ++qt)
#pragma unroll
            for (int pbl = 0; pbl < 2; ++pbl)
#pragma unroll
                for (int ks = 0; ks < 4; ++ks) wf[qt][pbl][ks] = *(const GAS bf16x8*)(wp + pbl * 32 * 128 + qt * 64 + ks * 16);
        typedef unsigned u32x2_t __attribute__((ext_vector_type(2)));
        u32x2_t uu[2][2][4]; float bs[2];
#pragma unroll
        for (int pbl = 0; pbl < 2; ++pbl) { bs[pbl] = F.b_spatial[h * 128 + p0 + 32 * pbl];
#pragma unroll
            for (int d0 = 0; d0 < 2; ++d0)
#pragma unroll
                for (int k = 0; k < 4; ++k) uu[pbl][d0][k] = *(const GAS u32x2_t*)(F.Y + (row0 + p0 + 32 * pbl) * INW + 768 + 64 * h + 32 * d0 + 8 * k + 4 * hi); }
        asm volatile("s_waitcnt vmcnt(0)" ::: "memory");
        f32x16 o[2][2]; o[0][0] = f32x16{}; o[0][1] = f32x16{}; o[1][0] = f32x16{}; o[1][1] = f32x16{};
#pragma unroll
        for (int qt = 0; qt < 2; ++qt)
#pragma unroll
            for (int d0 = 0; d0 < 2; ++d0) { s16x4 lo[4], hv[4];
#pragma unroll
                for (int ks = 0; ks < 4; ++ks) {
                    asm volatile("ds_read_b64_tr_b16 %0,%1 offset:%c2" : "=&v"(lo[ks]) : "v"(vb0), "i"(qt * 8192 + d0 * 4096 + ks * 1024) : "memory");
                    asm volatile("ds_read_b64_tr_b16 %0,%1 offset:%c2" : "=&v"(hv[ks]) : "v"(vb0), "i"(qt * 8192 + d0 * 4096 + ks * 1024 + 512) : "memory"); }
                asm volatile("s_waitcnt lgkmcnt(0)" ::: "memory"); MIX_SBAR();
#pragma unroll
                for (int ks = 0; ks < 4; ++ks) { const bf16x8 vf = (bf16x8){lo[ks][0], lo[ks][1], lo[ks][2], lo[ks][3], hv[ks][0], hv[ks][1], hv[ks][2], hv[ks][3]};
                    o[0][d0] = __builtin_amdgcn_mfma_f32_32x32x16_bf16(vf, wf[qt][0][ks], o[0][d0], 0, 0, 0);
                    o[1][d0] = __builtin_amdgcn_mfma_f32_32x32x16_bf16(vf, wf[qt][1][ks], o[1][d0], 0, 0, 0); } }
#pragma unroll
        for (int pbl = 0; pbl < 2; ++pbl) { float sq = 0.f; const size_t prow = row0 + p0 + 32 * pbl;
#pragma unroll
            for (int d0 = 0; d0 < 2; ++d0)
#pragma unroll
                for (int kp = 0; kp < 2; ++kp) { unsigned wa[2], wb[2];
#pragma unroll
                    for (int q = 0; q < 2; ++q) { const int k = 2 * kp + q; const u32x2_t u = uu[pbl][d0][k];
                        const float v0 = bf2f(u[0] & 0xffffu) * (o[pbl][d0][4 * k] + bs[pbl]), v1 = bf2f(u[0] >> 16) * (o[pbl][d0][4 * k + 1] + bs[pbl]);
                        const float v2 = bf2f(u[1] & 0xffffu) * (o[pbl][d0][4 * k + 2] + bs[pbl]), v3 = bf2f(u[1] >> 16) * (o[pbl][d0][4 * k + 3] + bs[pbl]);
                        sq += (v0 * v0 + v1 * v1) + (v2 * v2 + v3 * v3);
                        if (q == 0) { wa[0] = cvtpk_s(v0, v1); wa[1] = cvtpk_s(v2, v3); } else { wb[0] = cvtpk_s(v0, v1); wb[1] = cvtpk_s(v2, v3); } }
                    store_pair16(F.A2 + pg8::tiled_off((int)prow, 512 + 64 * h + 32 * d0 + 16 * kp + 8 * hi, 16), wa, wb); }
            sq += __shfl_xor(sq, 32);
            if (hi == 0) F.ssq2[prow * 16 + 8 + h] = sq; }
    }
}

__device__ __forceinline__ void pv2(f32x16* oA, f32x16* oB, int vb, const bf16x8* paA, const bf16x8* paB) {
#pragma unroll
    for (int d0 = 0; d0 < 2; ++d0) { s16x4 lo[4], hi[4];
#pragma unroll
        for (int ks = 0; ks < 4; ++ks) {
            asm volatile("ds_read_b64_tr_b16 %0,%1 offset:%c2" : "=&v"(lo[ks]) : "v"(vb), "i"(d0 * 4096 + ks * 1024) : "memory");
            asm volatile("ds_read_b64_tr_b16 %0,%1 offset:%c2" : "=&v"(hi[ks]) : "v"(vb), "i"(d0 * 4096 + ks * 1024 + 512) : "memory"); }
        asm volatile("s_waitcnt lgkmcnt(0)" ::: "memory"); MIX_SBAR();
#define MIX_PK(k) (bf16x8){lo[k][0], lo[k][1], lo[k][2], lo[k][3], hi[k][0], hi[k][1], hi[k][2], hi[k][3]}
#pragma unroll
        for (int ks = 0; ks < 4; ++ks) { const bf16x8 vf = MIX_PK(ks);
            oA[d0] = __builtin_amdgcn_mfma_f32_32x32x16_bf16(vf, paA[ks], oA[d0], 0, 0, 0);
            oB[d0] = __builtin_amdgcn_mfma_f32_32x32x16_bf16(vf, paB[ks], oB[d0], 0, 0, 0); }
#undef MIX_PK
    }
}
__device__ __forceinline__ void attn_mask(f32x16& p0, f32x16& p1, int j, int s, int r32, int hi) {
    if (64 * j >= 32 * s + 31 && 64 * j + 63 <= 32 * s + 256) return;
    const int q_rel = 32 * s + r32, kb = 64 * j + 4 * hi;
#pragma unroll
    for (int r = 0; r < 16; ++r) { const int ko = kb + (r & 3) + 8 * (r >> 2);
        if (ko < q_rel || ko > q_rel + 256) p0[r] = -INFINITY;
        if (ko + 32 < q_rel || ko + 32 > q_rel + 256) p1[r] = -INFINITY; }
}
__device__ __forceinline__ void attn_epi(Frame& F, const f32x16* o, float l_reg, float sink2, int s, size_t row0, int h) {
    int lane = F.lane; asm volatile("" : "+v"(lane)); const int r32 = lane & 31, hi = lane >> 5;
    l_reg += __shfl_xor(l_reg, 32); l_reg += sink2;
    const float inv = 1.0f / l_reg; float sq = 0.f; const size_t prow = row0 + 32 * s + r32;
#pragma unroll
    for (int d0 = 0; d0 < 2; ++d0)
#pragma unroll
        for (int kp = 0; kp < 2; ++kp) { unsigned wa[2], wb[2];
#pragma unroll
            for (int q = 0; q < 2; ++q) { const int k = 2 * kp + q; unsigned w0 = cvtpk_s(o[d0][4 * k] * inv, o[d0][4 * k + 1] * inv), w1 = cvtpk_s(o[d0][4 * k + 2] * inv, o[d0][4 * k + 3] * inv);
                const float a0 = bf2f(w0 & 0xffffu), a1 = bf2f(w0 >> 16), a2 = bf2f(w1 & 0xffffu), a3 = bf2f(w1 >> 16);
                sq += (a0 * a0 + a1 * a1) + (a2 * a2 + a3 * a3);
                if (q == 0) { wa[0] = w0; wa[1] = w1; } else { wb[0] = w0; wb[1] = w1; } }
            store_pair16(F.A2 + pg8::tiled_off((int)prow, 64 * h + 32 * d0 + 16 * kp + 8 * hi, 16), wa, wb); }
    sq += __shfl_xor(sq, 32);
    if (hi == 0) F.ssq2[prow * 16 + h] = sq;
}
__device__ __forceinline__ void attn_tile(lcp kb, lcp vp, const int (&koffs)[4], const bf16x8 (&qA)[4], const bf16x8 (&qB)[4], f32x16 (&oA)[2], f32x16 (&oB)[2],
                                          float& lA, float& lB, int jm, int sA, int r32, int hi) {
    f32x16 pA0 = {}, pA1 = {}, pB0 = {}, pB1 = {};
    if (jm >= 0) { const int dA = 64 * jm + 4 * hi - (32 * sA + r32), dB = dA - 32;
#pragma unroll
        for (int r = 0; r < 16; ++r) { const int c = (r & 3) + 8 * (r >> 2);
            pA0[r] = ((unsigned)(dA + c) > 256u) ? -INFINITY : 0.f; pA1[r] = ((unsigned)(dA + c + 32) > 256u) ? -INFINITY : 0.f;
            pB0[r] = ((unsigned)(dB + c) > 256u) ? -INFINITY : 0.f; pB1[r] = ((unsigned)(dB + c + 32) > 256u) ? -INFINITY : 0.f; } }
    MIX_SBAR();
    bf16x8 kf[8];
#pragma unroll
    for (int d0 = 0; d0 < 4; ++d0) { kf[2 * d0] = *(LAS const bf16x8*)(kb + koffs[d0]); kf[2 * d0 + 1] = *(LAS const bf16x8*)(kb + koffs[d0] + 4096); }
#pragma unroll
    for (int d0 = 0; d0 < 4; ++d0) { pA0 = __builtin_amdgcn_mfma_f32_32x32x16_bf16(kf[2 * d0], qA[d0], pA0, 0, 0, 0); pA1 = __builtin_amdgcn_mfma_f32_32x32x16_bf16(kf[2 * d0 + 1], qA[d0], pA1, 0, 0, 0); }
    MIX_SBAR();
#pragma unroll
    for (int d0 = 0; d0 < 4; ++d0) { pB0 = __builtin_amdgcn_mfma_f32_32x32x16_bf16(kf[2 * d0], qB[d0], pB0, 0, 0, 0); pB1 = __builtin_amdgcn_mfma_f32_32x32x16_bf16(kf[2 * d0 + 1], qB[d0], pB1, 0, 0, 0); }
    float sa = 0.f;
#pragma unroll
    for (int r = 0; r < 16; ++r) { pA0[r] = __builtin_amdgcn_exp2f(pA0[r]); pA1[r] = __builtin_amdgcn_exp2f(pA1[r]); sa += pA0[r] + pA1[r]; }
    lA += sa;
    bf16x8 paA[4], paB[4], vf0[4], vf1[4];
    paA[0] = pack8(pA0, 0); paA[1] = pack8(pA0, 8); paA[2] = pack8(pA1, 0); paA[3] = pack8(pA1, 8);
#pragma unroll
    for (int i = 0; i < 8; ++i) { __builtin_amdgcn_sched_group_barrier(0x008, 1, 0); __builtin_amdgcn_sched_group_barrier(0x402, 10, 0); }
    MIX_SBAR();
    {
#pragma unroll
        for (int ks = 0; ks < 4; ++ks) { const s16x4 lo = vtr(vp + ks * 1024), hv = vtr(vp + ks * 1024 + 512); vf0[ks] = (bf16x8){lo[0], lo[1], lo[2], lo[3], hv[0], hv[1], hv[2], hv[3]}; }
#pragma unroll
        for (int ks = 0; ks < 4; ++ks) { const s16x4 lo = vtr(vp + 4096 + ks * 1024), hv = vtr(vp + 4096 + ks * 1024 + 512); vf1[ks] = (bf16x8){lo[0], lo[1], lo[2], lo[3], hv[0], hv[1], hv[2], hv[3]}; }
#pragma unroll
        for (int ks = 0; ks < 4; ++ks) oA[0] = __builtin_amdgcn_mfma_f32_32x32x16_bf16(vf0[ks], paA[ks], oA[0], 0, 0, 0);
#pragma unroll
        for (int ks = 0; ks < 4; ++ks) oA[1] = __builtin_amdgcn_mfma_f32_32x32x16_bf16(vf1[ks], paA[ks], oA[1], 0, 0, 0);
    }
    float sb = 0.f;
#pragma unroll
    for (int r = 0; r < 16; ++r) { pB0[r] = __builtin_amdgcn_exp2f(pB0[r]); pB1[r] = __builtin_amdgcn_exp2f(pB1[r]); sb += pB0[r] + pB1[r]; }
    lB += sb;
    paB[0] = pack8(pB0, 0); paB[1] = pack8(pB0, 8); paB[2] = pack8(pB1, 0); paB[3] = pack8(pB1, 8);
    __builtin_amdgcn_sched_group_barrier(0x100, 16, 0);
#pragma unroll
    for (int i = 0; i < 8; ++i) { __builtin_amdgcn_sched_group_barrier(0x008, 1, 0); __builtin_amdgcn_sched_group_barrier(0x402, 10, 0); }
    MIX_SBAR();
    {
        bf16x8 wf0[4], wf1[4];
#pragma unroll
        for (int ks = 0; ks < 4; ++ks) { const s16x4 lo = vtr(vp + ks * 1024), hv = vtr(vp + ks * 1024 + 512); wf0[ks] = (bf16x8){lo[0], lo[1], lo[2], lo[3], hv[0], hv[1], hv[2], hv[3]}; }
#pragma unroll
        for (int ks = 0; ks < 4; ++ks) { const s16x4 lo = vtr(vp + 4096 + ks * 1024), hv = vtr(vp + 4096 + ks * 1024 + 512); wf1[ks] = (bf16x8){lo[0], lo[1], lo[2], lo[3], hv[0], hv[1], hv[2], hv[3]}; }
#pragma unroll
        for (int ks = 0; ks < 4; ++ks) oB[0] = __builtin_amdgcn_mfma_f32_32x32x16_bf16(wf0[ks], paB[ks], oB[0], 0, 0, 0);
#pragma unroll
        for (int ks = 0; ks < 4; ++ks) oB[1] = __builtin_amdgcn_mfma_f32_32x32x16_bf16(wf1[ks], paB[ks], oB[1], 0, 0, 0);
    }
    MIX_SBAR();
}
__device__ __forceinline__ void attn_unit(Frame& F, int b, int blk) {
    const int lane = F.lane, r32 = lane & 31, hi = lane >> 5, h = F.wave, g = h >> 2, wid = F.wave;
    const size_t row0 = (size_t)b * SEQ + blk * 128;
    const unsigned lds0 = (unsigned)(uintptr_t)F.lds;
    const float sink2 = exp2f(F.attn_sink[h] * LOG2E);
    int koffs[4];
#pragma unroll
    for (int d0 = 0; d0 < 4; ++d0) koffs[d0] = (r32 >> 3) * 1024 + (r32 & 7) * 128 + (((2 * d0 + hi) ^ ((r32 >> 1) & 7)) * 16);
    const int vbl = ((lane >> 4) & 1) * 32 + (lane & 3) * 8 + (4 * hi + ((lane & 15) >> 2)) * 64;
    const int jf_blk = (blk == 0) ? 2 : 0, jl_blk = (blk == 31) ? 3 : 5;
    const int jf0 = jf_blk, jl0 = 4 < jl_blk ? 4 : jl_blk, nw0 = jl0 - jf0 + 1, n0 = nw0 + 4;
    const int jf1 = 1 > jf_blk ? 1 : jf_blk, jl1 = jl_blk, nw1 = jl1 - jf1 + 1, n1 = nw1 + 4;
    const int ntot = n0 + n1;
#define MIX_DMA(gi, slot) do { const int gi_ = (gi); const int ps_ = gi_ >= n0 ? 1 : 0, ti_ = gi_ - ps_ * n0, nw_ = ps_ ? nw1 : nw0, jf_ = ps_ ? jf1 : jf0; const bf16* base_; unsigned pitch_; \
        if (ti_ < nw_) { base_ = F.KV + ((size_t)b * SEQ + (size_t)(128 * (blk - 1) + 64 * (jf_ + ti_))) * 256; pitch_ = 256; } \
        else { base_ = F.Yc + ((size_t)b * CTXL + 64 * (ti_ - nw_)) * 256; pitch_ = 256; } \
        const unsigned sl_ = lds0 + (slot) * SLOT; \
        unsigned ln_ = (unsigned)lane; asm volatile("" : "+v"(ln_));     \
        const unsigned kk_ = 8u * (unsigned)wid + (ln_ >> 3); \
        const unsigned ko_ = kk_ * pitch_ + 8u * ((ln_ & 7u) ^ ((kk_ >> 1) & 7u)), vo_ = (16u * (unsigned)(wid & 3) + (ln_ >> 2)) * pitch_ + 128u + (unsigned)(wid >> 2) * 32u + (ln_ & 3u) * 8u; \
        glds16(base_ + ko_, (unsigned)__builtin_amdgcn_readfirstlane(sl_ + wid * 1024)); \
        glds16(base_ + ko_ + 64, (unsigned)__builtin_amdgcn_readfirstlane(sl_ + 8192 + wid * 1024)); \
        glds16(base_ + vo_, (unsigned)__builtin_amdgcn_readfirstlane(sl_ + 16384 + wid * 1024)); \
        glds16(base_ + vo_ + 64, (unsigned)__builtin_amdgcn_readfirstlane(sl_ + 24576 + wid * 1024)); } while (0)
    bf16x8 qA[4], qB[4];
#define MIX_LOADQ(ps) do { unsigned lq_ = (unsigned)lane; asm volatile("" : "+v"(lq_)); const bf16* qp_ = F.Y + (row0 + 64 * (ps)) * INW + 256 + 64 * h + ((lq_ & 31u) * (unsigned)INW + 8u * (lq_ >> 5)); \
        _Pragma("unroll") for (int d0 = 0; d0 < 4; ++d0) { qA[d0] = *(const GAS bf16x8*)(qp_ + 16 * d0); qB[d0] = *(const GAS bf16x8*)(qp_ + (size_t)32 * INW + 16 * d0); } } while (0)
    MIX_LOADQ(0);
    MIX_DMA(0, 0); MIX_DMA(1, 1);
    int gi = 0, slot = 0; bool gpend = false;
    for (int ps = 0; ps < 2; ++ps) {
        const int np = ps ? n1 : n0, nwp = ps ? nw1 : nw0, jfp = ps ? jf1 : jf0, sA = 2 * ps, sB = 2 * ps + 1;
        if (ps) MIX_LOADQ(1);
        f32x16 oA[2], oB[2]; oA[0] = f32x16{}; oA[1] = f32x16{}; oB[0] = f32x16{}; oB[1] = f32x16{};
        float lA = 0.f, lB = 0.f;
        for (int ti = 0; ti < np; ++ti, ++gi) {
            if (gi + 1 < ntot) asm volatile("s_waitcnt vmcnt(4) lgkmcnt(0)\n\ts_barrier" ::: "memory");
            else if (gpend) asm volatile("s_waitcnt vmcnt(16) lgkmcnt(0)\n\ts_barrier" ::: "memory");
            else asm volatile("s_waitcnt vmcnt(0) lgkmcnt(0)\n\ts_barrier" ::: "memory");
            { const int s2 = slot + 2 >= 3 ? slot - 1 : slot + 2;
              if (gi == 1 && (h >> 1) == 3) gmlp_dma(F, b, blk);
              if (gi + 2 < ntot) MIX_DMA(gi + 2, s2);
              else if ((h >> 1) == s2) { gmlp_dma(F, b, blk); gpend = true; } }
            lcp kb = (lcp)(F.lds + slot * SLOT + g * 8192);
            lcp vp = (lcp)(F.lds + slot * SLOT + 16384 + g * 8192) + vbl;
            const int jt = ti < nwp ? jfp + ti : -1;
            attn_tile(kb, vp, koffs, qA, qB, oA, oB, lA, lB, (jt >= 0 && (jt == (ps ? 1 : 0) || jt == (ps ? 5 : 4))) ? jt : -1, sA, r32, hi);
            slot = slot == 2 ? 0 : slot + 1;
        }
        attn_epi(F, oA, lA, sink2, sA, row0, h);
        attn_epi(F, oB, lB, sink2, sB, row0, h);
    }
    asm volatile("s_waitcnt lgkmcnt(0)\n\ts_barrier" ::: "memory");
    { const int sl = slot == 0 ? 2 : slot - 1; if ((h >> 1) == sl) gmlp_dma(F, b, blk); }
#undef MIX_DMA
#undef MIX_LOADQ
}

__device__ __forceinline__ void p3_mixer(Frame& F) {
    for (int item = F.vcu; item < BATCH * 32; item += F.G) {
        const int b = item >> 5, blk = item & 31;
#ifdef MK_ATTN_TWICE
        for (int rep_ = 0; rep_ < 2; ++rep_) { asm volatile("s_waitcnt vmcnt(0) lgkmcnt(0)" ::: "memory"); __syncthreads();
#endif
        attn_unit(F, b, blk);
#ifdef MK_ATTN_TWICE
        }
#endif
        gmlp_unit<false>(F, b, blk);
        asm volatile("s_waitcnt vmcnt(0) lgkmcnt(0)" ::: "memory"); __syncthreads();
    }
}
#undef MIX_SBAR
#undef MIX_WAIT_BAR
}
struct Args { const float* in[20]; float* out; unsigned char* ws; int ph_lo, ph_hi, li, pad; };
__global__ void __launch_bounds__(NWAVES * 64, 2) fwd_mega(Args args) {
    extern __shared__ __attribute__((aligned(16))) unsigned char lds[];
    Frame F;
    F.lds = (LAS unsigned char*)lds;
    F.MISC = (volatile LAS unsigned*)(F.lds + MISC_OFF);
    F.tid = threadIdx.x; F.lane = F.tid & 63; F.wave = __builtin_amdgcn_readfirstlane(F.tid >> 6);
    F.G = gridDim.x; { const int bx = blockIdx.x; F.vcu = (F.G % 8 == 0) ? (bx % 8) * (F.G / 8) + bx / 8 : bx; }
    unsigned char* ws = args.ws;
    F.ctl = (gu32*)(ws + WS_CTL);
    F.x = args.in[0]; F.c = args.in[1]; F.ctx = args.in[2]; F.c_ctx = args.in[3]; F.w_mod = args.in[4]; F.b_mod = args.in[5]; F.norm_mix = args.in[6]; F.norm_ffn = args.in[7];
    F.w_in = args.in[8]; F.q_gain = args.in[9]; F.k_gain = args.in[10]; F.attn_sink = args.in[11]; F.gate_gain = args.in[12]; F.w_spatial = args.in[13]; F.b_spatial = args.in[14];
    F.attn_out_gain = args.in[15]; F.mlp_out_gain = args.in[16]; F.w_out = args.in[17]; F.w_gate_up = args.in[18]; F.w_down = args.in[19]; F.out = args.out;
    F.mod = (float*)(ws + WS_MOD); F.rope = (float*)(ws + WS_ROPE); F.bias_t = (float*)(ws + WS_BIAS); F.ssq3 = (float*)(ws + WS_SSQ3); F.ssq2 = (float*)(ws + WS_SSQ2); F.rstd3 = (float*)(ws + WS_RSTD3);
    F.Win_t = (bf16*)(ws + WS_WIN); F.Wout_t = (bf16*)(ws + WS_WOUT); F.Wgu_t = (bf16*)(ws + WS_WGU); F.Wdn_t = (bf16*)(ws + WS_WDN);
    F.XN = (bf16*)(ws + WS_XN); F.Y = (bf16*)(ws + WS_Y); F.Yc = (bf16*)(ws + WS_YC); F.H = (bf16*)(ws + WS_H); F.A2 = (bf16*)(ws + WS_A2); F.A3 = (bf16*)(ws + WS_A3); F.Wsp = (bf16*)(ws + WS_WSP); F.KV = (bf16*)(ws + WS_KV);
    for (int u = F.tid; u < (LDS_BYTES - LDSCTL_OFF) / 4; u += NWAVES * 64) ((LAS unsigned*)(F.lds + LDSCTL_OFF))[u] = 0u;
    __syncthreads();
    XcdBarrier bar = xcd_barrier_post((unsigned*)(F.ctl + CW_BAR) + args.li * XCD_BAR_WORDS, F.MISC + 8);
    if (F.tid == 0) { unsigned nloc, nx, uni; xcd_barrier_complete(bar.bar, bar.x, nloc, nx, uni); bar.st[0] = nloc; bar.st[1] = nx; bar.st[2] = uni; }
    __syncthreads();
    F.xcc = (int)bar.x; F.uni = (F.MISC[10] == 1u && F.G == 256) ? 1 : 0;
#ifdef MK_FORCE_NONUNI
    F.uni = 0;
#endif
    F.cid = (int)blockIdx.x;
    if (F.uni) { const int rank = (int)F.MISC[11]; F.cid = rank * 8 + F.xcc; F.vcu = F.xcc * 32 + rank; }
    const int lo = args.ph_lo, hi = args.ph_hi;
#define IN(k) (lo <= (k) && (k) < hi)
#define SEAM(k) do { if (IN(k) && IN((k) + 1)) xcd_barrier(bar, F.uni && (k) >= 1); } while (0)

#ifndef MK_DUP
#define MK_DUP 0
#endif
#define REP(k) for (int rep_ = 0; rep_ < (((MK_DUP >> (k)) & 1) ? 2 : 1); ++rep_)
    if (IN(0)) { REP(0) { p0_prologue(F); __syncthreads(); } SEAM(0); }
#ifdef MK_XBAR
    for (int xb = 0; xb < MK_XBAR; ++xb) xcd_barrier(bar);
#endif
    if (IN(1)) { REP(1) p1_norm_rows(F); if (!F.uni) SEAM(1); }
#if defined(MK_SLEEP_H) || defined(MK_SLEEP_L)
    { const int rank_ = F.vcu & 31; int us_ = 0;
#ifdef MK_SLEEP_H
      if (rank_ < P12_RANK_L) us_ = MK_SLEEP_H;
#endif
#ifdef MK_SLEEP_L
      if (rank_ >= P12_RANK_L) us_ = MK_SLEEP_L;
#endif
      const unsigned long long t0_ = rt(); while (rt() - t0_ < (unsigned long long)us_ * 100ull) __builtin_amdgcn_s_sleep(8); }
#endif
    if (IN(2)) {
        LAS float* ropeL = (LAS float*)(F.lds + LDSCTL_OFF + 1024); LAS float* gainL = ropeL + 2048;
        for (int i = F.tid; i < 2048; i += NWAVES * 64) ropeL[i] = F.rope[i];
        for (int i = F.tid; i < 640; i += NWAVES * 64) gainL[i] = i < 64 ? F.q_gain[i] * pg8::C2Q : i < 128 ? F.k_gain[i - 64] : F.gate_gain[i - 128];
        __syncthreads();
        pg8::Gemm g{F.XN, F.Win_t, MROWS, INW, DM}; pg8::InProjOrder S; S.so.init(MROWS, INW, F.G, F.cid); S.cnt = F.uni ? (const unsigned*)F.ctl + CW_RT + F.xcc * 32 : nullptr; S.flagp = (LAS unsigned*)(F.lds + LDSCTL_OFF + 512); S.na = P12_NA; S.nb = P12_NWL;
        pg8::EpiInProj E{F.Y, F.Yc, F.KV, ropeL, gainL};
        REP(2) pg8::gemm_phase<pg8::EpiInProj, pg8::InProjOrder, true, true>(F.lds + RING_OFF, g, S, E);
        SEAM(2);
    }
    if (IN(3)) { REP(3) mix::p3_mixer(F); SEAM(3); }
    if (IN(4)) {
        pg8::Gemm g{F.A2, F.Wout_t, MROWS, DM, DM}; pg8::OutProjOrder S; S.init(MROWS, DM, F.G, F.cid);
        S.ssq2 = F.ssq2; S.mod = F.mod; S.norm_ffn = F.norm_ffn; S.tab = (LAS float*)(F.lds + LDSCTL_OFF + 1024);
        pg8::EpiOutProj E{F.x, F.A3, F.ssq3, S.tab};
        REP(4) pg8::gemm_phase<pg8::EpiOutProj, pg8::OutProjOrder, true, true>(F.lds + RING_OFF, g, S, E);
        SEAM(4);
    }
    if (IN(5)) {
        { const int wv = F.uni ? (F.vcu & 31) * NWAVES + F.wave : F.vcu * NWAVES + F.wave, nwv = F.uni ? 256 : F.G * NWAVES; const size_t rbase = F.uni ? (size_t)F.xcc * SEQ : 0, rend = F.uni ? rbase + SEQ : MROWS;
          for (size_t rowb = rbase + 16 * (size_t)wv + (F.lane >> 2); rowb < rend; rowb += 16 * (size_t)nwv) {
              const f32x4 p = *(const f32x4*)(F.ssq3 + rowb * 16 + 4 * (F.lane & 3)); float ss = (p[0] + p[1]) + (p[2] + p[3]);
              ss += __shfl_xor(ss, 1); ss += __shfl_xor(ss, 2);
              if ((F.lane & 3) == 0) F.rstd3[rowb] = 1.0f / sqrtf(ss * (1.0f / 1024.0f) + 1e-6f); } }
        if (F.tid == 0) { unsigned* fl = (unsigned*)F.ctl + CW_BIASF; const unsigned want = (unsigned)(F.G * NWAVES); XB_SPIN(xb_ld(fl) < want, bar.bar); }
        xcd_barrier(bar, F.uni);
        pg8::Gemm g{F.A3, F.Wgu_t, MROWS, 2 * FFH, DM}; pg8::GateUpOrder S; S.init(MROWS, 2 * FFH, F.G, F.cid);
        S.rstd3 = F.rstd3; S.bias_t = F.bias_t; S.tab = (LAS float*)(F.lds + LDSCTL_OFF + 1024);
        pg8::EpiGateUp E{F.H, S.tab};
        REP(5) pg8::gemm_phase<pg8::EpiGateUp, pg8::GateUpOrder, true, true>(F.lds + RING_OFF, g, S, E);
        SEAM(5);
    }
    if (IN(6)) {
#ifdef MK_SLEEP_P6
        if (F.vcu & 16) { const unsigned long long t0_ = rt(); while (rt() - t0_ < (unsigned long long)(MK_SLEEP_P6) * 100ull) __builtin_amdgcn_s_sleep(8); }
#endif
        pg8::Gemm g{F.H, F.Wdn_t, MROWS, DM, FFH}; pg8::DownOrder S; S.init(MROWS, DM, F.G, F.cid);
        S.mod = F.mod; S.norm_ffn = F.norm_ffn; S.tab = (LAS float*)(F.lds + LDSCTL_OFF + 1024);
        pg8::EpiDown E{F.A3, F.out, S.tab};
        pg8::gemm_phase<pg8::EpiDown, pg8::DownOrder, true, true>(F.lds + RING_OFF, g, S, E);
    }
#undef IN
#undef SEAM
}

extern "C" void kernel_launch(void* const* d_in, const int* in_sizes, int n_in, void* d_out, int out_size, void* d_ws, size_t ws_size, hipStream_t stream) {
    static int grid = 0;
    if (grid == 0) {
        if (n_in != 20 || in_sizes[0] != MROWS * DM || out_size != MROWS * DM || ws_size < WS_END) { fprintf(stderr, "kernel_launch: unexpected shapes: n_in %d in0 %d out %d ws %zu\n", n_in, n_in > 0 ? in_sizes[0] : -1, out_size, ws_size); grid = -1; return; }
        int dev = 0, cus = 0, per_cu = 0;
        if (hipGetDevice(&dev) != hipSuccess || hipDeviceGetAttribute(&cus, hipDeviceAttributeMultiprocessorCount, dev) != hipSuccess) { grid = -1; return; }
        if (hipFuncSetAttribute((const void*)fwd_mega, hipFuncAttributeMaxDynamicSharedMemorySize, LDS_BYTES) != hipSuccess) { fprintf(stderr, "kernel_launch: hipFuncSetAttribute failed\n"); grid = -1; return; }
        if (hipOccupancyMaxActiveBlocksPerMultiprocessor(&per_cu, (const void*)fwd_mega, NWAVES * 64, LDS_BYTES) != hipSuccess || per_cu < 1) fprintf(stderr, "kernel_launch: occupancy query says %d\n", per_cu);
        (void)hipGetLastError();
        grid = cus - (cus % 8);
        if (grid < 8) grid = cus;
    }
    if (grid < 0) return;
    if (hipMemsetAsync((char*)d_ws + WS_CTL, 0, CTL_ZERO_BYTES, stream) != hipSuccess) return;
    Args a{};
    for (int i = 0; i < 20; ++i) a.in[i] = (const float*)d_in[i];
    a.out = (float*)d_out; a.ws = (unsigned char*)d_ws;
#ifdef MK_PROBE_PHASE
    const int plan[3][2] = {{0, MK_PROBE_PHASE + 1}, {MK_PROBE_PHASE, MK_PROBE_PHASE + 1}, {MK_PROBE_PHASE + 1, N_PHASES}};
    for (int li = 0; li < 3; ++li) { if (plan[li][0] >= plan[li][1]) continue; a.ph_lo = plan[li][0]; a.ph_hi = plan[li][1]; a.li = li;
        hipLaunchKernelGGL(fwd_mega, dim3(grid), dim3(NWAVES * 64), LDS_BYTES, stream, a); }
#else
    int lo = 0, li = 0;
    for (int k = 0; k < N_PHASES; ++k) {
        const bool cut = (k == N_PHASES - 1) || ((MK_CUTS >> k) & 1);
        if (!cut) continue;
        a.ph_lo = lo; a.ph_hi = k + 1; a.li = li++;
        hipLaunchKernelGGL(fwd_mega, dim3(grid), dim3(NWAVES * 64), LDS_BYTES, stream, a);
        lo = k + 1;
    }
#endif
}
```

```cpp
#define MK_NA 13
#include <hip/hip_runtime.h>
#include <cstdio>
#include <cstdint>
#include <cmath>
namespace pg8 {
#define PG8_LAS __attribute__((address_space(3)))
typedef unsigned short bf16_t;
typedef short bf16x8 __attribute__((ext_vector_type(8)));
typedef float f32x4 __attribute__((ext_vector_type(4)));
typedef unsigned u32x4 __attribute__((ext_vector_type(4)));
constexpr int BM = 256, BK = 64, HALF = 128, HTB = HALF * BK * 2  , STAGE_BYTES = 8 * HTB, NXCD = 8, WGM = 4;

__host__ __device__ __forceinline__ int lds_byte(int r, int c) { const int st = (r >> 4) * 2 + (c >> 5), rr = r & 15, cc = c & 31, ob = rr * 64 + cc * 2; return st * 1024 + (ob ^ (((ob >> 9) & 1) << 5)); }
__host__ __device__ __forceinline__ void stage_rc(int b, int& R, int& C) { const int st = b / 1024, sb = b % 1024, swz = sb ^ (((sb >> 9) & 1) << 5); R = (st >> 1) * 16 + swz / 64; C = (st & 1) * 32 + (swz % 64) / 2; }
__host__ __device__ __forceinline__ int perm32(int rho) { const int n = rho >> 4, i = rho & 15; return 8 * (i >> 2) + 4 * n + (i & 3); }

__host__ __device__ __forceinline__ size_t tiled_off(int row, int col, int nt) { return (((size_t)(row >> 8) * nt + (col >> 6)) * 256 + (row & 255)) * 64 + (col & 63); }
struct Unit { int pm, pn; };
struct Gemm { const bf16_t* A; const bf16_t* Bt; int M, N, K; };

struct StaticOrder {
    int nM, nN, nwg, G, c;
    __host__ __device__ void init(int M, int N, int G_, int c_) { nM = M / BM; nN = N / BM; nwg = nM * nN; G = G_; c = c_; }
    __host__ __device__ bool next(int i, Unit& u) const {
        const long L = (long)i * G + c; if (L >= nwg) return false;
        int wgid = (int)L; { const int q = nwg / NXCD, r = nwg % NXCD, xcd = wgid % NXCD, off = wgid / NXCD; wgid = (xcd < r ? xcd * (q + 1) : r * (q + 1) + (xcd - r) * q) + off; }
        const int nig = WGM * nN, gid = wgid / nig, fm = gid * WGM, gsz = (nM - fm) < WGM ? (nM - fm) : WGM;
        u.pm = fm + ((wgid % nig) % gsz); u.pn = (wgid % nig) / gsz; return true;
    }
    __device__ __forceinline__ void a_ready(const Unit&, int) const {}
    __device__ __forceinline__ void a_poll(const Unit&) const {}
    __device__ __forceinline__ void done(const Unit&) const {}
};
typedef float cvt_f32x2_t __attribute__((ext_vector_type(2))); typedef __bf16 cvt_bf16x2_t __attribute__((ext_vector_type(2)));
__device__ __forceinline__ unsigned cvt_pk_bf16(float lo, float hi) { cvt_f32x2_t v = {lo, hi}; cvt_bf16x2_t b = __builtin_convertvector(v, cvt_bf16x2_t); return __builtin_bit_cast(unsigned, b); }
typedef float f32x2 __attribute__((ext_vector_type(2)));
typedef unsigned u32x2 __attribute__((ext_vector_type(2)));
constexpr float C2Q = 0.125f * 1.4426950408889634f;
constexpr float RMS_EPS = 1e-6f;
__device__ __forceinline__ float gelu_tanh(float x) {
    const float z2 = x * (1.5957691216057308f + 0.07135481627244473f * x * x);
    const float e = __builtin_amdgcn_exp2f(-1.4426950408889634f * z2);
    return x * __builtin_amdgcn_rcpf(1.0f + e);
}
__device__ __forceinline__ float silu_f(float x) { return x * __builtin_amdgcn_rcpf(1.0f + __builtin_amdgcn_exp2f(-1.4426950408889634f * x)); }

struct EpiInProj {
    static constexpr bool PERM = true, AFTER_DRAIN = false, MIDSCALE = false; static constexpr int A_AUX = 0;
    bf16_t* Y; bf16_t* Yc; bf16_t* KV; PG8_LAS const float* ropeL; PG8_LAS const float* gainL;
    __device__ __forceinline__ void operator()(const f32x4 (&acc)[2][2][4][2], const Unit& u, int wr, int wc, int fr, int fq, int) const {
        const bool ctx = u.pm >= 128;
        const int head = __builtin_amdgcn_readfirstlane(4 * u.pn + wc);
        const int type = head < 2 ? 0 : head < 4 ? 1 : head < 12 ? 2 : head < 20 ? 3 : 4;
        bf16_t* base; int ld, rowb;
        if (ctx) { base = Yc; ld = 256; rowb = (u.pm - 128) * 256; } else if (head < 4) { base = KV; ld = 256; rowb = u.pm * 256; }
        else { base = Y; ld = 1792; rowb = u.pm * 256; }
        const int colb = head * 64 + 8 * fq;
        f32x4 g[2][2];
#pragma unroll
        for (int bj = 0; bj < 2; ++bj)
#pragma unroll
            for (int n = 0; n < 2; ++n) {
                if (type == 0) g[bj][n] = *(PG8_LAS const f32x4*)(gainL + 64 + 32 * bj + 16 * n + 4 * fq);
                else if (type == 2) g[bj][n] = *(PG8_LAS const f32x4*)(gainL + 32 * bj + 16 * n + 4 * fq);
                else if (type == 4) g[bj][n] = *(PG8_LAS const f32x4*)(gainL + 128 + (head - 20) * 64 + 32 * bj + 8 * fq + 4 * n);
                else g[bj][n] = (f32x4){1.f, 1.f, 1.f, 1.f};
            }
        const bool do_norm = (type == 0 || type == 2 || type == 4), do_rope = (type == 2) || (type == 0 && !ctx), do_gelu = type >= 3;
#pragma unroll
        for (int ai = 0; ai < 2; ++ai)
#pragma unroll
            for (int m = 0; m < 4; ++m) {
                const int row = rowb + ai * HALF + wr * 64 + m * 16 + fr;
                f32x4 v[2][2];
#pragma unroll
                for (int bj = 0; bj < 2; ++bj)
#pragma unroll
                    for (int n = 0; n < 2; ++n) v[bj][n] = acc[ai][bj][m][n];
                if (do_gelu) {
#pragma unroll
                    for (int bj = 0; bj < 2; ++bj)
#pragma unroll
                        for (int n = 0; n < 2; ++n) { const f32x4 xx = v[bj][n]; const f32x4 t = xx * ((xx * xx) * (-1.4426950408889634f * 0.07135481627244473f) + (-1.4426950408889634f * 1.5957691216057308f)); f32x4 d;
#pragma unroll
                            for (int e = 0; e < 4; ++e) d[e] = __builtin_amdgcn_exp2f(t[e]);
                            d = d + 1.0f; f32x4 r;
#pragma unroll
                            for (int e = 0; e < 4; ++e) r[e] = __builtin_amdgcn_rcpf(d[e]);
                            v[bj][n] = xx * r; }
                }
                if (do_norm) {
                    float ss = 0.f;
#pragma unroll
                    for (int bj = 0; bj < 2; ++bj)
#pragma unroll
                        for (int n = 0; n < 2; ++n) { const f32x4 t = v[bj][n]; ss += (t[0] * t[0] + t[1] * t[1]) + (t[2] * t[2] + t[3] * t[3]); }
                    ss += __shfl_xor(ss, 16); ss += __shfl_xor(ss, 32);
                    const float rstd = __builtin_amdgcn_rsqf(ss * (1.0f / 64.0f) + RMS_EPS);
#pragma unroll
                    for (int bj = 0; bj < 2; ++bj)
#pragma unroll
                        for (int n = 0; n < 2; ++n) v[bj][n] = v[bj][n] * rstd * g[bj][n];
                }
                if (do_rope) {
                    const int t = row & 4095;
#pragma unroll
                    for (int bj = 0; bj < 2; ++bj) {
                        const int pos = bj ? (t & 63) : (t >> 6);
                        const f32x4 cs0 = *(PG8_LAS const f32x4*)(ropeL + (pos * 16 + 4 * fq) * 2), cs1 = *(PG8_LAS const f32x4*)(ropeL + (pos * 16 + 4 * fq) * 2 + 4);
                        const f32x4 c = {cs0[0], cs0[2], cs1[0], cs1[2]}, s = {cs0[1], cs0[3], cs1[1], cs1[3]};
                        const f32x4 x1 = v[bj][0], x2 = v[bj][1]; v[bj][0] = x1 * c - x2 * s; v[bj][1] = x1 * s + x2 * c;
                    }
                }
                bf16_t* rowp = base + (size_t)row * ld + colb;
#pragma unroll
                for (int bj = 0; bj < 2; ++bj) { u32x4 w; w.x = cvt_pk_bf16(v[bj][0][0], v[bj][0][1]); w.y = cvt_pk_bf16(v[bj][0][2], v[bj][0][3]); w.z = cvt_pk_bf16(v[bj][1][0], v[bj][1][1]); w.w = cvt_pk_bf16(v[bj][1][2], v[bj][1][3]);
                    *(u32x4*)(rowp + 32 * bj) = w; }
            }
    }
};

__device__ __forceinline__ f32x4 gf_eff(f32x4 g) {
#pragma unroll
    for (int e = 0; e < 4; ++e) g[e] = (__builtin_fabsf(g[e]) < 1e-30f) ? 1e-30f : g[e];
    return g; }
struct EpiOutProj {
    static constexpr bool PERM = true, AFTER_DRAIN = false, MIDSCALE = true; static constexpr int A_AUX = 0;
    const float* x; bf16_t* A3; float* ssq3; PG8_LAS const float* tab;
    __device__ __forceinline__ void midscale(f32x4 (&acc)[2][2][4][2], int wr, int fr, int ui) const {
        PG8_LAS const float* t = tab + (ui & 1) * 1024;
#pragma unroll
        for (int ai = 0; ai < 2; ++ai)
#pragma unroll
            for (int m = 0; m < 4; ++m) { const float f = t[ai * HALF + wr * 64 + m * 16 + fr];
#pragma unroll
                for (int bj = 0; bj < 2; ++bj)
#pragma unroll
                    for (int n = 0; n < 2; ++n) acc[ai][bj][m][n] = acc[ai][bj][m][n] * f; }
    }
    __device__ __forceinline__ void operator()(const f32x4 (&acc)[2][2][4][2], const Unit& u, int wr, int wc, int fr, int fq, int ui) const {
        PG8_LAS const float* t = tab + (ui & 1) * 1024;
        const int col0 = u.pn * BM + wc * 32 + 8 * fq, cl0 = wc * 32 + 8 * fq;
#pragma unroll
        for (int ai = 0; ai < 2; ++ai) {
            f32x4 xv[4][2][2];
#pragma unroll
            for (int m = 0; m < 4; ++m)
#pragma unroll
                for (int bj = 0; bj < 2; ++bj)
#pragma unroll
                    for (int n = 0; n < 2; ++n) xv[m][bj][n] = *(const f32x4*)(x + (size_t)(u.pm * BM + ai * HALF + wr * 64 + m * 16 + fr) * 1024 + col0 + bj * HALF + n * 4);
#pragma unroll
            for (int m = 0; m < 4; ++m) {
                const int rl = ai * HALF + wr * 64 + m * 16 + fr, row = u.pm * BM + rl; float ss = 0.f; const float f2 = t[256 + rl];
#pragma unroll
                for (int bj = 0; bj < 2; ++bj) { u32x4 w;
#pragma unroll
                    for (int n = 0; n < 2; ++n) {
                        const f32x4 gtv = *(PG8_LAS const f32x4*)(t + 512 + cl0 + bj * HALF + n * 4), gfv = *(PG8_LAS const f32x4*)(t + 768 + cl0 + bj * HALF + n * 4);
                        const f32x4 h = xv[m][bj][n] + gtv * (acc[ai][bj][m][n] * f2);
                        ss += (h[0] * h[0] + h[1] * h[1]) + (h[2] * h[2] + h[3] * h[3]);
                        const f32x4 a = h * gfv; if (n == 0) { w.x = cvt_pk_bf16(a[0], a[1]); w.y = cvt_pk_bf16(a[2], a[3]); } else { w.z = cvt_pk_bf16(a[0], a[1]); w.w = cvt_pk_bf16(a[2], a[3]); } }
                    *(u32x4*)(A3 + tiled_off(row, col0 + bj * HALF, 16)) = w; }
                ss += __shfl_xor(ss, 16); ss += __shfl_xor(ss, 32);
                if (fq == 0) ssq3[(size_t)row * 16 + u.pn * 4 + wc] = ss;
            }
        }
    }
};
struct OutProjOrder : StaticOrder {
    const float* ssq2; const float* mod; const float* norm_ffn; PG8_LAS float* tab;
    __device__ __forceinline__ void a_ready(const Unit& u, int ui) const {
        int tid = threadIdx.x; asm volatile("" : "+v"(tid));
        PG8_LAS float* t = tab + (ui & 1) * 1024;
        const int r = tid >> 1, hf = tid & 1;
        const f32x4* sp = (const f32x4*)(ssq2 + ((size_t)u.pm * BM + r) * 16 + hf * 8);
        const f32x4 s0 = sp[0], s1 = sp[1];
        const float ss = ((s0[0] + s0[1]) + (s0[2] + s0[3])) + ((s1[0] + s1[1]) + (s1[2] + s1[3]));
        const float rs = 1.0f / sqrtf(ss * (1.0f / 512.0f) + RMS_EPS);
        const float ro = __shfl_xor(rs, 1);
        if (hf == 0) { t[r] = rs / ro; t[256 + r] = ro; }
        if (tid < 256) { const int b = u.pm >> 4, c = u.pn * BM + tid; t[512 + tid] = mod[b * 6144 + 2 * 1024 + c];
            const float g = norm_ffn[c] * (mod[b * 6144 + 4 * 1024 + c] + 1.0f); t[768 + tid] = (__builtin_fabsf(g) < 1e-30f) ? 1e-30f : g; }
    }
};

struct EpiGateUp {
    static constexpr bool PERM = true, AFTER_DRAIN = false, MIDSCALE = false; static constexpr int A_AUX = 0;
    bf16_t* H; PG8_LAS const float* tab;
    __device__ __forceinline__ void operator()(const f32x4 (&acc)[2][2][4][2], const Unit& u, int wr, int wc, int fr, int fq, int ui) const {
        PG8_LAS const float* t = tab + (ui & 1) * 512;
        f32x4 ba[2], bb[2];
#pragma unroll
        for (int n = 0; n < 2; ++n) { ba[n] = *(PG8_LAS const f32x4*)(t + 256 + wc * 32 + 8 * fq + 4 * n); bb[n] = *(PG8_LAS const f32x4*)(t + 256 + HALF + wc * 32 + 8 * fq + 4 * n); }
        const int hc0 = u.pn * HALF + wc * 32 + 8 * fq;
#pragma unroll
        for (int ai = 0; ai < 2; ++ai)
#pragma unroll
            for (int m = 0; m < 4; ++m) {
                const int rl = ai * HALF + wr * 64 + m * 16 + fr;
                const float rstd = t[rl];
                f32x4 hv[2];
#pragma unroll
                for (int n = 0; n < 2; ++n) { const f32x4 a = acc[ai][0][m][n] * rstd + ba[n], bq = acc[ai][1][m][n] * rstd + bb[n];
                    const f32x4 t = a * (-1.4426950408889634f); f32x4 d;
#pragma unroll
                    for (int e = 0; e < 4; ++e) d[e] = __builtin_amdgcn_exp2f(t[e]);
                    d = d + 1.0f; f32x4 r;
#pragma unroll
                    for (int e = 0; e < 4; ++e) r[e] = __builtin_amdgcn_rcpf(d[e]);
                    hv[n] = (a * bq) * r; }
                u32x4 w; w.x = cvt_pk_bf16(hv[0][0], hv[0][1]); w.y = cvt_pk_bf16(hv[0][2], hv[0][3]); w.z = cvt_pk_bf16(hv[1][0], hv[1][1]); w.w = cvt_pk_bf16(hv[1][2], hv[1][3]);

#ifdef MK_NT_H
                __builtin_nontemporal_store(w, (u32x4*)(H + tiled_off(u.pm * BM + rl, hc0, 44)));
#else
                *(u32x4*)(H + tiled_off(u.pm * BM + rl, hc0, 44)) = w;
#endif

            }
    }
};
__device__ __forceinline__ void pg8_glds16(const void* gsrc, unsigned lds_dst) { unsigned keep;
    asm volatile("s_mov_b32 %0, m0\n\ts_mov_b32 m0, %2\n\ts_nop 0\n\tglobal_load_lds_dwordx4 %1, off\n\ts_mov_b32 m0, %0" : "=&s"(keep) : "v"(gsrc), "s"(lds_dst) : "memory"); }
struct GateUpOrder : StaticOrder {
    const float* rstd3; const float* bias_t; PG8_LAS float* tab;
    __device__ __forceinline__ void a_ready(const Unit& u, int ui) const {
        if (__builtin_amdgcn_readfirstlane((int)threadIdx.x) < 64) {
            int lane = threadIdx.x; asm volatile("" : "+v"(lane));
            const unsigned dst = (unsigned)(uintptr_t)(tab + (ui & 1) * 512);
            pg8_glds16(rstd3 + (size_t)u.pm * BM + 4 * lane, (unsigned)__builtin_amdgcn_readfirstlane(dst));
            pg8_glds16(bias_t + (u.pm >> 4) * 5632 + u.pn * BM + 4 * lane, (unsigned)__builtin_amdgcn_readfirstlane(dst + 1024));
        }
    }
};

#ifndef MK_DOWN_AAUX
#define MK_DOWN_AAUX 0
#endif
struct EpiDown {
    static constexpr bool PERM = true, AFTER_DRAIN = false, MIDSCALE = false; static constexpr int A_AUX = MK_DOWN_AAUX;
    const bf16_t* A3; float* out; PG8_LAS const float* tab;
    __device__ __forceinline__ void operator()(const f32x4 (&acc)[2][2][4][2], const Unit& u, int wr, int wc, int fr, int fq, int ui) const {
        PG8_LAS const float* t = tab + (ui & 1) * 512;
        const int col0 = u.pn * BM + wc * 32 + 8 * fq, cl0 = wc * 32 + 8 * fq;
#pragma unroll
        for (int ai = 0; ai < 2; ++ai) {
            u32x4 hv[4][2];
#pragma unroll
            for (int m = 0; m < 4; ++m)
#pragma unroll
                for (int bj = 0; bj < 2; ++bj) hv[m][bj] = *(const u32x4*)(A3 + tiled_off(u.pm * BM + ai * HALF + wr * 64 + m * 16 + fr, col0 + bj * HALF, 16));
#pragma unroll
            for (int m = 0; m < 4; ++m) {
                const int row = u.pm * BM + ai * HALF + wr * 64 + m * 16 + fr;
#pragma unroll
                for (int bj = 0; bj < 2; ++bj)
#pragma unroll
                    for (int n = 0; n < 2; ++n) { const size_t off = (size_t)row * 1024 + col0 + bj * HALF + n * 4; const unsigned w0 = n ? hv[m][bj].z : hv[m][bj].x, w1 = n ? hv[m][bj].w : hv[m][bj].y;
                        const f32x4 gtv = *(PG8_LAS const f32x4*)(t + cl0 + bj * HALF + n * 4), giv = *(PG8_LAS const f32x4*)(t + 256 + cl0 + bj * HALF + n * 4);
                        const f32x4 h1 = (f32x4){__builtin_bit_cast(float, w0 << 16), __builtin_bit_cast(float, w0 & 0xffff0000u), __builtin_bit_cast(float, w1 << 16), __builtin_bit_cast(float, w1 & 0xffff0000u)} * giv;
                        { const f32x4 ov = h1 + gtv * acc[ai][bj][m][n];
#ifdef MK_NT_OUT
                        __builtin_nontemporal_store(ov, (f32x4*)(out + off));
#else
                        *(f32x4*)(out + off) = ov;
#endif
                        } }
            }
        }
    }
};
struct DownOrder : StaticOrder {
    const float* mod; const float* norm_ffn; PG8_LAS float* tab;
    __device__ __forceinline__ bool next(int i, Unit& u) const { const int nc = c < nwg ? (nwg - 1 - c) / G + 1 : 0; if (i >= nc) return false; return StaticOrder::next(nc - 1 - i, u); }
    __device__ __forceinline__ void a_ready(const Unit& u, int ui) const {
        int tid = threadIdx.x; asm volatile("" : "+v"(tid));
        PG8_LAS float* t = tab + (ui & 1) * 512;
        if (tid < 256) { const int b = u.pm >> 4, c = u.pn * BM + tid; t[tid] = mod[b * 6144 + 5 * 1024 + c];
            const float g = norm_ffn[c] * (mod[b * 6144 + 4 * 1024 + c] + 1.0f); t[256 + tid] = 1.0f / ((__builtin_fabsf(g) < 1e-30f) ? 1e-30f : g); }
    }
};

__device__ __forceinline__ void pg8_glds4_sc1(const void* gsrc, unsigned lds_dst) { unsigned keep;
    asm volatile("s_mov_b32 %0, m0\n\ts_mov_b32 m0, %2\n\ts_nop 0\n\tglobal_load_lds_dword %1, off sc1\n\ts_mov_b32 m0, %0" : "=&s"(keep) : "v"(gsrc), "s"(lds_dst) : "memory"); }
struct InProjOrder {
    StaticOrder so;
    const unsigned* cnt; PG8_LAS unsigned* flagp; int na; unsigned nb;
    __device__ __forceinline__ bool next(int i, Unit& u) const {
        const long L = (long)i * so.G + so.c;
        if (L < so.nwg) return so.next(i, u);
        const long r = L - so.nwg; if (r >= 8) return false;
        u.pm = 128 + (int)r; u.pn = 0; return true;
    }
    __device__ __forceinline__ int stage_of(const Unit& u) const { return (u.pm < 128 && (u.pm & 15) < na) ? 0 : 1; }
    __device__ __forceinline__ void spin(const Unit& u) const {
        const int st = stage_of(u); const unsigned* p = cnt + st; const unsigned want = st ? nb : 256u;
        for (unsigned sp = 0; __hip_atomic_load(p, __ATOMIC_RELAXED, __HIP_MEMORY_SCOPE_AGENT) < want && sp < (1u << 22); ++sp) __builtin_amdgcn_s_sleep(1);
    }
    __device__ __forceinline__ void a_poll(const Unit& u) const {
        if (cnt == nullptr) return;
        if (__builtin_amdgcn_readfirstlane((int)threadIdx.x) < 64) { int lane = threadIdx.x; asm volatile("" : "+v"(lane));
            if (lane == 0) pg8_glds4_sc1(cnt + stage_of(u), (unsigned)__builtin_amdgcn_readfirstlane((unsigned)(uintptr_t)flagp)); }
    }
    __device__ __forceinline__ void a_ready(const Unit& u, int ui) const {
        if (cnt == nullptr) return;
        if (ui == 0) { spin(u); return; }
        const unsigned seen = *(volatile PG8_LAS const unsigned*)flagp;
        if ((unsigned)__builtin_amdgcn_readfirstlane(seen) < (stage_of(u) ? nb : 256u)) spin(u);
    }
    __device__ __forceinline__ void done(const Unit&) const {}
};
template <class Epi, class Sched, bool ALIGN_EPI = false, bool SP2 = false>
__device__ __forceinline__ void gemm_phase(PG8_LAS unsigned char* lds, const Gemm g, const Sched& S, const Epi& E) {
    const int tid = threadIdx.x, wid = __builtin_amdgcn_readfirstlane(tid >> 6), lane = tid & 63, wr = wid >> 2, wc = wid & 3, fr = lane & 15, fq = lane >> 4;
    const int K = g.K, nt = K / BK;
    unsigned voffA[2], voffB[2];
#pragma unroll
    for (int i = 0; i < 2; ++i) { int R, C; stage_rc(tid * 16 + i * 8192, R, C); const int Rb = Epi::PERM ? ((R & ~31) + perm32(R & 31)) : R;
        voffA[i] = (unsigned)(R * BK + C) * 2u; voffB[i] = (unsigned)(Rb * BK + C) * 2u; }
    const size_t kstep = (size_t)(BM * BK * 2);
    const size_t hstep = (size_t)HALF * BK * 2;
    const size_t tstep = (size_t)BM * K * 2;
    const unsigned ldsw = (unsigned)wid * 1024u;
    const int aoff = lds_byte(wr * 64 + fr, fq * 8), boff = lds_byte(wc * 32 + fr, fq * 8);
#define PG8_SA(b, h) (((b) * 2 + (h)) * HTB)
#define PG8_SB(b, h) ((4 + (b) * 2 + (h)) * HTB)
#define PG8_STAGE(bufoff, gbase, voff) do { _Pragma("unroll") for (int _i = 0; _i < 2; ++_i) \
        __builtin_amdgcn_global_load_lds((const unsigned*)((const char*)(gbase) + (voff)[_i]), (PG8_LAS unsigned*)(lds + (bufoff) + ldsw + _i * 8192), 16, 0, 0); } while (0)
#define PG8_STAGE_A(bufoff, gbase, voff) do { _Pragma("unroll") for (int _i = 0; _i < 2; ++_i) \
        __builtin_amdgcn_global_load_lds((const unsigned*)((const char*)(gbase) + (voff)[_i]), (PG8_LAS unsigned*)(lds + (bufoff) + ldsw + _i * 8192), 16, 0, Epi::A_AUX); } while (0)
#define PG8_LDA(dst, b, h) do { _Pragma("unroll") for (int m = 0; m < 4; ++m) _Pragma("unroll") for (int k = 0; k < 2; ++k) dst[m][k] = *(const PG8_LAS bf16x8*)(lds + PG8_SA(b, h) + aoff + m * 2048 + k * 1024); } while (0)
#define PG8_LDB(dst, b, h) do { _Pragma("unroll") for (int n = 0; n < 2; ++n) _Pragma("unroll") for (int k = 0; k < 2; ++k) dst[n][k] = *(const PG8_LAS bf16x8*)(lds + PG8_SB(b, h) + boff + n * 2048 + k * 1024); } while (0)
#define PG8_MMA(ai, bj, At, Bt) do { __builtin_amdgcn_s_setprio(1); _Pragma("unroll") for (int m = 0; m < 4; ++m) _Pragma("unroll") for (int n = 0; n < 2; ++n) _Pragma("unroll") for (int k = 0; k < 2; ++k) \
        acc[ai][bj][m][n] = __builtin_amdgcn_mfma_f32_16x16x32_bf16(Bt[n][k], At[m][k], acc[ai][bj][m][n], 0, 0, 0); __builtin_amdgcn_s_setprio(0); } while (0)
#define PG8_WAIT_V(n) asm volatile("s_waitcnt vmcnt(" #n ")" ::: "memory")
#define PG8_WAIT_L(n) asm volatile("s_waitcnt lgkmcnt(" #n ")" ::: "memory")
#define PG8_BAR __builtin_amdgcn_s_barrier()
#define PG8_SCHED __builtin_amdgcn_sched_barrier(0)
    Unit cur, nxt; int ui = 0;
    if (!S.next(0, cur)) return;
    f32x4 acc[2][2][4][2];
#pragma unroll
    for (int a = 0; a < 2; ++a)
#pragma unroll
        for (int b = 0; b < 2; ++b)
#pragma unroll
            for (int m = 0; m < 4; ++m)
#pragma unroll
                for (int n = 0; n < 2; ++n) acc[a][b][m][n] = (f32x4){0.f, 0.f, 0.f, 0.f};
    bf16x8 At[4][2], B0[2][2], B1[2][2];
    const char* cA = (const char*)g.A + (size_t)cur.pm * tstep; const char* cB = (const char*)g.Bt + (size_t)cur.pn * tstep;
    S.a_ready(cur, 0);
    if constexpr (SP2) {
        PG8_STAGE(PG8_SB(0, 0), cB, voffB); PG8_STAGE(PG8_SB(0, 1), cB + hstep, voffB); PG8_STAGE_A(PG8_SA(0, 0), cA, voffA); PG8_STAGE_A(PG8_SA(0, 1), cA + hstep, voffA);
        if (wr == 1) PG8_BAR;
        PG8_WAIT_V(2); PG8_BAR;
        PG8_STAGE(PG8_SB(1, 0), cB + kstep, voffB); PG8_STAGE_A(PG8_SA(1, 0), cA + kstep, voffA); PG8_STAGE(PG8_SB(1, 1), cB + hstep + kstep, voffB);
        PG8_WAIT_V(6); PG8_BAR;
    } else {
        PG8_STAGE(PG8_SB(0, 0), cB, voffB); PG8_STAGE_A(PG8_SA(0, 0), cA, voffA); PG8_STAGE(PG8_SB(0, 1), cB + hstep, voffB); PG8_STAGE_A(PG8_SA(0, 1), cA + hstep, voffA);
        if (wr == 1) PG8_BAR;
        PG8_WAIT_V(4); PG8_BAR;
        PG8_STAGE(PG8_SB(1, 0), cB + kstep, voffB); PG8_STAGE_A(PG8_SA(1, 0), cA + kstep, voffA); PG8_STAGE(PG8_SB(1, 1), cB + hstep + kstep, voffB);
        PG8_WAIT_V(6); PG8_BAR;
    }
    for (;;) {
        const bool has_next = S.next(ui + 1, nxt);
        const char* nA = has_next ? (const char*)g.A + (size_t)nxt.pm * tstep : cA; const char* nB = has_next ? (const char*)g.Bt + (size_t)nxt.pn * tstep : cB;
        for (int t = 0; t < nt; t += 2) {
            if constexpr (Epi::MIDSCALE) { if (t == (nt >> 1)) E.midscale(acc, wr, fr, ui); }
            if (t == nt - 4 && has_next) S.a_poll(nxt);
            const bool last = (t == nt - 2);
            const char* a1 = cA + (size_t)(t + 1) * kstep;
            const char* a2 = last ? nA : cA + (size_t)(t + 2) * kstep; const char* b2 = last ? nB : cB + (size_t)(t + 2) * kstep;
            const char* a3 = a2 + kstep; const char* b3 = b2 + kstep;
            if (last && has_next) { S.a_ready(nxt, ui + 1);
#ifdef MK_HOOK_TWICE
            S.a_ready(nxt, ui + 1);
#endif
            }
            if constexpr (SP2) {
            PG8_LDB(B0, 0, 0); PG8_LDB(B1, 0, 1); PG8_SCHED; PG8_LDA(At, 0, 0); PG8_STAGE_A(PG8_SA(1, 1), a1 + hstep, voffA);
            PG8_WAIT_V(8); PG8_WAIT_L(0); PG8_BAR; PG8_MMA(0, 0, At, B0); PG8_MMA(0, 1, At, B1); PG8_BAR; PG8_SCHED;
            PG8_LDA(At, 0, 1); PG8_STAGE(PG8_SB(0, 0), b2, voffB); PG8_STAGE(PG8_SB(0, 1), b2 + hstep, voffB); PG8_STAGE_A(PG8_SA(0, 0), a2, voffA);
            PG8_WAIT_V(8); PG8_WAIT_L(0); PG8_BAR; PG8_MMA(1, 0, At, B0); PG8_MMA(1, 1, At, B1); PG8_BAR; PG8_SCHED;
            PG8_LDB(B0, 1, 0); PG8_LDB(B1, 1, 1); PG8_SCHED; PG8_LDA(At, 1, 0); PG8_STAGE_A(PG8_SA(0, 1), a2 + hstep, voffA);
            PG8_WAIT_V(8); PG8_WAIT_L(0); PG8_BAR; PG8_MMA(0, 0, At, B0); PG8_MMA(0, 1, At, B1); PG8_BAR; PG8_SCHED;
            PG8_LDA(At, 1, 1); PG8_STAGE(PG8_SB(1, 0), b3, voffB); PG8_STAGE(PG8_SB(1, 1), b3 + hstep, voffB); PG8_STAGE_A(PG8_SA(1, 0), a3, voffA);
            PG8_WAIT_V(8); PG8_WAIT_L(0); PG8_BAR; PG8_MMA(1, 0, At, B0); PG8_MMA(1, 1, At, B1); PG8_BAR; PG8_SCHED;
            } else {
            PG8_LDB(B0, 0, 0); PG8_SCHED; PG8_LDA(At, 0, 0); PG8_STAGE_A(PG8_SA(1, 1), a1 + hstep, voffA);
            PG8_WAIT_L(8); PG8_BAR; PG8_WAIT_L(0); PG8_MMA(0, 0, At, B0); PG8_BAR; PG8_SCHED;
            PG8_LDB(B1, 0, 1); PG8_STAGE(PG8_SB(0, 0), b2, voffB);
            PG8_BAR; PG8_WAIT_L(0); PG8_MMA(0, 1, At, B1); PG8_BAR;
            PG8_LDA(At, 0, 1); PG8_STAGE_A(PG8_SA(0, 0), a2, voffA);
            PG8_BAR; PG8_WAIT_L(0); PG8_MMA(1, 0, At, B0); PG8_BAR; PG8_SCHED;
            PG8_STAGE(PG8_SB(0, 1), b2 + hstep, voffB);
            PG8_WAIT_V(6); PG8_BAR; PG8_MMA(1, 1, At, B1); PG8_BAR;
            PG8_LDB(B0, 1, 0); PG8_SCHED; PG8_LDA(At, 1, 0); PG8_STAGE_A(PG8_SA(0, 1), a2 + hstep, voffA);
            PG8_WAIT_L(8); PG8_BAR; PG8_WAIT_L(0); PG8_MMA(0, 0, At, B0); PG8_BAR; PG8_SCHED;
            PG8_LDB(B1, 1, 1); PG8_STAGE(PG8_SB(1, 0), b3, voffB);
            PG8_BAR; PG8_WAIT_L(0); PG8_MMA(0, 1, At, B1); PG8_BAR;
            PG8_LDA(At, 1, 1); PG8_STAGE_A(PG8_SA(1, 0), a3, voffA);
            PG8_BAR; PG8_WAIT_L(0); PG8_MMA(1, 0, At, B0); PG8_BAR; PG8_SCHED;
            PG8_STAGE(PG8_SB(1, 1), b3 + hstep, voffB);
            PG8_WAIT_V(6); PG8_BAR; PG8_MMA(1, 1, At, B1); PG8_BAR;
            }
        }
        if constexpr (ALIGN_EPI) { if (wr == 0) PG8_BAR; }
        if constexpr (!Epi::AFTER_DRAIN) { E(acc, cur, wr, wc, fr, fq, ui); S.done(cur); }
        if (!has_next) break;
#pragma unroll
        for (int a = 0; a < 2; ++a)
#pragma unroll
            for (int b = 0; b < 2; ++b)
#pragma unroll
                for (int m = 0; m < 4; ++m)
#pragma unroll
                    for (int n = 0; n < 2; ++n) acc[a][b][m][n] = (f32x4){0.f, 0.f, 0.f, 0.f};
        cur = nxt; cA = nA; cB = nB; ++ui;
        if constexpr (ALIGN_EPI) { if (wr == 1) PG8_BAR; }
    }
    PG8_WAIT_V(0);
    if constexpr (!ALIGN_EPI) { if (wr == 0) PG8_BAR; }
    PG8_BAR;
    if constexpr (Epi::AFTER_DRAIN) { E.fused(acc, cur, wr, wc, fr, fq, lds, wid, lane); S.done(cur); }
#undef PG8_SA
#undef PG8_SB
#undef PG8_STAGE
#undef PG8_STAGE_A
#undef PG8_LDA
#undef PG8_LDB
#undef PG8_MMA
#undef PG8_WAIT_V
#undef PG8_WAIT_L
#undef PG8_BAR
#undef PG8_SCHED
}
}
constexpr int NWAVES = 8;
#ifndef MK_CUTS
#define MK_CUTS 0
#endif
constexpr int N_PHASES = 7;

constexpr int BATCH = 8, SEQ = 4096, DM = 1024, CTXL = 256;
constexpr int MROWS = BATCH * SEQ;
constexpr int CROWS = BATCH * CTXL;
constexpr int INW = 1792, FFH = 2816, NMOD = 6 * DM;
constexpr float LOG2E = 1.4426950408889634f;

constexpr size_t MiB = 1u << 20;
constexpr size_t WS_CTL = 0, CTL_ZERO_BYTES = 128 * 1024;
constexpr size_t WS_MOD = 1 * MiB;
constexpr size_t WS_ROPE = WS_MOD + 256 * 1024;
constexpr size_t WS_BIAS = WS_ROPE + 64 * 1024;
constexpr size_t WS_SSQ3 = 2 * MiB;
constexpr size_t WS_WIN = 4 * MiB, WS_WOUT = 8 * MiB, WS_WGU = 10 * MiB, WS_WDN = 21 * MiB;
constexpr size_t WS_SSQ2 = 27 * MiB;
constexpr size_t WS_WSP = 29 * MiB;
constexpr size_t WS_RSTD3 = 30 * MiB;
constexpr size_t WS_XN = 32 * MiB;
constexpr size_t WS_A2 = WS_XN;
constexpr size_t WS_Y = 100 * MiB;
constexpr size_t WS_YC = 212 * MiB;
constexpr size_t WS_A3 = 216 * MiB;
constexpr size_t WS_H = 280 * MiB;
constexpr size_t WS_KV = 456 * MiB;
constexpr size_t WS_END = 472 * MiB;
static_assert(WS_BIAS + 8 * 5632 * 4 <= WS_SSQ3 && WS_WDN + (size_t)1024 * 2816 * 2 <= WS_SSQ2 && WS_SSQ2 + 2 * MiB <= WS_WSP && WS_WSP + 262144 <= WS_XN && WS_XN + (size_t)34816 * 2048 <= WS_Y && WS_Y + (size_t)MROWS * INW * 2 <= WS_YC && WS_YC + (size_t)CROWS * 512 <= WS_A3 && WS_A3 + (size_t)MROWS * 2048 <= WS_H && WS_H + (size_t)MROWS * FFH * 2 <= WS_END, "d_ws map");
constexpr int CW_TMO = 0, CW_CODE = 1;
constexpr int CW_BIASF = 28800;
constexpr int CW_RT = 28928;
constexpr int CW_BAR = 4096;

constexpr int RING_OFF = 0, RING_BYTES = 131072;
constexpr int LDSCTL_OFF = RING_BYTES, MISC_OFF = LDSCTL_OFF + 320;
constexpr int LDS_BYTES = 147456;

#define GAS __attribute__((address_space(1)))
#define LAS __attribute__((address_space(3)))
typedef unsigned short bf16;
typedef unsigned v4u __attribute__((ext_vector_type(4)));
typedef float f32x4 __attribute__((ext_vector_type(4)));
typedef short bf16x8 __attribute__((ext_vector_type(8)));
typedef GAS unsigned gu32;
typedef GAS unsigned long long gu64;
#define RLX_AGENT __ATOMIC_RELAXED, __HIP_MEMORY_SCOPE_AGENT
#define LDS_WAIT() asm volatile("s_waitcnt lgkmcnt(0)" ::: "memory")
#define VM_WAIT() asm volatile("s_waitcnt vmcnt(0)" ::: "memory")
__device__ __forceinline__ unsigned long long rt() { return __builtin_amdgcn_s_memrealtime(); }
__device__ __forceinline__ unsigned f2bf(float f) { unsigned u = __builtin_bit_cast(unsigned, f); return (u + 0x7fffu + ((u >> 16) & 1u)) >> 16; }
__device__ __forceinline__ unsigned pk2(float lo, float hi) { return f2bf(lo) | (f2bf(hi) << 16); }
#define XB_TMO      128
#define XB_XCNT(j)  (256  + 64 * (j))
#define XB_XSUB(j)  (1280 + 64 * (j))
#define XB_XGEN(j)  (2304 + 64 * (j))
#define XB_TOP      3328
#define XB_TOPGEN   3392
#define XCD_BAR_WORDS 3456
#define XB_SPIN_CAP (1u << 22)

__device__ __forceinline__ unsigned xb_ld(unsigned* p)              { return __hip_atomic_load(p, __ATOMIC_RELAXED, __HIP_MEMORY_SCOPE_AGENT); }
__device__ __forceinline__ unsigned xb_add(unsigned* p, unsigned v) { return __hip_atomic_fetch_add(p, v, __ATOMIC_RELAXED, __HIP_MEMORY_SCOPE_AGENT); }
__device__ __forceinline__ unsigned xb_xcc_id() { return (unsigned)__builtin_amdgcn_s_getreg((3 << 11) | 20) & 0xFu; }
#define XB_SPIN(cond, bar) do { unsigned _sp = 0; while (cond) { __builtin_amdgcn_s_sleep(1); \
    if ((++_sp & 255u) == 0u) { if (xb_ld(&(bar)[XB_TMO])) break; if (_sp > XB_SPIN_CAP) { atomicAdd(&(bar)[XB_TMO], 1u); break; } } } } while (0)

struct XcdBarrier {
    unsigned* bar; unsigned x;
    volatile LAS unsigned* st;
};

__device__ __forceinline__ XcdBarrier xcd_barrier_post(unsigned* bar, volatile LAS unsigned* st) {
    XcdBarrier b; b.bar = bar; b.x = xb_xcc_id(); b.st = st;
    if (threadIdx.x == 0) st[3] = xb_add(&bar[XB_XCNT(b.x)], 1u);
    return b;
}
__device__ __forceinline__ void xcd_barrier_complete(unsigned* bar, unsigned x, unsigned& nloc, unsigned& nx, unsigned& uni) {
    const unsigned G = gridDim.x * gridDim.y * gridDim.z;
    unsigned sum, cnt, mine, even, sp = 0u;
    for (;;) {
        sum = 0u; cnt = 0u; mine = 0u; even = 1u;
#pragma unroll
        for (unsigned j = 0; j < 16; ++j) { const unsigned c = xb_ld(&bar[XB_XCNT(j)]); sum += c; cnt += (c > 0u) ? 1u : 0u; mine = (j == x) ? c : mine; even &= (c == ((j < 8u) ? (G >> 3) : 0u)) ? 1u : 0u; }
        if (sum == G) break;
        __builtin_amdgcn_s_sleep(1);
        if ((++sp & 255u) == 0u) { if (xb_ld(&bar[XB_TMO])) break; if (sp > XB_SPIN_CAP) { atomicAdd(&bar[XB_TMO], 1u); break; } }
    }
    nloc = mine > 0u ? mine : 1u; nx = cnt > 0u ? cnt : 1u; uni = (sum == G && (G & 7u) == 0u && even) ? 1u : 2u;
}

__device__ __forceinline__ void xcd_barrier(const XcdBarrier& b, bool local = false) {
    asm volatile("s_waitcnt vmcnt(0)" ::: "memory");
    __syncthreads();
    if (threadIdx.x == 0) {
        unsigned* bar = b.bar;
        __builtin_amdgcn_s_waitcnt(0);
        unsigned nloc = b.st[0], nx = b.st[1];
        if (nloc == 0u) { unsigned uni; xcd_barrier_complete(bar, b.x, nloc, nx, uni); b.st[0] = nloc; b.st[1] = nx; b.st[2] = uni; }
        const unsigned old = xb_add(&bar[XB_XSUB(b.x)], 1u);
        const unsigned gen = old / nloc;
        if (old + 1u == (gen + 1u) * nloc && local) {
            __builtin_amdgcn_fence(__ATOMIC_ACQUIRE, "agent");
            xb_add(&bar[XB_XGEN(b.x)], 1u);
            asm volatile("s_waitcnt vmcnt(0)" ::: "memory");
        } else if (old + 1u == (gen + 1u) * nloc) {
            __builtin_amdgcn_fence(__ATOMIC_RELEASE, "agent");
            asm volatile("s_waitcnt vmcnt(0)" ::: "memory");
            const unsigned og = xb_add(&bar[XB_TOP], 1u);
            const unsigned tg = og / nx;
            if (og + 1u == (tg + 1u) * nx) xb_add(&bar[XB_TOPGEN], 1u);
            else XB_SPIN(xb_ld(&bar[XB_TOPGEN]) == tg, bar);
            __builtin_amdgcn_fence(__ATOMIC_ACQUIRE, "agent");
            xb_add(&bar[XB_XGEN(b.x)], 1u);
            asm volatile("s_waitcnt vmcnt(0)" ::: "memory");
        } else {
            XB_SPIN(xb_ld(&bar[XB_XGEN(b.x)]) == gen, bar);
            __builtin_amdgcn_fence(__ATOMIC_ACQUIRE, "agent");
            asm volatile("s_waitcnt vmcnt(0)" ::: "memory");
        }
    }
    __syncthreads();
}
struct Frame {
    LAS unsigned char* lds;
    volatile LAS unsigned* MISC;
    gu32* ctl;
    int tid, lane, wave;
    int vcu, G, cid, xcc, uni;
    const float *x, *c, *ctx, *c_ctx, *w_mod, *b_mod, *norm_mix, *norm_ffn, *w_in, *q_gain, *k_gain, *attn_sink, *gate_gain, *w_spatial, *b_spatial, *attn_out_gain, *mlp_out_gain, *w_out, *w_gate_up, *w_down;
    float* out;
    float *mod, *rope, *bias_t, *ssq3, *ssq2, *rstd3;
    bf16 *Win_t, *Wout_t, *Wgu_t, *Wdn_t, *XN, *Y, *Yc, *H, *A2, *A3, *Wsp, *KV;
};
__device__ __forceinline__ float bf2f(unsigned h) { return __builtin_bit_cast(float, h << 16); }
__device__ __forceinline__ float wave_sum(float v) {
#pragma unroll
    for (int o = 1; o < 64; o <<= 1) v += __shfl_xor(v, o);
    return v;
}
__device__ __forceinline__ float wave_max(float v) {
#pragma unroll
    for (int o = 1; o < 64; o <<= 1) v = fmaxf(v, __shfl_xor(v, o));
    return v;
}

__device__ __forceinline__ int dst_row(int mat, int n) {
    if (mat == 0) {
        const int head = n >> 6, d = n & 63, bj = d >> 5, l = d & 31;
        const bool rp = head < 2 || (head >= 4 && head < 12);
        const int p = rp ? (8 * ((l >> 2) & 3) + 4 * (l >> 4) + (l & 3)) : l;
        return 256 * (head >> 2) + 128 * bj + 32 * (head & 3) + p;
    }
    if (mat == 2) { const int bj = n >= FFH ? 1 : 0, j = n - FFH * bj; return 256 * (j >> 7) + 128 * bj + (j & 127); }
    return n;
}
__device__ __forceinline__ void p0_transpose_item(const float* W, int K, int N, bf16* WT, int mat, const float* g0, const float* g1, LAS float* scr, int item, int lane) {
    const int nblk = N / 32, kb = item / nblk, nb = item % nblk, k0 = 64 * kb, n0 = 32 * nb;
    const unsigned loff = (unsigned)((lane >> 5) * N + (lane & 31)); const float* wb = W + (size_t)k0 * N + n0;
#pragma unroll
    for (int i0 = 0; i0 < 32; i0 += 16) {
        float v[16];
#pragma unroll
        for (int i = 0; i < 16; ++i) v[i] = __builtin_nontemporal_load(wb + (size_t)(2 * (i0 + i)) * N + loff);
        __builtin_amdgcn_sched_barrier(0);
#pragma unroll
        for (int i = 0; i < 16; ++i) scr[(2 * (i0 + i) + (lane >> 5)) * 33 + (lane & 31)] = v[i];
        __builtin_amdgcn_sched_barrier(0);
    }
    LDS_WAIT(); asm volatile("" ::: "memory");
    const int c = lane & 7;
    float gk[8];
#pragma unroll
    for (int i = 0; i < 8; ++i) { const int k = k0 + 8 * c + i; gk[i] = (mat == 1) ? (k < 512 ? g0[k] : g1[k - 512]) : 1.0f; }
#pragma unroll
    for (int j = 0; j < 4; ++j) { const int n = (lane >> 3) + 8 * j; const LAS float* s = scr + (8 * c) * 33 + n;
        v4u o; o.x = pk2(s[0 * 33] * gk[0], s[1 * 33] * gk[1]); o.y = pk2(s[2 * 33] * gk[2], s[3 * 33] * gk[3]); o.z = pk2(s[4 * 33] * gk[4], s[5 * 33] * gk[5]); o.w = pk2(s[6 * 33] * gk[6], s[7 * 33] * gk[7]);
        *(GAS v4u*)(WT + pg8::tiled_off(dst_row(mat, n0 + n), k0 + 8 * c, K / 64)) = o; }
    LDS_WAIT(); asm volatile("" ::: "memory");
}
__device__ __forceinline__ void p0_prologue(Frame& F) {
#ifdef MK_P0A_TWICE
    for (int repa = 0; repa < 2; ++repa)
#endif
    if (F.vcu < NMOD / 32) {
        LAS float* sc = (LAS float*)(F.lds);
        LAS float* red = (LAS float*)(F.lds + 36864);
        { float cv[18];
#pragma unroll
          for (int j = 0; j < 18; ++j) { const int k = 512 * (j & 1) + F.tid; cv[j] = (j < 16) ? F.c[(j >> 1) * DM + k] : F.c_ctx[k]; }
          __builtin_amdgcn_sched_barrier(0);
#pragma unroll
          for (int j = 0; j < 18; ++j) { const float v = cv[j]; sc[512 * j + F.tid] = v / (1.0f + __expf(-v)); } }
        __syncthreads();
        for (int item = F.vcu; item < NMOD / 32; item += F.G) {
            const int kg = F.tid >> 5; const unsigned loff = (unsigned)(kg * NMOD + (F.tid & 31));
            const float* wb = F.w_mod + item * 32;
            float a[9];
#pragma unroll
            for (int n = 0; n < 9; ++n) a[n] = 0.f;
#pragma unroll
            for (int i0 = 0; i0 < DM / 16; i0 += 16) {
                float w[16];
#pragma unroll
                for (int i = 0; i < 16; ++i) w[i] = __builtin_nontemporal_load(wb + (size_t)(i0 + i) * 16 * NMOD + loff);
                __builtin_amdgcn_sched_barrier(0);
#pragma unroll
                for (int i = 0; i < 16; ++i) { const int k = 16 * (i0 + i) + kg;
#pragma unroll
                    for (int n = 0; n < 9; ++n) a[n] += sc[n * DM + k] * w[i]; }
                __builtin_amdgcn_sched_barrier(0);
            }
#pragma unroll
            for (int n = 0; n < 9; ++n) red[(kg * 9 + n) * 32 + (F.tid & 31)] = a[n];
            __syncthreads();
            if (F.tid < 288) { const int n = F.tid >> 5, cc = F.tid & 31; float s = 0.f;
#pragma unroll
                for (int g = 0; g < 16; ++g) s += red[(g * 9 + n) * 32 + cc];
                F.mod[n * NMOD + item * 32 + cc] = s + F.b_mod[item * 32 + cc]; }
            __syncthreads();
        }
    }
    { const int gt = F.vcu * NWAVES * 64 + F.tid;
      if (gt < 1024) { const int pos = gt >> 4, f = gt & 15; const float inv = powf(10000.0f, -(float)(2 * f) / 32.0f); const float ang = (float)pos * inv; F.rope[2 * gt] = cosf(ang); F.rope[2 * gt + 1] = sinf(ang); } }
    for (int it = F.vcu * NWAVES * 64 + F.tid; it < 8 * 128 * 16; it += F.G * NWAVES * 64) {
        const int hp = it >> 4, ks = (it >> 1) & 7, hi = it & 1;
        const float* srcp = F.w_spatial + (size_t)hp * 128 + 16 * ks + 4 * hi;
        const f32x4 a0 = *(const f32x4*)srcp, a1 = *(const f32x4*)(srcp + 8);
        v4u o; o.x = pk2(a0[0], a0[1]); o.y = pk2(a0[2], a0[3]); o.z = pk2(a1[0], a1[1]); o.w = pk2(a1[2], a1[3]);
        *(GAS v4u*)(F.Wsp + (size_t)hp * 128 + 16 * ks + 8 * hi) = o; }
    __syncthreads();
    LAS float* scr = (LAS float*)(F.lds + RING_OFF + F.wave * 16384);
    const int gw = F.vcu * NWAVES + F.wave, NGW = F.G * NWAVES;
    constexpr int I_IN = (DM / 64) * (INW / 32), I_OUT = (DM / 64) * (DM / 32), I_GU = (DM / 64) * (2 * FFH / 32), I_DN = (FFH / 64) * (DM / 32);
    constexpr int NITEMS = I_IN + I_OUT + I_GU + I_DN;
#ifdef MK_P0C_TWICE
    for (int repc = 0; repc < 2; ++repc)
#endif
    for (int it = gw; it < NITEMS; it += NGW) {
        int r = it;
        if (r < I_IN) { p0_transpose_item(F.w_in, DM, INW, F.Win_t, 0, nullptr, nullptr, scr, r, F.lane); continue; } r -= I_IN;
        if (r < I_OUT) { p0_transpose_item(F.w_out, DM, DM, F.Wout_t, 1, F.attn_out_gain, F.mlp_out_gain, scr, r, F.lane); continue; } r -= I_OUT;
        if (r < I_GU) { p0_transpose_item(F.w_gate_up, DM, 2 * FFH, F.Wgu_t, 2, nullptr, nullptr, scr, r, F.lane); continue; } r -= I_GU;
        p0_transpose_item(F.w_down, FFH, DM, F.Wdn_t, 3, nullptr, nullptr, scr, r, F.lane);
    }
}
#ifndef MK_NA
#define MK_NA 14
#endif
constexpr int P12_NA = MK_NA;
constexpr int P12_RANK_L = 17, P12_NWL = (32 - P12_RANK_L) * NWAVES;
constexpr int P12_NB = (17 - P12_NA) * 256;
__device__ __forceinline__ void p1_two_rows(Frame& F, int r0, int r1, bool has1) {
    const float* src0 = r0 < MROWS ? F.x + (size_t)r0 * DM : F.ctx + (size_t)(r0 - MROWS) * DM;
    const float* src1 = r1 < MROWS ? F.x + (size_t)r1 * DM : F.ctx + (size_t)(r1 - MROWS) * DM;
    f32x4 v0[4], v1[4]; float s0 = 0.f, s1 = 0.f;
#pragma unroll
    for (int j = 0; j < 4; ++j) { v0[j] = __builtin_nontemporal_load((const GAS f32x4*)src0 + F.lane + 64 * j); v1[j] = __builtin_nontemporal_load((const GAS f32x4*)src1 + F.lane + 64 * j); }
#pragma unroll
    for (int j = 0; j < 4; ++j) { s0 += (v0[j].x * v0[j].x + v0[j].y * v0[j].y) + (v0[j].z * v0[j].z + v0[j].w * v0[j].w); s1 += (v1[j].x * v1[j].x + v1[j].y * v1[j].y) + (v1[j].z * v1[j].z + v1[j].w * v1[j].w); }
    const float rstd0 = 1.0f / sqrtf(wave_sum(s0) * (1.0f / DM) + 1e-6f), rstd1 = 1.0f / sqrtf(wave_sum(s1) * (1.0f / DM) + 1e-6f);
#pragma unroll
    for (int rr = 0; rr < 2; ++rr) { if (rr == 1 && !has1) break;
        const int r = rr ? r1 : r0; const float rstd = rr ? rstd1 : rstd0;
        const float* md = F.mod + (r < MROWS ? (r >> 12) : 8) * NMOD;
#pragma unroll
        for (int j = 0; j < 4; ++j) { const int cidx = 4 * F.lane + 256 * j;
            const f32x4 g = *(const f32x4*)(F.norm_mix + cidx), sh = *(const f32x4*)(md + cidx), sc = *(const f32x4*)(md + DM + cidx);
            const f32x4 y = ((rr ? v1[j] : v0[j]) * rstd) * g * (sc + 1.0f) + sh;
            *(GAS unsigned long long*)(F.XN + pg8::tiled_off(r, cidx, 16)) = (unsigned long long)pk2(y.x, y.y) | ((unsigned long long)pk2(y.z, y.w) << 32); } }
}
__device__ __forceinline__ void p1_norm_rows(Frame& F) {
    const int gw = F.vcu * NWAVES + F.wave, NGW = F.G * NWAVES;
    if (F.uni) {
        const int rank = F.vcu & 31, wl = rank * NWAVES + F.wave;
        unsigned* cnt = (unsigned*)F.ctl + CW_RT + F.xcc * 32;
#pragma unroll 1
        for (int k0 = 0; k0 < P12_NA; k0 += 2) { const bool has1 = k0 + 1 < P12_NA; p1_two_rows(F, F.xcc * SEQ + wl + 256 * k0, F.xcc * SEQ + wl + 256 * (has1 ? k0 + 1 : k0), has1); }
        asm volatile("s_waitcnt vmcnt(0)" ::: "memory");
        if (F.lane == 0) __hip_atomic_fetch_add(cnt, 1u, __ATOMIC_RELAXED, __HIP_MEMORY_SCOPE_AGENT);
        if (rank >= P12_RANK_L) {
            const int wlL = (rank - P12_RANK_L) * NWAVES + F.wave;
#pragma unroll 1
            for (int j0 = wlL; j0 < P12_NB; j0 += 2 * P12_NWL) {
                const int j1 = j0 + P12_NWL; const bool has1 = j1 < P12_NB; const int jc = has1 ? j1 : j0;
                const int r0 = j0 < (16 - P12_NA) * 256 ? F.xcc * SEQ + P12_NA * 256 + j0 : MROWS + F.xcc * CTXL + (j0 - (16 - P12_NA) * 256);
                const int r1 = jc < (16 - P12_NA) * 256 ? F.xcc * SEQ + P12_NA * 256 + jc : MROWS + F.xcc * CTXL + (jc - (16 - P12_NA) * 256);
                p1_two_rows(F, r0, r1, has1);
            }
            asm volatile("s_waitcnt vmcnt(0)" ::: "memory");
            if (F.lane == 0) __hip_atomic_fetch_add(cnt + 1, 1u, __ATOMIC_RELAXED, __HIP_MEMORY_SCOPE_AGENT);
        }
    } else {
        const int nk = (MROWS + CROWS - gw + NGW - 1) / NGW;
#pragma unroll 1
        for (int k0 = 0; k0 < nk; k0 += 2) { const bool has1 = k0 + 1 < nk; p1_two_rows(F, gw + NGW * k0, has1 ? gw + NGW * (k0 + 1) : gw + NGW * k0, has1); }
    }
#ifdef MK_BIAS_TWICE
    for (int brep = 0; brep < 2; ++brep)
#endif
#pragma unroll 1
    for (int R0 = gw; R0 < 2 * FFH; R0 += 3 * NGW) {
        v4u w0[3], w1[3]; f32x4 shv[BATCH][4];
#pragma unroll
        for (int k = 0; k < 3; ++k) { const int R = R0 + NGW * k, Rc = R < 2 * FFH ? R : R0;
            w0[k] = *(const GAS v4u*)(F.Wgu_t + pg8::tiled_off(Rc, 16 * F.lane, 16)); w1[k] = *(const GAS v4u*)(F.Wgu_t + pg8::tiled_off(Rc, 16 * F.lane, 16) + 8); }
#pragma unroll
        for (int b = 0; b < BATCH; ++b)
#pragma unroll
            for (int i = 0; i < 4; ++i) shv[b][i] = *(const f32x4*)(F.mod + b * NMOD + 3 * DM + 16 * F.lane + 4 * i);
        __builtin_amdgcn_sched_barrier(0);
#pragma unroll
        for (int k = 0; k < 3; ++k) { float wf[16]; const int R = R0 + NGW * k;
#pragma unroll
            for (int i = 0; i < 4; ++i) { wf[2 * i] = bf2f(w0[k][i] & 0xffffu); wf[2 * i + 1] = bf2f(w0[k][i] >> 16); wf[8 + 2 * i] = bf2f(w1[k][i] & 0xffffu); wf[8 + 2 * i + 1] = bf2f(w1[k][i] >> 16); }
            float s[BATCH];
#pragma unroll
            for (int b = 0; b < BATCH; ++b) { s[b] = 0.f;
#pragma unroll
                for (int i = 0; i < 4; ++i) { const f32x4 t = shv[b][i]; s[b] += (t[0] * wf[4 * i] + t[1] * wf[4 * i + 1]) + (t[2] * wf[4 * i + 2] + t[3] * wf[4 * i + 3]); } }
#pragma unroll
            for (int o = 1; o < 64; o <<= 1) {
#pragma unroll
                for (int b = 0; b < BATCH; ++b) s[b] += __shfl_xor(s[b], o); }
            if (F.lane == 0 && R < 2 * FFH) {
#pragma unroll
                for (int b = 0; b < BATCH; ++b) __hip_atomic_store(F.bias_t + b * 2 * FFH + R, s[b], __ATOMIC_RELAXED, __HIP_MEMORY_SCOPE_AGENT); } }
    }
    asm volatile("s_waitcnt vmcnt(0)" ::: "memory");
    if (F.lane == 0) __hip_atomic_fetch_add((unsigned*)F.ctl + CW_BIASF, 1u, __ATOMIC_RELAXED, __HIP_MEMORY_SCOPE_AGENT);
}

namespace mix {
typedef short bf16x8 __attribute__((ext_vector_type(8)));
typedef short s16x4 __attribute__((ext_vector_type(4)));
typedef float f32x16 __attribute__((ext_vector_type(16)));
typedef LAS const char* lcp;
constexpr int SLOT = 32768;
constexpr int L_OST = 98304, L_WSF = LDSCTL_OFF + 1024;
constexpr int L_GT = 0;
__device__ __forceinline__ int crow(int r, int hi) { return (r & 3) + 8 * (r >> 2) + 4 * hi; }
__device__ __forceinline__ void glds16(const void* gsrc, unsigned lds_dst) { unsigned keep;
    asm volatile("s_mov_b32 %0, m0\n\ts_mov_b32 m0, %2\n\ts_nop 0\n\tglobal_load_lds_dwordx4 %1, off\n\ts_mov_b32 m0, %0" : "=&s"(keep) : "v"(gsrc), "s"(lds_dst) : "memory"); }
typedef float f32x2_t __attribute__((ext_vector_type(2))); typedef __bf16 bf16x2_t __attribute__((ext_vector_type(2)));
__device__ __forceinline__ unsigned cvtpk_s(float lo, float hi) { f32x2_t v = {lo, hi}; bf16x2_t b = __builtin_convertvector(v, bf16x2_t); return __builtin_bit_cast(unsigned, b); }
#define MIX_SBAR() __builtin_amdgcn_sched_barrier(0)
#define MIX_WAIT_BAR() asm volatile("s_waitcnt vmcnt(0) lgkmcnt(0)\n\ts_barrier" ::: "memory")
__device__ __forceinline__ void qkt(f32x16& p0, f32x16& p1, lcp Kslot, const bf16x8* qr, int r32, int hi) {
    lcp kb = Kslot + hi * 1024 + r32 * 16;
    f32x16 z0 = {}, z1 = {};
#pragma unroll
    for (int d0 = 0; d0 < 4; ++d0) {
        const bf16x8 b0 = *(LAS const bf16x8*)(kb + d0 * 2048), b1 = *(LAS const bf16x8*)(kb + d0 * 2048 + 512);
        z0 = __builtin_amdgcn_mfma_f32_32x32x16_bf16(b0, qr[d0], z0, 0, 0, 0); z1 = __builtin_amdgcn_mfma_f32_32x32x16_bf16(b1, qr[d0], z1, 0, 0, 0); }
    p0 = z0; p1 = z1;
}
__device__ __forceinline__ void pv(f32x16* o, int vb, bf16x8 pa0, bf16x8 pa1, bf16x8 pa2, bf16x8 pa3) {
#pragma unroll
    for (int d0 = 0; d0 < 2; ++d0) { s16x4 lo[4], hi[4];
#pragma unroll
        for (int ks = 0; ks < 4; ++ks) {
            asm volatile("ds_read_b64_tr_b16 %0,%1 offset:%c2" : "=&v"(lo[ks]) : "v"(vb), "i"(d0 * 4096 + ks * 1024) : "memory");
            asm volatile("ds_read_b64_tr_b16 %0,%1 offset:%c2" : "=&v"(hi[ks]) : "v"(vb), "i"(d0 * 4096 + ks * 1024 + 512) : "memory"); }
        asm volatile("s_waitcnt lgkmcnt(0)" ::: "memory"); MIX_SBAR();
#define MIX_PK(k) (bf16x8){lo[k][0], lo[k][1], lo[k][2], lo[k][3], hi[k][0], hi[k][1], hi[k][2], hi[k][3]}
        o[d0] = __builtin_amdgcn_mfma_f32_32x32x16_bf16(pa0, MIX_PK(0), o[d0], 0, 0, 0);
        o[d0] = __builtin_amdgcn_mfma_f32_32x32x16_bf16(pa1, MIX_PK(1), o[d0], 0, 0, 0);
        o[d0] = __builtin_amdgcn_mfma_f32_32x32x16_bf16(pa2, MIX_PK(2), o[d0], 0, 0, 0);
        o[d0] = __builtin_amdgcn_mfma_f32_32x32x16_bf16(pa3, MIX_PK(3), o[d0], 0, 0, 0);
#undef MIX_PK
    }
}
__device__ __forceinline__ void store_pair16(bf16* p, unsigned (&wa)[2], unsigned (&wb)[2]) {
    auto r0 = __builtin_amdgcn_permlane32_swap(wa[0], wb[0], false, false); auto r1 = __builtin_amdgcn_permlane32_swap(wa[1], wb[1], false, false);
    v4u w; w.x = r0[0]; w.y = r1[0]; w.z = r0[1]; w.w = r1[1];
    *(GAS v4u*)p = w;
}
typedef short v4i16_t __attribute__((ext_vector_type(4)));
__device__ __forceinline__ s16x4 vtr(lcp p) { return __builtin_bit_cast(s16x4, __builtin_amdgcn_ds_read_tr16_b64_v4i16((LAS v4i16_t*)p)); }
__device__ __forceinline__ bf16x8 pack8(const f32x16& p, int b0) {
    v4u w; w.x = cvtpk_s(p[b0], p[b0 + 1]); w.y = cvtpk_s(p[b0 + 2], p[b0 + 3]); w.z = cvtpk_s(p[b0 + 4], p[b0 + 5]); w.w = cvtpk_s(p[b0 + 6], p[b0 + 7]); return __builtin_bit_cast(bf16x8, w); }

__device__ __forceinline__ void gmlp_dma(Frame& F, int b, int blk) {
    unsigned ln = (unsigned)F.lane; asm volatile("" : "+v"(ln));
    const int h = F.wave; const size_t row0 = (size_t)b * SEQ + blk * 128;
    const unsigned gslot = (unsigned)(uintptr_t)F.lds + L_GT + h * 16384;
    const bf16* base = F.Y + row0 * INW + 1280 + 64 * h + ((ln >> 2) * (unsigned)INW + (ln & 3u) * 8u);
#pragma unroll
    for (int qt = 0; qt < 2; ++qt)
#pragma unroll
        for (int w = 0; w < 8; ++w)
            glds16(base + (size_t)(64 * qt + 16 * (w & 3)) * INW + (w >> 2) * 32, (unsigned)__builtin_amdgcn_readfirstlane(gslot + qt * 8192 + w * 1024));
}
template <bool DO_DMA> __device__ __forceinline__ void gmlp_unit(Frame& F, int b, int blk) {
    const int lane = F.lane, r32 = lane & 31, hi = lane >> 5, h = F.wave;
    const size_t row0 = (size_t)b * SEQ + blk * 128;
    const unsigned lds0 = (unsigned)(uintptr_t)F.lds;
    const unsigned gslot = lds0 + L_GT + h * 16384;
    const int vb0 = (int)gslot + ((lane >> 4) & 1) * 32 + (lane & 3) * 8 + (4 * hi + ((lane & 15) >> 2)) * 64;
    if (DO_DMA) gmlp_dma(F, b, blk);
#pragma unroll 1
    for (int half = 0; half < 2; ++half) {
        int p0 = 64 * half + r32; asm volatile("" : "+v"(p0));
        const bf16* wp = F.Wsp + ((size_t)h * 128 + p0) * 128 + 8 * hi;
        bf16x8 wf[2][2][4];
#pragma unroll
        for (int qt = 0; qt < 2; ++qt)
#pragma unroll
            for (int pbl = 0; pbl < 2; ++pbl)
#pragma unroll
                for (int ks = 0; ks < 4; ++ks) wf[qt][pbl][ks] = *(const GAS bf16x8*)(wp + pbl * 32 * 128 + qt * 64 + ks * 16);
        typedef unsigned u32x2_t __attribute__((ext_vector_type(2)));
        u32x2_t uu[2][2][4]; float bs[2];
#pragma unroll
        for (int pbl = 0; pbl < 2; ++pbl) { bs[pbl] = F.b_spatial[h * 128 + p0 + 32 * pbl];
#pragma unroll
            for (int d0 = 0; d0 < 2; ++d0)
#pragma unroll
                for (int k = 0; k < 4; ++k) uu[pbl][d0][k] = *(const GAS u32x2_t*)(F.Y + (row0 + p0 + 32 * pbl) * INW + 768 + 64 * h + 32 * d0 + 8 * k + 4 * hi); }
        asm volatile("s_waitcnt vmcnt(0)" ::: "memory");
        f32x16 o[2][2]; o[0][0] = f32x16{}; o[0][1] = f32x16{}; o[1][0] = f32x16{}; o[1][1] = f32x16{};
#pragma unroll
        for (int qt = 0; qt < 2; ++qt)
#pragma unroll
            for (int d0 = 0; d0 < 2; ++d0) { s16x4 lo[4], hv[4];
#pragma unroll
                for (int ks = 0; ks < 4; ++ks) {
                    asm volatile("ds_read_b64_tr_b16 %0,%1 offset:%c2" : "=&v"(lo[ks]) : "v"(vb0), "i"(qt * 8192 + d0 * 4096 + ks * 1024) : "memory");
                    asm volatile("ds_read_b64_tr_b16 %0,%1 offset:%c2" : "=&v"(hv[ks]) : "v"(vb0), "i"(qt * 8192 + d0 * 4096 + ks * 1024 + 512) : "memory"); }
                asm volatile("s_waitcnt lgkmcnt(0)" ::: "memory"); MIX_SBAR();
#pragma unroll
                for (int ks = 0; ks < 4; ++ks) { const bf16x8 vf = (bf16x8){lo[ks][0], lo[ks][1], lo[ks][2], lo[ks][3], hv[ks][0], hv[ks][1], hv[ks][2], hv[ks][3]};
                    o[0][d0] = __builtin_amdgcn_mfma_f32_32x32x16_bf16(vf, wf[qt][0][ks], o[0][d0], 0, 0, 0);
                    o[1][d0] = __builtin_amdgcn_mfma_f32_32x32x16_bf16(vf, wf[qt][1][ks], o[1][d0], 0, 0, 0); } }
#pragma unroll
        for (int pbl = 0; pbl < 2; ++pbl) { float sq = 0.f; const size_t prow = row0 + p0 + 32 * pbl;
#pragma unroll
            for (int d0 = 0; d0 < 2; ++d0)
#pragma unroll
                for (int kp = 0; kp < 2; ++kp) { unsigned wa[2], wb[2];
#pragma unroll
                    for (int q = 0; q < 2; ++q) { const int k = 2 * kp + q; const u32x2_t u = uu[pbl][d0][k];
                        const float v0 = bf2f(u[0] & 0xffffu) * (o[pbl][d0][4 * k] + bs[pbl]), v1 = bf2f(u[0] >> 16) * (o[pbl][d0][4 * k + 1] + bs[pbl]);
                        const float v2 = bf2f(u[1] & 0xffffu) * (o[pbl][d0][4 * k + 2] + bs[pbl]), v3 = bf2f(u[1] >> 16) * (o[pbl][d0][4 * k + 3] + bs[pbl]);
                        sq += (v0 * v0 + v1 * v1) + (v2 * v2 + v3 * v3);
                        if (q == 0) { wa[0] = cvtpk_s(v0, v1); wa[1] = cvtpk_s(v2, v3); } else { wb[0] = cvtpk_s(v0, v1); wb[1] = cvtpk_s(v2, v3); } }
                    store_pair16(F.A2 + pg8::tiled_off((int)prow, 512 + 64 * h + 32 * d0 + 16 * kp + 8 * hi, 16), wa, wb); }
            sq += __shfl_xor(sq, 32);
            if (hi == 0) F.ssq2[prow * 16 + 8 + h] = sq; }
    }
}

__device__ __forceinline__ void pv2(f32x16* oA, f32x16* oB, int vb, const bf16x8* paA, const bf16x8* paB) {
#pragma unroll
    for (int d0 = 0; d0 < 2; ++d0) { s16x4 lo[4], hi[4];
#pragma unroll
        for (int ks = 0; ks < 4; ++ks) {
            asm volatile("ds_read_b64_tr_b16 %0,%1 offset:%c2" : "=&v"(lo[ks]) : "v"(vb), "i"(d0 * 4096 + ks * 1024) : "memory");
            asm volatile("ds_read_b64_tr_b16 %0,%1 offset:%c2" : "=&v"(hi[ks]) : "v"(vb), "i"(d0 * 4096 + ks * 1024 + 512) : "memory"); }
        asm volatile("s_waitcnt lgkmcnt(0)" ::: "memory"); MIX_SBAR();
#define MIX_PK(k) (bf16x8){lo[k][0], lo[k][1], lo[k][2], lo[k][3], hi[k][0], hi[k][1], hi[k][2], hi[k][3]}
#pragma unroll
        for (int ks = 0; ks < 4; ++ks) { const bf16x8 vf = MIX_PK(ks);
            oA[d0] = __builtin_amdgcn_mfma_f32_32x32x16_bf16(vf, paA[ks], oA[d0], 0, 0, 0);
            oB[d0] = __builtin_amdgcn_mfma_f32_32x32x16_bf16(vf, paB[ks], oB[d0], 0, 0, 0); }
#undef MIX_PK
    }
}
__device__ __forceinline__ void attn_mask(f32x16& p0, f32x16& p1, int j, int s, int r32, int hi) {
    if (64 * j >= 32 * s + 31 && 64 * j + 63 <= 32 * s + 256) return;
    const int q_rel = 32 * s + r32, kb = 64 * j + 4 * hi;
#pragma unroll
    for (int r = 0; r < 16; ++r) { const int ko = kb + (r & 3) + 8 * (r >> 2);
        if (ko < q_rel || ko > q_rel + 256) p0[r] = -INFINITY;
        if (ko + 32 < q_rel || ko + 32 > q_rel + 256) p1[r] = -INFINITY; }
}
__device__ __forceinline__ void attn_epi(Frame& F, const f32x16* o, float l_reg, float sink2, int s, size_t row0, int h) {
    int lane = F.lane; asm volatile("" : "+v"(lane)); const int r32 = lane & 31, hi = lane >> 5;
    l_reg += __shfl_xor(l_reg, 32); l_reg += sink2;
    const float inv = 1.0f / l_reg; float sq = 0.f; const size_t prow = row0 + 32 * s + r32;
#pragma unroll
    for (int d0 = 0; d0 < 2; ++d0)
#pragma unroll
        for (int kp = 0; kp < 2; ++kp) { unsigned wa[2], wb[2];
#pragma unroll
            for (int q = 0; q < 2; ++q) { const int k = 2 * kp + q; unsigned w0 = cvtpk_s(o[d0][4 * k] * inv, o[d0][4 * k + 1] * inv), w1 = cvtpk_s(o[d0][4 * k + 2] * inv, o[d0][4 * k + 3] * inv);
                const float a0 = bf2f(w0 & 0xffffu), a1 = bf2f(w0 >> 16), a2 = bf2f(w1 & 0xffffu), a3 = bf2f(w1 >> 16);
                sq += (a0 * a0 + a1 * a1) + (a2 * a2 + a3 * a3);
                if (q == 0) { wa[0] = w0; wa[1] = w1; } else { wb[0] = w0; wb[1] = w1; } }
            store_pair16(F.A2 + pg8::tiled_off((int)prow, 64 * h + 32 * d0 + 16 * kp + 8 * hi, 16), wa, wb); }
    sq += __shfl_xor(sq, 32);
    if (hi == 0) F.ssq2[prow * 16 + h] = sq;
}
__device__ __forceinline__ void attn_tile(lcp kb, lcp vp, const int (&koffs)[4], const bf16x8 (&qA)[4], const bf16x8 (&qB)[4], f32x16 (&oA)[2], f32x16 (&oB)[2],
                                          float& lA, float& lB, int jm, int sA, int r32, int hi) {
    f32x16 pA0 = {}, pA1 = {}, pB0 = {}, pB1 = {};
    if (jm >= 0) { const int dA = 64 * jm + 4 * hi - (32 * sA + r32), dB = dA - 32;
#pragma unroll
        for (int r = 0; r < 16; ++r) { const int c = (r & 3) + 8 * (r >> 2);
            pA0[r] = ((unsigned)(dA + c) > 256u) ? -INFINITY : 0.f; pA1[r] = ((unsigned)(dA + c + 32) > 256u) ? -INFINITY : 0.f;
            pB0[r] = ((unsigned)(dB + c) > 256u) ? -INFINITY : 0.f; pB1[r] = ((unsigned)(dB + c + 32) > 256u) ? -INFINITY : 0.f; } }
    MIX_SBAR();
    bf16x8 kf[8];
#pragma unroll
    for (int d0 = 0; d0 < 4; ++d0) { kf[2 * d0] = *(LAS const bf16x8*)(kb + koffs[d0]); kf[2 * d0 + 1] = *(LAS const bf16x8*)(kb + koffs[d0] + 4096); }
#pragma unroll
    for (int d0 = 0; d0 < 4; ++d0) { pA0 = __builtin_amdgcn_mfma_f32_32x32x16_bf16(kf[2 * d0], qA[d0], pA0, 0, 0, 0); pA1 = __builtin_amdgcn_mfma_f32_32x32x16_bf16(kf[2 * d0 + 1], qA[d0], pA1, 0, 0, 0); }
    MIX_SBAR();
#pragma unroll
    for (int d0 = 0; d0 < 4; ++d0) { pB0 = __builtin_amdgcn_mfma_f32_32x32x16_bf16(kf[2 * d0], qB[d0], pB0, 0, 0, 0); pB1 = __builtin_amdgcn_mfma_f32_32x32x16_bf16(kf[2 * d0 + 1], qB[d0], pB1, 0, 0, 0); }
    float sa = 0.f;
#pragma unroll
    for (int r = 0; r < 16; ++r) { pA0[r] = __builtin_amdgcn_exp2f(pA0[r]); pA1[r] = __builtin_amdgcn_exp2f(pA1[r]); sa += pA0[r] + pA1[r]; }
    lA += sa;
    bf16x8 paA[4], paB[4], vf0[4], vf1[4];
    paA[0] = pack8(pA0, 0); paA[1] = pack8(pA0, 8); paA[2] = pack8(pA1, 0); paA[3] = pack8(pA1, 8);
#pragma unroll
    for (int i = 0; i < 8; ++i) { __builtin_amdgcn_sched_group_barrier(0x008, 1, 0); __builtin_amdgcn_sched_group_barrier(0x402, 10, 0); }
    MIX_SBAR();
    {
#pragma unroll
        for (int ks = 0; ks < 4; ++ks) { const s16x4 lo = vtr(vp + ks * 1024), hv = vtr(vp + ks * 1024 + 512); vf0[ks] = (bf16x8){lo[0], lo[1], lo[2], lo[3], hv[0], hv[1], hv[2], hv[3]}; }
#pragma unroll
        for (int ks = 0; ks < 4; ++ks) { const s16x4 lo = vtr(vp + 4096 + ks * 1024), hv = vtr(vp + 4096 + ks * 1024 + 512); vf1[ks] = (bf16x8){lo[0], lo[1], lo[2], lo[3], hv[0], hv[1], hv[2], hv[3]}; }
#pragma unroll
        for (int ks = 0; ks < 4; ++ks) oA[0] = __builtin_amdgcn_mfma_f32_32x32x16_bf16(vf0[ks], paA[ks], oA[0], 0, 0, 0);
#pragma unroll
        for (int ks = 0; ks < 4; ++ks) oA[1] = __builtin_amdgcn_mfma_f32_32x32x16_bf16(vf1[ks], paA[ks], oA[1], 0, 0, 0);
    }
    float sb = 0.f;
#pragma unroll
    for (int r = 0; r < 16; ++r) { pB0[r] = __builtin_amdgcn_exp2f(pB0[r]); pB1[r] = __builtin_amdgcn_exp2f(pB1[r]); sb += pB0[r] + pB1[r]; }
    lB += sb;
    paB[0] = pack8(pB0, 0); paB[1] = pack8(pB0, 8); paB[2] = pack8(pB1, 0); paB[3] = pack8(pB1, 8);
    __builtin_amdgcn_sched_group_barrier(0x100, 16, 0);
#pragma unroll
    for (int i = 0; i < 8; ++i) { __builtin_amdgcn_sched_group_barrier(0x008, 1, 0); __builtin_amdgcn_sched_group_barrier(0x402, 10, 0); }
    MIX_SBAR();
    {
        bf16x8 wf0[4], wf1[4];
#pragma unroll
        for (int ks = 0; ks < 4; ++ks) { const s16x4 lo = vtr(vp + ks * 1024), hv = vtr(vp + ks * 1024 + 512); wf0[ks] = (bf16x8){lo[0], lo[1], lo[2], lo[3], hv[0], hv[1], hv[2], hv[3]}; }
#pragma unroll
        for (int ks = 0; ks < 4; ++ks) { const s16x4 lo = vtr(vp + 4096 + ks * 1024), hv = vtr(vp + 4096 + ks * 1024 + 512); wf1[ks] = (bf16x8){lo[0], lo[1], lo[2], lo[3], hv[0], hv[1], hv[2], hv[3]}; }
#pragma unroll
        for (int ks = 0; ks < 4; ++ks) oB[0] = __builtin_amdgcn_mfma_f32_32x32x16_bf16(wf0[ks], paB[ks], oB[0], 0, 0, 0);
#pragma unroll
        for (int ks = 0; ks < 4; ++ks) oB[1] = __builtin_amdgcn_mfma_f32_32x32x16_bf16(wf1[ks], paB[ks], oB[1], 0, 0, 0);
    }
    MIX_SBAR();
}
__device__ __forceinline__ void attn_unit(Frame& F, int b, int blk) {
    const int lane = F.lane, r32 = lane & 31, hi = lane >> 5, h = F.wave, g = h >> 2, wid = F.wave;
    const size_t row0 = (size_t)b * SEQ + blk * 128;
    const unsigned lds0 = (unsigned)(uintptr_t)F.lds;
    const float sink2 = exp2f(F.attn_sink[h] * LOG2E);
    int koffs[4];
#pragma unroll
    for (int d0 = 0; d0 < 4; ++d0) koffs[d0] = (r32 >> 3) * 1024 + (r32 & 7) * 128 + (((2 * d0 + hi) ^ ((r32 >> 1) & 7)) * 16);
    const int vbl = ((lane >> 4) & 1) * 32 + (lane & 3) * 8 + (4 * hi + ((lane & 15) >> 2)) * 64;
    const int jf_blk = (blk == 0) ? 2 : 0, jl_blk = (blk == 31) ? 3 : 5;
    const int jf0 = jf_blk, jl0 = 4 < jl_blk ? 4 : jl_blk, nw0 = jl0 - jf0 + 1, n0 = nw0 + 4;
    const int jf1 = 1 > jf_blk ? 1 : jf_blk, jl1 = jl_blk, nw1 = jl1 - jf1 + 1, n1 = nw1 + 4;
    const int ntot = n0 + n1;
#define MIX_DMA(gi, slot) do { const int gi_ = (gi); const int ps_ = gi_ >= n0 ? 1 : 0, ti_ = gi_ - ps_ * n0, nw_ = ps_ ? nw1 : nw0, jf_ = ps_ ? jf1 : jf0; const bf16* base_; unsigned pitch_; \
        if (ti_ < nw_) { base_ = F.KV + ((size_t)b * SEQ + (size_t)(128 * (blk - 1) + 64 * (jf_ + ti_))) * 256; pitch_ = 256; } \
        else { base_ = F.Yc + ((size_t)b * CTXL + 64 * (ti_ - nw_)) * 256; pitch_ = 256; } \
        const unsigned sl_ = lds0 + (slot) * SLOT; \
        unsigned ln_ = (unsigned)lane; asm volatile("" : "+v"(ln_));     \
        const unsigned kk_ = 8u * (unsigned)wid + (ln_ >> 3); \
        const unsigned ko_ = kk_ * pitch_ + 8u * ((ln_ & 7u) ^ ((kk_ >> 1) & 7u)), vo_ = (16u * (unsigned)(wid & 3) + (ln_ >> 2)) * pitch_ + 128u + (unsigned)(wid >> 2) * 32u + (ln_ & 3u) * 8u; \
        glds16(base_ + ko_, (unsigned)__builtin_amdgcn_readfirstlane(sl_ + wid * 1024)); \
        glds16(base_ + ko_ + 64, (unsigned)__builtin_amdgcn_readfirstlane(sl_ + 8192 + wid * 1024)); \
        glds16(base_ + vo_, (unsigned)__builtin_amdgcn_readfirstlane(sl_ + 16384 + wid * 1024)); \
        glds16(base_ + vo_ + 64, (unsigned)__builtin_amdgcn_readfirstlane(sl_ + 24576 + wid * 1024)); } while (0)
    bf16x8 qA[4], qB[4];
#define MIX_LOADQ(ps) do { unsigned lq_ = (unsigned)lane; asm volatile("" : "+v"(lq_)); const bf16* qp_ = F.Y + (row0 + 64 * (ps)) * INW + 256 + 64 * h + ((lq_ & 31u) * (unsigned)INW + 8u * (lq_ >> 5)); \
        _Pragma("unroll") for (int d0 = 0; d0 < 4; ++d0) { qA[d0] = *(const GAS bf16x8*)(qp_ + 16 * d0); qB[d0] = *(const GAS bf16x8*)(qp_ + (size_t)32 * INW + 16 * d0); } } while (0)
    MIX_LOADQ(0);
    MIX_DMA(0, 0); MIX_DMA(1, 1);
    int gi = 0, slot = 0; bool gpend = false;
    for (int ps = 0; ps < 2; ++ps) {
        const int np = ps ? n1 : n0, nwp = ps ? nw1 : nw0, jfp = ps ? jf1 : jf0, sA = 2 * ps, sB = 2 * ps + 1;
        if (ps) MIX_LOADQ(1);
        f32x16 oA[2], oB[2]; oA[0] = f32x16{}; oA[1] = f32x16{}; oB[0] = f32x16{}; oB[1] = f32x16{};
        float lA = 0.f, lB = 0.f;
        for (int ti = 0; ti < np; ++ti, ++gi) {
            if (gi + 1 < ntot) asm volatile("s_waitcnt vmcnt(4) lgkmcnt(0)\n\ts_barrier" ::: "memory");
            else if (gpend) asm volatile("s_waitcnt vmcnt(16) lgkmcnt(0)\n\ts_barrier" ::: "memory");
            else asm volatile("s_waitcnt vmcnt(0) lgkmcnt(0)\n\ts_barrier" ::: "memory");
            { const int s2 = slot + 2 >= 3 ? slot - 1 : slot + 2;
              if (gi == 1 && (h >> 1) == 3) gmlp_dma(F, b, blk);
              if (gi + 2 < ntot) MIX_DMA(gi + 2, s2);
              else if ((h >> 1) == s2) { gmlp_dma(F, b, blk); gpend = true; } }
            lcp kb = (lcp)(F.lds + slot * SLOT + g * 8192);
            lcp vp = (lcp)(F.lds + slot * SLOT + 16384 + g * 8192) + vbl;
            const int jt = ti < nwp ? jfp + ti : -1;
            attn_tile(kb, vp, koffs, qA, qB, oA, oB, lA, lB, (jt >= 0 && (jt == (ps ? 1 : 0) || jt == (ps ? 5 : 4))) ? jt : -1, sA, r32, hi);
            slot = slot == 2 ? 0 : slot + 1;
        }
        attn_epi(F, oA, lA, sink2, sA, row0, h);
        attn_epi(F, oB, lB, sink2, sB, row0, h);
    }
    asm volatile("s_waitcnt lgkmcnt(0)\n\ts_barrier" ::: "memory");
    { const int sl = slot == 0 ? 2 : slot - 1; if ((h >> 1) == sl) gmlp_dma(F, b, blk); }
#undef MIX_DMA
#undef MIX_LOADQ
}

__device__ __forceinline__ void p3_mixer(Frame& F) {
    for (int item = F.vcu; item < BATCH * 32; item += F.G) {
        const int b = item >> 5, blk = item & 31;
#ifdef MK_ATTN_TWICE
        for (int rep_ = 0; rep_ < 2; ++rep_) { asm volatile("s_waitcnt vmcnt(0) lgkmcnt(0)" ::: "memory"); __syncthreads();
#endif
        attn_unit(F, b, blk);
#ifdef MK_ATTN_TWICE
        }
#endif
        gmlp_unit<false>(F, b, blk);
        asm volatile("s_waitcnt vmcnt(0) lgkmcnt(0)" ::: "memory"); __syncthreads();
    }
}
#undef MIX_SBAR
#undef MIX_WAIT_BAR
}
struct Args { const float* in[20]; float* out; unsigned char* ws; int ph_lo, ph_hi, li, pad; };
__global__ void __launch_bounds__(NWAVES * 64, 2) fwd_mega(Args args) {
    extern __shared__ __attribute__((aligned(16))) unsigned char lds[];
    Frame F;
    F.lds = (LAS unsigned char*)lds;
    F.MISC = (volatile LAS unsigned*)(F.lds + MISC_OFF);
    F.tid = threadIdx.x; F.lane = F.tid & 63; F.wave = __builtin_amdgcn_readfirstlane(F.tid >> 6);
    F.G = gridDim.x; { const int bx = blockIdx.x; F.vcu = (F.G % 8 == 0) ? (bx % 8) * (F.G / 8) + bx / 8 : bx; }
    unsigned char* ws = args.ws;
    F.ctl = (gu32*)(ws + WS_CTL);
    F.x = args.in[0]; F.c = args.in[1]; F.ctx = args.in[2]; F.c_ctx = args.in[3]; F.w_mod = args.in[4]; F.b_mod = args.in[5]; F.norm_mix = args.in[6]; F.norm_ffn = args.in[7];
    F.w_in = args.in[8]; F.q_gain = args.in[9]; F.k_gain = args.in[10]; F.attn_sink = args.in[11]; F.gate_gain = args.in[12]; F.w_spatial = args.in[13]; F.b_spatial = args.in[14];
    F.attn_out_gain = args.in[15]; F.mlp_out_gain = args.in[16]; F.w_out = args.in[17]; F.w_gate_up = args.in[18]; F.w_down = args.in[19]; F.out = args.out;
    F.mod = (float*)(ws + WS_MOD); F.rope = (float*)(ws + WS_ROPE); F.bias_t = (float*)(ws + WS_BIAS); F.ssq3 = (float*)(ws + WS_SSQ3); F.ssq2 = (float*)(ws + WS_SSQ2); F.rstd3 = (float*)(ws + WS_RSTD3);
    F.Win_t = (bf16*)(ws + WS_WIN); F.Wout_t = (bf16*)(ws + WS_WOUT); F.Wgu_t = (bf16*)(ws + WS_WGU); F.Wdn_t = (bf16*)(ws + WS_WDN);
    F.XN = (bf16*)(ws + WS_XN); F.Y = (bf16*)(ws + WS_Y); F.Yc = (bf16*)(ws + WS_YC); F.H = (bf16*)(ws + WS_H); F.A2 = (bf16*)(ws + WS_A2); F.A3 = (bf16*)(ws + WS_A3); F.Wsp = (bf16*)(ws + WS_WSP); F.KV = (bf16*)(ws + WS_KV);
    for (int u = F.tid; u < (LDS_BYTES - LDSCTL_OFF) / 4; u += NWAVES * 64) ((LAS unsigned*)(F.lds + LDSCTL_OFF))[u] = 0u;
    __syncthreads();
    XcdBarrier bar = xcd_barrier_post((unsigned*)(F.ctl + CW_BAR) + args.li * XCD_BAR_WORDS, F.MISC + 8);
    if (F.tid == 0) { unsigned nloc, nx, uni; xcd_barrier_complete(bar.bar, bar.x, nloc, nx, uni); bar.st[0] = nloc; bar.st[1] = nx; bar.st[2] = uni; }
    __syncthreads();
    F.xcc = (int)bar.x; F.uni = (F.MISC[10] == 1u && F.G == 256) ? 1 : 0;
#ifdef MK_FORCE_NONUNI
    F.uni = 0;
#endif
    F.cid = (int)blockIdx.x;
    if (F.uni) { const int rank = (int)F.MISC[11]; F.cid = rank * 8 + F.xcc; F.vcu = F.xcc * 32 + rank; }
    const int lo = args.ph_lo, hi = args.ph_hi;
#define IN(k) (lo <= (k) && (k) < hi)
#define SEAM(k) do { if (IN(k) && IN((k) + 1)) xcd_barrier(bar, F.uni && (k) >= 1); } while (0)

#ifndef MK_DUP
#define MK_DUP 0
#endif
#define REP(k) for (int rep_ = 0; rep_ < (((MK_DUP >> (k)) & 1) ? 2 : 1); ++rep_)
    if (IN(0)) { REP(0) { p0_prologue(F); __syncthreads(); } SEAM(0); }
#ifdef MK_XBAR
    for (int xb = 0; xb < MK_XBAR; ++xb) xcd_barrier(bar);
#endif
    if (IN(1)) { REP(1) p1_norm_rows(F); if (!F.uni) SEAM(1); }
#if defined(MK_SLEEP_H) || defined(MK_SLEEP_L)
    { const int rank_ = F.vcu & 31; int us_ = 0;
#ifdef MK_SLEEP_H
      if (rank_ < P12_RANK_L) us_ = MK_SLEEP_H;
#endif
#ifdef MK_SLEEP_L
      if (rank_ >= P12_RANK_L) us_ = MK_SLEEP_L;
#endif
      const unsigned long long t0_ = rt(); while (rt() - t0_ < (unsigned long long)us_ * 100ull) __builtin_amdgcn_s_sleep(8); }
#endif
    if (IN(2)) {
        LAS float* ropeL = (LAS float*)(F.lds + LDSCTL_OFF + 1024); LAS float* gainL = ropeL + 2048;
        for (int i = F.tid; i < 2048; i += NWAVES * 64) ropeL[i] = F.rope[i];
        for (int i = F.tid; i < 640; i += NWAVES * 64) gainL[i] = i < 64 ? F.q_gain[i] * pg8::C2Q : i < 128 ? F.k_gain[i - 64] : F.gate_gain[i - 128];
        __syncthreads();
        pg8::Gemm g{F.XN, F.Win_t, MROWS, INW, DM}; pg8::InProjOrder S; S.so.init(MROWS, INW, F.G, F.cid); S.cnt = F.uni ? (const unsigned*)F.ctl + CW_RT + F.xcc * 32 : nullptr; S.flagp = (LAS unsigned*)(F.lds + LDSCTL_OFF + 512); S.na = P12_NA; S.nb = P12_NWL;
        pg8::EpiInProj E{F.Y, F.Yc, F.KV, ropeL, gainL};
        REP(2) pg8::gemm_phase<pg8::EpiInProj, pg8::InProjOrder, true, true>(F.lds + RING_OFF, g, S, E);
        SEAM(2);
    }
    if (IN(3)) { REP(3) mix::p3_mixer(F); SEAM(3); }
    if (IN(4)) {
        pg8::Gemm g{F.A2, F.Wout_t, MROWS, DM, DM}; pg8::OutProjOrder S; S.init(MROWS, DM, F.G, F.cid);
        S.ssq2 = F.ssq2; S.mod = F.mod; S.norm_ffn = F.norm_ffn; S.tab = (LAS float*)(F.lds + LDSCTL_OFF + 1024);
        pg8::EpiOutProj E{F.x, F.A3, F.ssq3, S.tab};
        REP(4) pg8::gemm_phase<pg8::EpiOutProj, pg8::OutProjOrder, true, true>(F.lds + RING_OFF, g, S, E);
        SEAM(4);
    }
    if (IN(5)) {
        { const int wv = F.uni ? (F.vcu & 31) * NWAVES + F.wave : F.vcu * NWAVES + F.wave, nwv = F.uni ? 256 : F.G * NWAVES; const size_t rbase = F.uni ? (size_t)F.xcc * SEQ : 0, rend = F.uni ? rbase + SEQ : MROWS;
          for (size_t rowb = rbase + 16 * (size_t)wv + (F.lane >> 2); rowb < rend; rowb += 16 * (size_t)nwv) {
              const f32x4 p = *(const f32x4*)(F.ssq3 + rowb * 16 + 4 * (F.lane & 3)); float ss = (p[0] + p[1]) + (p[2] + p[3]);
              ss += __shfl_xor(ss, 1); ss += __shfl_xor(ss, 2);
              if ((F.lane & 3) == 0) F.rstd3[rowb] = 1.0f / sqrtf(ss * (1.0f / 1024.0f) + 1e-6f); } }
        if (F.tid == 0) { unsigned* fl = (unsigned*)F.ctl + CW_BIASF; const unsigned want = (unsigned)(F.G * NWAVES); XB_SPIN(xb_ld(fl) < want, bar.bar); }
        xcd_barrier(bar, F.uni);
        pg8::Gemm g{F.A3, F.Wgu_t, MROWS, 2 * FFH, DM}; pg8::GateUpOrder S; S.init(MROWS, 2 * FFH, F.G, F.cid);
        S.rstd3 = F.rstd3; S.bias_t = F.bias_t; S.tab = (LAS float*)(F.lds + LDSCTL_OFF + 1024);
        pg8::EpiGateUp E{F.H, S.tab};
        REP(5) pg8::gemm_phase<pg8::EpiGateUp, pg8::GateUpOrder, true, true>(F.lds + RING_OFF, g, S, E);
        SEAM(5);
    }
    if (IN(6)) {
#ifdef MK_SLEEP_P6
        if (F.vcu & 16) { const unsigned long long t0_ = rt(); while (rt() - t0_ < (unsigned long long)(MK_SLEEP_P6) * 100ull) __builtin_amdgcn_s_sleep(8); }
#endif
        pg8::Gemm g{F.H, F.Wdn_t, MROWS, DM, FFH}; pg8::DownOrder S; S.init(MROWS, DM, F.G, F.cid);
        S.mod = F.mod; S.norm_ffn = F.norm_ffn; S.tab = (LAS float*)(F.lds + LDSCTL_OFF + 1024);
        pg8::EpiDown E{F.A3, F.out, S.tab};
        pg8::gemm_phase<pg8::EpiDown, pg8::DownOrder, true, true>(F.lds + RING_OFF, g, S, E);
    }
#undef IN
#undef SEAM
}

extern "C" void kernel_launch(void* const* d_in, const int* in_sizes, int n_in, void* d_out, int out_size, void* d_ws, size_t ws_size, hipStream_t stream) {
    static int grid = 0;
    if (grid == 0) {
        if (n_in != 20 || in_sizes[0] != MROWS * DM || out_size != MROWS * DM || ws_size < WS_END) { fprintf(stderr, "kernel_launch: unexpected shapes: n_in %d in0 %d out %d ws %zu\n", n_in, n_in > 0 ? in_sizes[0] : -1, out_size, ws_size); grid = -1; return; }
        int dev = 0, cus = 0, per_cu = 0;
        if (hipGetDevice(&dev) != hipSuccess || hipDeviceGetAttribute(&cus, hipDeviceAttributeMultiprocessorCount, dev) != hipSuccess) { grid = -1; return; }
        if (hipFuncSetAttribute((const void*)fwd_mega, hipFuncAttributeMaxDynamicSharedMemorySize, LDS_BYTES) != hipSuccess) { fprintf(stderr, "kernel_launch: hipFuncSetAttribute failed\n"); grid = -1; return; }
        if (hipOccupancyMaxActiveBlocksPerMultiprocessor(&per_cu, (const void*)fwd_mega, NWAVES * 64, LDS_BYTES) != hipSuccess || per_cu < 1) fprintf(stderr, "kernel_launch: occupancy query says %d\n", per_cu);
        (void)hipGetLastError();
        grid = cus - (cus % 8);
        if (grid < 8) grid = cus;
    }
    if (grid < 0) return;
    if (hipMemsetAsync((char*)d_ws + WS_CTL, 0, CTL_ZERO_BYTES, stream) != hipSuccess) return;
    Args a{};
    for (int i = 0; i < 20; ++i) a.in[i] = (const float*)d_in[i];
    a.out = (float*)d_out; a.ws = (unsigned char*)d_ws;
#ifdef MK_PROBE_PHASE
    const int plan[3][2] = {{0, MK_PROBE_PHASE + 1}, {MK_PROBE_PHASE, MK_PROBE_PHASE + 1}, {MK_PROBE_PHASE + 1, N_PHASES}};
    for (int li = 0; li < 3; ++li) { if (plan[li][0] >= plan[li][1]) continue; a.ph_lo = plan[li][0]; a.ph_hi = plan[li][1]; a.li = li;
        hipLaunchKernelGGL(fwd_mega, dim3(grid), dim3(NWAVES * 64), LDS_BYTES, stream, a); }
#else
    int lo = 0, li = 0;
    for (int k = 0; k < N_PHASES; ++k) {
        const bool cut = (k == N_PHASES - 1) || ((MK_CUTS >> k) & 1);
        if (!cut) continue;
        a.ph_lo = lo; a.ph_hi = k + 1; a.li = li++;
        hipLaunchKernelGGL(fwd_mega, dim3(grid), dim3(NWAVES * 64), LDS_BYTES, stream, a);
        lo = k + 1;
    }
#endif
}
```

```cpp
#include <hip/hip_runtime.h>
#include <cstdio>
#include <cstdint>
#include <cmath>
namespace pg8 {
#define PG8_LAS __attribute__((address_space(3)))
typedef unsigned short bf16_t;
typedef short bf16x8 __attribute__((ext_vector_type(8)));
typedef float f32x4 __attribute__((ext_vector_type(4)));
typedef unsigned u32x4 __attribute__((ext_vector_type(4)));
constexpr int BM = 256, BK = 64, HALF = 128, HTB = HALF * BK * 2  , STAGE_BYTES = 8 * HTB, NXCD = 8, WGM = 4;

__host__ __device__ __forceinline__ int lds_byte(int r, int c) { const int st = (r >> 4) * 2 + (c >> 5), rr = r & 15, cc = c & 31, ob = rr * 64 + cc * 2; return st * 1024 + (ob ^ (((ob >> 9) & 1) << 5)); }
__host__ __device__ __forceinline__ void stage_rc(int b, int& R, int& C) { const int st = b / 1024, sb = b % 1024, swz = sb ^ (((sb >> 9) & 1) << 5); R = (st >> 1) * 16 + swz / 64; C = (st & 1) * 32 + (swz % 64) / 2; }
__host__ __device__ __forceinline__ int perm32(int rho) { const int n = rho >> 4, i = rho & 15; return 8 * (i >> 2) + 4 * n + (i & 3); }

__host__ __device__ __forceinline__ size_t tiled_off(int row, int col, int nt) { return (((size_t)(row >> 8) * nt + (col >> 6)) * 256 + (row & 255)) * 64 + (col & 63); }
struct Unit { int pm, pn; };
struct Gemm { const bf16_t* A; const bf16_t* Bt; int M, N, K; };

struct StaticOrder {
    int nM, nN, nwg, G, c;
    __host__ __device__ void init(int M, int N, int G_, int c_) { nM = M / BM; nN = N / BM; nwg = nM * nN; G = G_; c = c_; }
    __host__ __device__ bool next(int i, Unit& u) const {
        const long L = (long)i * G + c; if (L >= nwg) return false;
        int wgid = (int)L; { const int q = nwg / NXCD, r = nwg % NXCD, xcd = wgid % NXCD, off = wgid / NXCD; wgid = (xcd < r ? xcd * (q + 1) : r * (q + 1) + (xcd - r) * q) + off; }
        const int nig = WGM * nN, gid = wgid / nig, fm = gid * WGM, gsz = (nM - fm) < WGM ? (nM - fm) : WGM;
        u.pm = fm + ((wgid % nig) % gsz); u.pn = (wgid % nig) / gsz; return true;
    }
    __device__ __forceinline__ void a_ready(const Unit&, int) const {}
    __device__ __forceinline__ void a_poll(const Unit&) const {}
    __device__ __forceinline__ void done(const Unit&) const {}
};
typedef float cvt_f32x2_t __attribute__((ext_vector_type(2))); typedef __bf16 cvt_bf16x2_t __attribute__((ext_vector_type(2)));
__device__ __forceinline__ unsigned cvt_pk_bf16(float lo, float hi) { cvt_f32x2_t v = {lo, hi}; cvt_bf16x2_t b = __builtin_convertvector(v, cvt_bf16x2_t); return __builtin_bit_cast(unsigned, b); }
typedef float f32x2 __attribute__((ext_vector_type(2)));
typedef unsigned u32x2 __attribute__((ext_vector_type(2)));
constexpr float C2Q = 0.125f * 1.4426950408889634f;
constexpr float RMS_EPS = 1e-6f;
__device__ __forceinline__ float gelu_tanh(float x) {
    const float z2 = x * (1.5957691216057308f + 0.07135481627244473f * x * x);
    const float e = __builtin_amdgcn_exp2f(-1.4426950408889634f * z2);
    return x * __builtin_amdgcn_rcpf(1.0f + e);
}
__device__ __forceinline__ float silu_f(float x) { return x * __builtin_amdgcn_rcpf(1.0f + __builtin_amdgcn_exp2f(-1.4426950408889634f * x)); }

struct EpiInProj {
    static constexpr bool PERM = true, AFTER_DRAIN = false, MIDSCALE = false; static constexpr int A_AUX = 0;
    bf16_t* Y; bf16_t* Yc; bf16_t* KV; PG8_LAS const float* ropeL; PG8_LAS const float* gainL;
    __device__ __forceinline__ void operator()(const f32x4 (&acc)[2][2][4][2], const Unit& u, int wr, int wc, int fr, int fq, int) const {
        const bool ctx = u.pm >= 128;
        const int head = __builtin_amdgcn_readfirstlane(4 * u.pn + wc);
        const int type = head < 2 ? 0 : head < 4 ? 1 : head < 12 ? 2 : head < 20 ? 3 : 4;
        bf16_t* base; int ld, rowb;
        if (ctx) { base = Yc; ld = 256; rowb = (u.pm - 128) * 256; } else if (head < 4) { base = KV; ld = 256; rowb = u.pm * 256; }
        else { base = Y; ld = 1792; rowb = u.pm * 256; }
        const int colb = head * 64 + 8 * fq;
        f32x4 g[2][2];
#pragma unroll
        for (int bj = 0; bj < 2; ++bj)
#pragma unroll
            for (int n = 0; n < 2; ++n) {
                if (type == 0) g[bj][n] = *(PG8_LAS const f32x4*)(gainL + 64 + 32 * bj + 16 * n + 4 * fq);
                else if (type == 2) g[bj][n] = *(PG8_LAS const f32x4*)(gainL + 32 * bj + 16 * n + 4 * fq);
                else if (type == 4) g[bj][n] = *(PG8_LAS const f32x4*)(gainL + 128 + (head - 20) * 64 + 32 * bj + 8 * fq + 4 * n);
                else g[bj][n] = (f32x4){1.f, 1.f, 1.f, 1.f};
            }
        const bool do_norm = (type == 0 || type == 2 || type == 4), do_rope = (type == 2) || (type == 0 && !ctx), do_gelu = type >= 3;
#pragma unroll
        for (int ai = 0; ai < 2; ++ai)
#pragma unroll
            for (int m = 0; m < 4; ++m) {
                const int row = rowb + ai * HALF + wr * 64 + m * 16 + fr;
                f32x4 v[2][2];
#pragma unroll
                for (int bj = 0; bj < 2; ++bj)
#pragma unroll
                    for (int n = 0; n < 2; ++n) v[bj][n] = acc[ai][bj][m][n];
                if (do_gelu) {
#pragma unroll
                    for (int bj = 0; bj < 2; ++bj)
#pragma unroll
                        for (int n = 0; n < 2; ++n) { const f32x4 xx = v[bj][n]; const f32x4 t = xx * ((xx * xx) * (-1.4426950408889634f * 0.07135481627244473f) + (-1.4426950408889634f * 1.5957691216057308f)); f32x4 d;
#pragma unroll
                            for (int e = 0; e < 4; ++e) d[e] = __builtin_amdgcn_exp2f(t[e]);
                            d = d + 1.0f; f32x4 r;
#pragma unroll
                            for (int e = 0; e < 4; ++e) r[e] = __builtin_amdgcn_rcpf(d[e]);
                            v[bj][n] = xx * r; }
                }
                if (do_norm) {
                    float ss = 0.f;
#pragma unroll
                    for (int bj = 0; bj < 2; ++bj)
#pragma unroll
                        for (int n = 0; n < 2; ++n) { const f32x4 t = v[bj][n]; ss += (t[0] * t[0] + t[1] * t[1]) + (t[2] * t[2] + t[3] * t[3]); }
                    ss += __shfl_xor(ss, 16); ss += __shfl_xor(ss, 32);
                    const float rstd = __builtin_amdgcn_rsqf(ss * (1.0f / 64.0f) + RMS_EPS);
#pragma unroll
                    for (int bj = 0; bj < 2; ++bj)
#pragma unroll
                        for (int n = 0; n < 2; ++n) v[bj][n] = v[bj][n] * rstd * g[bj][n];
                }
                if (do_rope) {
                    const int t = row & 4095;
#pragma unroll
                    for (int bj = 0; bj < 2; ++bj) {
                        const int pos = bj ? (t & 63) : (t >> 6);
                        const f32x4 cs0 = *(PG8_LAS const f32x4*)(ropeL + (pos * 16 + 4 * fq) * 2), cs1 = *(PG8_LAS const f32x4*)(ropeL + (pos * 16 + 4 * fq) * 2 + 4);
                        const f32x4 c = {cs0[0], cs0[2], cs1[0], cs1[2]}, s = {cs0[1], cs0[3], cs1[1], cs1[3]};
                        const f32x4 x1 = v[bj][0], x2 = v[bj][1]; v[bj][0] = x1 * c - x2 * s; v[bj][1] = x1 * s + x2 * c;
                    }
                }
                bf16_t* rowp = base + (size_t)row * ld + colb;
#pragma unroll
                for (int bj = 0; bj < 2; ++bj) { u32x4 w; w.x = cvt_pk_bf16(v[bj][0][0], v[bj][0][1]); w.y = cvt_pk_bf16(v[bj][0][2], v[bj][0][3]); w.z = cvt_pk_bf16(v[bj][1][0], v[bj][1][1]); w.w = cvt_pk_bf16(v[bj][1][2], v[bj][1][3]);
                    *(u32x4*)(rowp + 32 * bj) = w; }
            }
    }
};

__device__ __forceinline__ f32x4 gf_eff(f32x4 g) {
#pragma unroll
    for (int e = 0; e < 4; ++e) g[e] = (__builtin_fabsf(g[e]) < 1e-30f) ? 1e-30f : g[e];
    return g; }
struct EpiOutProj {
    static constexpr bool PERM = true, AFTER_DRAIN = false, MIDSCALE = true; static constexpr int A_AUX = 0;
    const float* x; bf16_t* A3; float* ssq3; PG8_LAS const float* tab;
    __device__ __forceinline__ void midscale(f32x4 (&acc)[2][2][4][2], int wr, int fr, int ui) const {
        PG8_LAS const float* t = tab + (ui & 1) * 1024;
#pragma unroll
        for (int ai = 0; ai < 2; ++ai)
#pragma unroll
            for (int m = 0; m < 4; ++m) { const float f = t[ai * HALF + wr * 64 + m * 16 + fr];
#pragma unroll
                for (int bj = 0; bj < 2; ++bj)
#pragma unroll
                    for (int n = 0; n < 2; ++n) acc[ai][bj][m][n] = acc[ai][bj][m][n] * f; }
    }
    __device__ __forceinline__ void operator()(const f32x4 (&acc)[2][2][4][2], const Unit& u, int wr, int wc, int fr, int fq, int ui) const {
        PG8_LAS const float* t = tab + (ui & 1) * 1024;
        const int col0 = u.pn * BM + wc * 32 + 8 * fq, cl0 = wc * 32 + 8 * fq;
#pragma unroll
        for (int ai = 0; ai < 2; ++ai) {
            f32x4 xv[4][2][2];
#pragma unroll
            for (int m = 0; m < 4; ++m)
#pragma unroll
                for (int bj = 0; bj < 2; ++bj)
#pragma unroll
                    for (int n = 0; n < 2; ++n) xv[m][bj][n] = *(const f32x4*)(x + (size_t)(u.pm * BM + ai * HALF + wr * 64 + m * 16 + fr) * 1024 + col0 + bj * HALF + n * 4);
#pragma unroll
            for (int m = 0; m < 4; ++m) {
                const int rl = ai * HALF + wr * 64 + m * 16 + fr, row = u.pm * BM + rl; float ss = 0.f; const float f2 = t[256 + rl];
#pragma unroll
                for (int bj = 0; bj < 2; ++bj) { u32x4 w;
#pragma unroll
                    for (int n = 0; n < 2; ++n) {
                        const f32x4 gtv = *(PG8_LAS const f32x4*)(t + 512 + cl0 + bj * HALF + n * 4), gfv = *(PG8_LAS const f32x4*)(t + 768 + cl0 + bj * HALF + n * 4);
                        const f32x4 h = xv[m][bj][n] + gtv * (acc[ai][bj][m][n] * f2);
                        ss += (h[0] * h[0] + h[1] * h[1]) + (h[2] * h[2] + h[3] * h[3]);
                        const f32x4 a = h * gfv; if (n == 0) { w.x = cvt_pk_bf16(a[0], a[1]); w.y = cvt_pk_bf16(a[2], a[3]); } else { w.z = cvt_pk_bf16(a[0], a[1]); w.w = cvt_pk_bf16(a[2], a[3]); } }
                    *(u32x4*)(A3 + tiled_off(row, col0 + bj * HALF, 16)) = w; }
                ss += __shfl_xor(ss, 16); ss += __shfl_xor(ss, 32);
                if (fq == 0) ssq3[(size_t)row * 16 + u.pn * 4 + wc] = ss;
            }
        }
    }
};
struct OutProjOrder : StaticOrder {
    const float* ssq2; const float* mod; const float* norm_ffn; PG8_LAS float* tab;
    __device__ __forceinline__ void a_ready(const Unit& u, int ui) const {
        int tid = threadIdx.x; asm volatile("" : "+v"(tid));
        PG8_LAS float* t = tab + (ui & 1) * 1024;
        const int r = tid >> 1, hf = tid & 1;
        const f32x4* sp = (const f32x4*)(ssq2 + ((size_t)u.pm * BM + r) * 16 + hf * 8);
        const f32x4 s0 = sp[0], s1 = sp[1];
        const float ss = ((s0[0] + s0[1]) + (s0[2] + s0[3])) + ((s1[0] + s1[1]) + (s1[2] + s1[3]));
        const float rs = 1.0f / sqrtf(ss * (1.0f / 512.0f) + RMS_EPS);
        const float ro = __shfl_xor(rs, 1);
        if (hf == 0) { t[r] = rs / ro; t[256 + r] = ro; }
        if (tid < 256) { const int b = u.pm >> 4, c = u.pn * BM + tid; t[512 + tid] = mod[b * 6144 + 2 * 1024 + c];
            const float g = norm_ffn[c] * (mod[b * 6144 + 4 * 1024 + c] + 1.0f); t[768 + tid] = (__builtin_fabsf(g) < 1e-30f) ? 1e-30f : g; }
    }
};

struct EpiGateUp {
    static constexpr bool PERM = true, AFTER_DRAIN = false, MIDSCALE = false; static constexpr int A_AUX = 0;
    bf16_t* H; PG8_LAS const float* tab;
    __device__ __forceinline__ void operator()(const f32x4 (&acc)[2][2][4][2], const Unit& u, int wr, int wc, int fr, int fq, int ui) const {
        PG8_LAS const float* t = tab + (ui & 1) * 512;
        f32x4 ba[2], bb[2];
#pragma unroll
        for (int n = 0; n < 2; ++n) { ba[n] = *(PG8_LAS const f32x4*)(t + 256 + wc * 32 + 8 * fq + 4 * n); bb[n] = *(PG8_LAS const f32x4*)(t + 256 + HALF + wc * 32 + 8 * fq + 4 * n); }
        const int hc0 = u.pn * HALF + wc * 32 + 8 * fq;
#pragma unroll
        for (int ai = 0; ai < 2; ++ai)
#pragma unroll
            for (int m = 0; m < 4; ++m) {
                const int rl = ai * HALF + wr * 64 + m * 16 + fr;
                const float rstd = t[rl];
                f32x4 hv[2];
#pragma unroll
                for (int n = 0; n < 2; ++n) { const f32x4 a = acc[ai][0][m][n] * rstd + ba[n], bq = acc[ai][1][m][n] * rstd + bb[n];
                    const f32x4 t = a * (-1.4426950408889634f); f32x4 d;
#pragma unroll
                    for (int e = 0; e < 4; ++e) d[e] = __builtin_amdgcn_exp2f(t[e]);
                    d = d + 1.0f; f32x4 r;
#pragma unroll
                    for (int e = 0; e < 4; ++e) r[e] = __builtin_amdgcn_rcpf(d[e]);
                    hv[n] = (a * bq) * r; }
                u32x4 w; w.x = cvt_pk_bf16(hv[0][0], hv[0][1]); w.y = cvt_pk_bf16(hv[0][2], hv[0][3]); w.z = cvt_pk_bf16(hv[1][0], hv[1][1]); w.w = cvt_pk_bf16(hv[1][2], hv[1][3]);

#ifdef MK_NT_H
                __builtin_nontemporal_store(w, (u32x4*)(H + tiled_off(u.pm * BM + rl, hc0, 44)));
#else
                *(u32x4*)(H + tiled_off(u.pm * BM + rl, hc0, 44)) = w;
#endif

            }
    }
};
__device__ __forceinline__ void pg8_glds16(const void* gsrc, unsigned lds_dst) { unsigned keep;
    asm volatile("s_mov_b32 %0, m0\n\ts_mov_b32 m0, %2\n\ts_nop 0\n\tglobal_load_lds_dwordx4 %1, off\n\ts_mov_b32 m0, %0" : "=&s"(keep) : "v"(gsrc), "s"(lds_dst) : "memory"); }
struct GateUpOrder : StaticOrder {
    const float* rstd3; const float* bias_t; PG8_LAS float* tab;
    __device__ __forceinline__ void a_ready(const Unit& u, int ui) const {
        if (__builtin_amdgcn_readfirstlane((int)threadIdx.x) < 64) {
            int lane = threadIdx.x; asm volatile("" : "+v"(lane));
            const unsigned dst = (unsigned)(uintptr_t)(tab + (ui & 1) * 512);
            pg8_glds16(rstd3 + (size_t)u.pm * BM + 4 * lane, (unsigned)__builtin_amdgcn_readfirstlane(dst));
            pg8_glds16(bias_t + (u.pm >> 4) * 5632 + u.pn * BM + 4 * lane, (unsigned)__builtin_amdgcn_readfirstlane(dst + 1024));
        }
    }
};

#ifndef MK_DOWN_AAUX
#define MK_DOWN_AAUX 0
#endif
struct EpiDown {
    static constexpr bool PERM = true, AFTER_DRAIN = false, MIDSCALE = false; static constexpr int A_AUX = MK_DOWN_AAUX;
    const bf16_t* A3; float* out; PG8_LAS const float* tab;
    __device__ __forceinline__ void operator()(const f32x4 (&acc)[2][2][4][2], const Unit& u, int wr, int wc, int fr, int fq, int ui) const {
        PG8_LAS const float* t = tab + (ui & 1) * 512;
        const int col0 = u.pn * BM + wc * 32 + 8 * fq, cl0 = wc * 32 + 8 * fq;
#pragma unroll
        for (int ai = 0; ai < 2; ++ai) {
            u32x4 hv[4][2];
#pragma unroll
            for (int m = 0; m < 4; ++m)
#pragma unroll
                for (int bj = 0; bj < 2; ++bj) hv[m][bj] = *(const u32x4*)(A3 + tiled_off(u.pm * BM + ai * HALF + wr * 64 + m * 16 + fr, col0 + bj * HALF, 16));
#pragma unroll
            for (int m = 0; m < 4; ++m) {
                const int row = u.pm * BM + ai * HALF + wr * 64 + m * 16 + fr;
#pragma unroll
                for (int bj = 0; bj < 2; ++bj)
#pragma unroll
                    for (int n = 0; n < 2; ++n) { const size_t off = (size_t)row * 1024 + col0 + bj * HALF + n * 4; const unsigned w0 = n ? hv[m][bj].z : hv[m][bj].x, w1 = n ? hv[m][bj].w : hv[m][bj].y;
                        const f32x4 gtv = *(PG8_LAS const f32x4*)(t + cl0 + bj * HALF + n * 4), giv = *(PG8_LAS const f32x4*)(t + 256 + cl0 + bj * HALF + n * 4);
                        const f32x4 h1 = (f32x4){__builtin_bit_cast(float, w0 << 16), __builtin_bit_cast(float, w0 & 0xffff0000u), __builtin_bit_cast(float, w1 << 16), __builtin_bit_cast(float, w1 & 0xffff0000u)} * giv;
                        { const f32x4 ov = h1 + gtv * acc[ai][bj][m][n];
#ifdef MK_NT_OUT
                        __builtin_nontemporal_store(ov, (f32x4*)(out + off));
#else
                        *(f32x4*)(out + off) = ov;
#endif
                        } }
            }
        }
    }
};
struct DownOrder : StaticOrder {
    const float* mod; const float* norm_ffn; PG8_LAS float* tab;
    __device__ __forceinline__ bool next(int i, Unit& u) const { const int nc = c < nwg ? (nwg - 1 - c) / G + 1 : 0; if (i >= nc) return false; return StaticOrder::next(nc - 1 - i, u); }
    __device__ __forceinline__ void a_ready(const Unit& u, int ui) const {
        int tid = threadIdx.x; asm volatile("" : "+v"(tid));
        PG8_LAS float* t = tab + (ui & 1) * 512;
        if (tid < 256) { const int b = u.pm >> 4, c = u.pn * BM + tid; t[tid] = mod[b * 6144 + 5 * 1024 + c];
            const float g = norm_ffn[c] * (mod[b * 6144 + 4 * 1024 + c] + 1.0f); t[256 + tid] = 1.0f / ((__builtin_fabsf(g) < 1e-30f) ? 1e-30f : g); }
    }
};

__device__ __forceinline__ void pg8_glds4_sc1(const void* gsrc, unsigned lds_dst) { unsigned keep;
    asm volatile("s_mov_b32 %0, m0\n\ts_mov_b32 m0, %2\n\ts_nop 0\n\tglobal_load_lds_dword %1, off sc1\n\ts_mov_b32 m0, %0" : "=&s"(keep) : "v"(gsrc), "s"(lds_dst) : "memory"); }
struct InProjOrder {
    StaticOrder so;
    const unsigned* cnt; PG8_LAS unsigned* flagp; int na; unsigned nb;
    __device__ __forceinline__ bool next(int i, Unit& u) const {
        const long L = (long)i * so.G + so.c;
        if (L < so.nwg) return so.next(i, u);
        const long r = L - so.nwg; if (r >= 8) return false;
        u.pm = 128 + (int)r; u.pn = 0; return true;
    }
    __device__ __forceinline__ int stage_of(const Unit& u) const { return (u.pm < 128 && (u.pm & 15) < na) ? 0 : 1; }
    __device__ __forceinline__ void spin(const Unit& u) const {
        const int st = stage_of(u); const unsigned* p = cnt + st; const unsigned want = st ? nb : 256u;
        for (unsigned sp = 0; __hip_atomic_load(p, __ATOMIC_RELAXED, __HIP_MEMORY_SCOPE_AGENT) < want && sp < (1u << 22); ++sp) __builtin_amdgcn_s_sleep(1);
    }
    __device__ __forceinline__ void a_poll(const Unit& u) const {
        if (cnt == nullptr) return;
        if (__builtin_amdgcn_readfirstlane((int)threadIdx.x) < 64) { int lane = threadIdx.x; asm volatile("" : "+v"(lane));
            if (lane == 0) pg8_glds4_sc1(cnt + stage_of(u), (unsigned)__builtin_amdgcn_readfirstlane((unsigned)(uintptr_t)flagp)); }
    }
    __device__ __forceinline__ void a_ready(const Unit& u, int ui) const {
        if (cnt == nullptr) return;
        if (ui == 0) { spin(u); return; }
        const unsigned seen = *(volatile PG8_LAS const unsigned*)flagp;
        if ((unsigned)__builtin_amdgcn_readfirstlane(seen) < (stage_of(u) ? nb : 256u)) spin(u);
    }
    __device__ __forceinline__ void done(const Unit&) const {}
};
template <class Epi, class Sched, bool ALIGN_EPI = false, bool SP2 = false>
__device__ __forceinline__ void gemm_phase(PG8_LAS unsigned char* lds, const Gemm g, const Sched& S, const Epi& E) {
    const int tid = threadIdx.x, wid = __builtin_amdgcn_readfirstlane(tid >> 6), lane = tid & 63, wr = wid >> 2, wc = wid & 3, fr = lane & 15, fq = lane >> 4;
    const int K = g.K, nt = K / BK;
    unsigned voffA[2], voffB[2];
#pragma unroll
    for (int i = 0; i < 2; ++i) { int R, C; stage_rc(tid * 16 + i * 8192, R, C); const int Rb = Epi::PERM ? ((R & ~31) + perm32(R & 31)) : R;
        voffA[i] = (unsigned)(R * BK + C) * 2u; voffB[i] = (unsigned)(Rb * BK + C) * 2u; }
    const size_t kstep = (size_t)(BM * BK * 2);
    const size_t hstep = (size_t)HALF * BK * 2;
    const size_t tstep = (size_t)BM * K * 2;
    const unsigned ldsw = (unsigned)wid * 1024u;
    const int aoff = lds_byte(wr * 64 + fr, fq * 8), boff = lds_byte(wc * 32 + fr, fq * 8);
#define PG8_SA(b, h) (((b) * 2 + (h)) * HTB)
#define PG8_SB(b, h) ((4 + (b) * 2 + (h)) * HTB)
#define PG8_STAGE(bufoff, gbase, voff) do { _Pragma("unroll") for (int _i = 0; _i < 2; ++_i) \
        __builtin_amdgcn_global_load_lds((const unsigned*)((const char*)(gbase) + (voff)[_i]), (PG8_LAS unsigned*)(lds + (bufoff) + ldsw + _i * 8192), 16, 0, 0); } while (0)
#define PG8_STAGE_A(bufoff, gbase, voff) do { _Pragma("unroll") for (int _i = 0; _i < 2; ++_i) \
        __builtin_amdgcn_global_load_lds((const unsigned*)((const char*)(gbase) + (voff)[_i]), (PG8_LAS unsigned*)(lds + (bufoff) + ldsw + _i * 8192), 16, 0, Epi::A_AUX); } while (0)
#define PG8_LDA(dst, b, h) do { _Pragma("unroll") for (int m = 0; m < 4; ++m) _Pragma("unroll") for (int k = 0; k < 2; ++k) dst[m][k] = *(const PG8_LAS bf16x8*)(lds + PG8_SA(b, h) + aoff + m * 2048 + k * 1024); } while (0)
#define PG8_LDB(dst, b, h) do { _Pragma("unroll") for (int n = 0; n < 2; ++n) _Pragma("unroll") for (int k = 0; k < 2; ++k) dst[n][k] = *(const PG8_LAS bf16x8*)(lds + PG8_SB(b, h) + boff + n * 2048 + k * 1024); } while (0)
#define PG8_MMA(ai, bj, At, Bt) do { __builtin_amdgcn_s_setprio(1); _Pragma("unroll") for (int m = 0; m < 4; ++m) _Pragma("unroll") for (int n = 0; n < 2; ++n) _Pragma("unroll") for (int k = 0; k < 2; ++k) \
        acc[ai][bj][m][n] = __builtin_amdgcn_mfma_f32_16x16x32_bf16(Bt[n][k], At[m][k], acc[ai][bj][m][n], 0, 0, 0); __builtin_amdgcn_s_setprio(0); } while (0)
#define PG8_WAIT_V(n) asm volatile("s_waitcnt vmcnt(" #n ")" ::: "memory")
#define PG8_WAIT_L(n) asm volatile("s_waitcnt lgkmcnt(" #n ")" ::: "memory")
#define PG8_BAR __builtin_amdgcn_s_barrier()
#define PG8_SCHED __builtin_amdgcn_sched_barrier(0)
    Unit cur, nxt; int ui = 0;
    if (!S.next(0, cur)) return;
    f32x4 acc[2][2][4][2];
#pragma unroll
    for (int a = 0; a < 2; ++a)
#pragma unroll
        for (int b = 0; b < 2; ++b)
#pragma unroll
            for (int m = 0; m < 4; ++m)
#pragma unroll
                for (int n = 0; n < 2; ++n) acc[a][b][m][n] = (f32x4){0.f, 0.f, 0.f, 0.f};
    bf16x8 At[4][2], B0[2][2], B1[2][2];
    const char* cA = (const char*)g.A + (size_t)cur.pm * tstep; const char* cB = (const char*)g.Bt + (size_t)cur.pn * tstep;
    S.a_ready(cur, 0);
    if constexpr (SP2) {
        PG8_STAGE(PG8_SB(0, 0), cB, voffB); PG8_STAGE(PG8_SB(0, 1), cB + hstep, voffB); PG8_STAGE_A(PG8_SA(0, 0), cA, voffA); PG8_STAGE_A(PG8_SA(0, 1), cA + hstep, voffA);
        if (wr == 1) PG8_BAR;
        PG8_WAIT_V(2); PG8_BAR;
        PG8_STAGE(PG8_SB(1, 0), cB + kstep, voffB); PG8_STAGE_A(PG8_SA(1, 0), cA + kstep, voffA); PG8_STAGE(PG8_SB(1, 1), cB + hstep + kstep, voffB);
        PG8_WAIT_V(6); PG8_BAR;
    } else {
        PG8_STAGE(PG8_SB(0, 0), cB, voffB); PG8_STAGE_A(PG8_SA(0, 0), cA, voffA); PG8_STAGE(PG8_SB(0, 1), cB + hstep, voffB); PG8_STAGE_A(PG8_SA(0, 1), cA + hstep, voffA);
        if (wr == 1) PG8_BAR;
        PG8_WAIT_V(4); PG8_BAR;
        PG8_STAGE(PG8_SB(1, 0), cB + kstep, voffB); PG8_STAGE_A(PG8_SA(1, 0), cA + kstep, voffA); PG8_STAGE(PG8_SB(1, 1), cB + hstep + kstep, voffB);
        PG8_WAIT_V(6); PG8_BAR;
    }
    for (;;) {
        const bool has_next = S.next(ui + 1, nxt);
        const char* nA = has_next ? (const char*)g.A + (size_t)nxt.pm * tstep : cA; const char* nB = has_next ? (const char*)g.Bt + (size_t)nxt.pn * tstep : cB;
        for (int t = 0; t < nt; t += 2) {
            if constexpr (Epi::MIDSCALE) { if (t == (nt >> 1)) E.midscale(acc, wr, fr, ui); }
            if (t == nt - 4 && has_next) S.a_poll(nxt);
            const bool last = (t == nt - 2);
            const char* a1 = cA + (size_t)(t + 1) * kstep;
            const char* a2 = last ? nA : cA + (size_t)(t + 2) * kstep; const char* b2 = last ? nB : cB + (size_t)(t + 2) * kstep;
            const char* a3 = a2 + kstep; const char* b3 = b2 + kstep;
            if (last && has_next) { S.a_ready(nxt, ui + 1);
#ifdef MK_HOOK_TWICE
            S.a_ready(nxt, ui + 1);
#endif
            }
            if constexpr (SP2) {
            PG8_LDB(B0, 0, 0); PG8_LDB(B1, 0, 1); PG8_SCHED; PG8_LDA(At, 0, 0); PG8_STAGE_A(PG8_SA(1, 1), a1 + hstep, voffA);
            PG8_WAIT_V(8); PG8_WAIT_L(0); PG8_BAR; PG8_MMA(0, 0, At, B0); PG8_MMA(0, 1, At, B1); PG8_BAR; PG8_SCHED;
            PG8_LDA(At, 0, 1); PG8_STAGE(PG8_SB(0, 0), b2, voffB); PG8_STAGE(PG8_SB(0, 1), b2 + hstep, voffB); PG8_STAGE_A(PG8_SA(0, 0), a2, voffA);
            PG8_WAIT_V(8); PG8_WAIT_L(0); PG8_BAR; PG8_MMA(1, 0, At, B0); PG8_MMA(1, 1, At, B1); PG8_BAR; PG8_SCHED;
            PG8_LDB(B0, 1, 0); PG8_LDB(B1, 1, 1); PG8_SCHED; PG8_LDA(At, 1, 0); PG8_STAGE_A(PG8_SA(0, 1), a2 + hstep, voffA);
            PG8_WAIT_V(8); PG8_WAIT_L(0); PG8_BAR; PG8_MMA(0, 0, At, B0); PG8_MMA(0, 1, At, B1); PG8_BAR; PG8_SCHED;
            PG8_LDA(At, 1, 1); PG8_STAGE(PG8_SB(1, 0), b3, voffB); PG8_STAGE(PG8_SB(1, 1), b3 + hstep, voffB); PG8_STAGE_A(PG8_SA(1, 0), a3, voffA);
            PG8_WAIT_V(8); PG8_WAIT_L(0); PG8_BAR; PG8_MMA(1, 0, At, B0); PG8_MMA(1, 1, At, B1); PG8_BAR; PG8_SCHED;
            } else {
            PG8_LDB(B0, 0, 0); PG8_SCHED; PG8_LDA(At, 0, 0); PG8_STAGE_A(PG8_SA(1, 1), a1 + hstep, voffA);
            PG8_WAIT_L(8); PG8_BAR; PG8_WAIT_L(0); PG8_MMA(0, 0, At, B0); PG8_BAR; PG8_SCHED;
            PG8_LDB(B1, 0, 1); PG8_STAGE(PG8_SB(0, 0), b2, voffB);
            PG8_BAR; PG8_WAIT_L(0); PG8_MMA(0, 1, At, B1); PG8_BAR;
            PG8_LDA(At, 0, 1); PG8_STAGE_A(PG8_SA(0, 0), a2, voffA);
            PG8_BAR; PG8_WAIT_L(0); PG8_MMA(1, 0, At, B0); PG8_BAR; PG8_SCHED;
            PG8_STAGE(PG8_SB(0, 1), b2 + hstep, voffB);
            PG8_WAIT_V(6); PG8_BAR; PG8_MMA(1, 1, At, B1); PG8_BAR;
            PG8_LDB(B0, 1, 0); PG8_SCHED; PG8_LDA(At, 1, 0); PG8_STAGE_A(PG8_SA(0, 1), a2 + hstep, voffA);
            PG8_WAIT_L(8); PG8_BAR; PG8_WAIT_L(0); PG8_MMA(0, 0, At, B0); PG8_BAR; PG8_SCHED;
            PG8_LDB(B1, 1, 1); PG8_STAGE(PG8_SB(1, 0), b3, voffB);
            PG8_BAR; PG8_WAIT_L(0); PG8_MMA(0, 1, At, B1); PG8_BAR;
            PG8_LDA(At, 1, 1); PG8_STAGE_A(PG8_SA(1, 0), a3, voffA);
            PG8_BAR; PG8_WAIT_L(0); PG8_MMA(1, 0, At, B0); PG8_BAR; PG8_SCHED;
            PG8_STAGE(PG8_SB(1, 1), b3 + hstep, voffB);
            PG8_WAIT_V(6); PG8_BAR; PG8_MMA(1, 1, At, B1); PG8_BAR;
            }
        }
        if constexpr (ALIGN_EPI) { if (wr == 0) PG8_BAR; }
        if constexpr (!Epi::AFTER_DRAIN) { E(acc, cur, wr, wc, fr, fq, ui); S.done(cur); }
        if (!has_next) break;
#pragma unroll
        for (int a = 0; a < 2; ++a)
#pragma unroll
            for (int b = 0; b < 2; ++b)
#pragma unroll
                for (int m = 0; m < 4; ++m)
#pragma unroll
                    for (int n = 0; n < 2; ++n) acc[a][b][m][n] = (f32x4){0.f, 0.f, 0.f, 0.f};
        cur = nxt; cA = nA; cB = nB; ++ui;
        if constexpr (ALIGN_EPI) { if (wr == 1) PG8_BAR; }
    }
    PG8_WAIT_V(0);
    if constexpr (!ALIGN_EPI) { if (wr == 0) PG8_BAR; }
    PG8_BAR;
    if constexpr (Epi::AFTER_DRAIN) { E.fused(acc, cur, wr, wc, fr, fq, lds, wid, lane); S.done(cur); }
#undef PG8_SA
#undef PG8_SB
#undef PG8_STAGE
#undef PG8_STAGE_A
#undef PG8_LDA
#undef PG8_LDB
#undef PG8_MMA
#undef PG8_WAIT_V
#undef PG8_WAIT_L
#undef PG8_BAR
#undef PG8_SCHED
}
}
constexpr int NWAVES = 8;
#ifndef MK_CUTS
#define MK_CUTS 0
#endif
constexpr int N_PHASES = 7;

constexpr int BATCH = 8, SEQ = 4096, DM = 1024, CTXL = 256;
constexpr int MROWS = BATCH * SEQ;
constexpr int CROWS = BATCH * CTXL;
constexpr int INW = 1792, FFH = 2816, NMOD = 6 * DM;
constexpr float LOG2E = 1.4426950408889634f;

constexpr size_t MiB = 1u << 20;
constexpr size_t WS_CTL = 0, CTL_ZERO_BYTES = 128 * 1024;
constexpr size_t WS_MOD = 1 * MiB;
constexpr size_t WS_ROPE = WS_MOD + 256 * 1024;
constexpr size_t WS_BIAS = WS_ROPE + 64 * 1024;
constexpr size_t WS_SSQ3 = 2 * MiB;
constexpr size_t WS_WIN = 4 * MiB, WS_WOUT = 8 * MiB, WS_WGU = 10 * MiB, WS_WDN = 21 * MiB;
constexpr size_t WS_SSQ2 = 27 * MiB;
constexpr size_t WS_WSP = 29 * MiB;
constexpr size_t WS_RSTD3 = 30 * MiB;
constexpr size_t WS_XN = 32 * MiB;
constexpr size_t WS_A2 = WS_XN;
constexpr size_t WS_Y = 100 * MiB;
constexpr size_t WS_YC = 212 * MiB;
constexpr size_t WS_A3 = 216 * MiB;
constexpr size_t WS_H = 280 * MiB;
constexpr size_t WS_KV = 456 * MiB;
constexpr size_t WS_END = 472 * MiB;
static_assert(WS_BIAS + 8 * 5632 * 4 <= WS_SSQ3 && WS_WDN + (size_t)1024 * 2816 * 2 <= WS_SSQ2 && WS_SSQ2 + 2 * MiB <= WS_WSP && WS_WSP + 262144 <= WS_XN && WS_XN + (size_t)34816 * 2048 <= WS_Y && WS_Y + (size_t)MROWS * INW * 2 <= WS_YC && WS_YC + (size_t)CROWS * 512 <= WS_A3 && WS_A3 + (size_t)MROWS * 2048 <= WS_H && WS_H + (size_t)MROWS * FFH * 2 <= WS_END, "d_ws map");
constexpr int CW_TMO = 0, CW_CODE = 1;
constexpr int CW_BIASF = 28800;
constexpr int CW_RT = 28928;
constexpr int CW_BAR = 4096;

constexpr int RING_OFF = 0, RING_BYTES = 131072;
constexpr int LDSCTL_OFF = RING_BYTES, MISC_OFF = LDSCTL_OFF + 320;
constexpr int LDS_BYTES = 147456;

#define GAS __attribute__((address_space(1)))
#define LAS __attribute__((address_space(3)))
typedef unsigned short bf16;
typedef unsigned v4u __attribute__((ext_vector_type(4)));
typedef float f32x4 __attribute__((ext_vector_type(4)));
typedef short bf16x8 __attribute__((ext_vector_type(8)));
typedef GAS unsigned gu32;
typedef GAS unsigned long long gu64;
#define RLX_AGENT __ATOMIC_RELAXED, __HIP_MEMORY_SCOPE_AGENT
#define LDS_WAIT() asm volatile("s_waitcnt lgkmcnt(0)" ::: "memory")
#define VM_WAIT() asm volatile("s_waitcnt vmcnt(0)" ::: "memory")
__device__ __forceinline__ unsigned long long rt() { return __builtin_amdgcn_s_memrealtime(); }
__device__ __forceinline__ unsigned f2bf(float f) { unsigned u = __builtin_bit_cast(unsigned, f); return (u + 0x7fffu + ((u >> 16) & 1u)) >> 16; }
__device__ __forceinline__ unsigned pk2(float lo, float hi) { return f2bf(lo) | (f2bf(hi) << 16); }
#define XB_TMO      128
#define XB_XCNT(j)  (256  + 64 * (j))
#define XB_XSUB(j)  (1280 + 64 * (j))
#define XB_XGEN(j)  (2304 + 64 * (j))
#define XB_TOP      3328
#define XB_TOPGEN   3392
#define XCD_BAR_WORDS 3456
#define XB_SPIN_CAP (1u << 22)

__device__ __forceinline__ unsigned xb_ld(unsigned* p)              { return __hip_atomic_load(p, __ATOMIC_RELAXED, __HIP_MEMORY_SCOPE_AGENT); }
__device__ __forceinline__ unsigned xb_add(unsigned* p, unsigned v) { return __hip_atomic_fetch_add(p, v, __ATOMIC_RELAXED, __HIP_MEMORY_SCOPE_AGENT); }
__device__ __forceinline__ unsigned xb_xcc_id() { return (unsigned)__builtin_amdgcn_s_getreg((3 << 11) | 20) & 0xFu; }
#define XB_SPIN(cond, bar) do { unsigned _sp = 0; while (cond) { __builtin_amdgcn_s_sleep(1); \
    if ((++_sp & 255u) == 0u) { if (xb_ld(&(bar)[XB_TMO])) break; if (_sp > XB_SPIN_CAP) { atomicAdd(&(bar)[XB_TMO], 1u); break; } } } } while (0)

struct XcdBarrier {
    unsigned* bar; unsigned x;
    volatile LAS unsigned* st;
};

__device__ __forceinline__ XcdBarrier xcd_barrier_post(unsigned* bar, volatile LAS unsigned* st) {
    XcdBarrier b; b.bar = bar; b.x = xb_xcc_id(); b.st = st;
    if (threadIdx.x == 0) st[3] = xb_add(&bar[XB_XCNT(b.x)], 1u);
    return b;
}
__device__ __forceinline__ void xcd_barrier_complete(unsigned* bar, unsigned x, unsigned& nloc, unsigned& nx, unsigned& uni) {
    const unsigned G = gridDim.x * gridDim.y * gridDim.z;
    unsigned sum, cnt, mine, even, sp = 0u;
    for (;;) {
        sum = 0u; cnt = 0u; mine = 0u; even = 1u;
#pragma unroll
        for (unsigned j = 0; j < 16; ++j) { const unsigned c = xb_ld(&bar[XB_XCNT(j)]); sum += c; cnt += (c > 0u) ? 1u : 0u; mine = (j == x) ? c : mine; even &= (c == ((j < 8u) ? (G >> 3) : 0u)) ? 1u : 0u; }
        if (sum == G) break;
        __builtin_amdgcn_s_sleep(1);
        if ((++sp & 255u) == 0u) { if (xb_ld(&bar[XB_TMO])) break; if (sp > XB_SPIN_CAP) { atomicAdd(&bar[XB_TMO], 1u); break; } }
    }
    nloc = mine > 0u ? mine : 1u; nx = cnt > 0u ? cnt : 1u; uni = (sum == G && (G & 7u) == 0u && even) ? 1u : 2u;
}

__device__ __forceinline__ void xcd_barrier(const XcdBarrier& b, bool local = false) {
    asm volatile("s_waitcnt vmcnt(0)" ::: "memory");
    __syncthreads();
    if (threadIdx.x == 0) {
        unsigned* bar = b.bar;
        __builtin_amdgcn_s_waitcnt(0);
        unsigned nloc = b.st[0], nx = b.st[1];
        if (nloc == 0u) { unsigned uni; xcd_barrier_complete(bar, b.x, nloc, nx, uni); b.st[0] = nloc; b.st[1] = nx; b.st[2] = uni; }
        const unsigned old = xb_add(&bar[XB_XSUB(b.x)], 1u);
        const unsigned gen = old / nloc;
        if (old + 1u == (gen + 1u) * nloc && local) {
            __builtin_amdgcn_fence(__ATOMIC_ACQUIRE, "agent");
            xb_add(&bar[XB_XGEN(b.x)], 1u);
            asm volatile("s_waitcnt vmcnt(0)" ::: "memory");
        } else if (old + 1u == (gen + 1u) * nloc) {
            __builtin_amdgcn_fence(__ATOMIC_RELEASE, "agent");
            asm volatile("s_waitcnt vmcnt(0)" ::: "memory");
            const unsigned og = xb_add(&bar[XB_TOP], 1u);
            const unsigned tg = og / nx;
            if (og + 1u == (tg + 1u) * nx) xb_add(&bar[XB_TOPGEN], 1u);
            else XB_SPIN(xb_ld(&bar[XB_TOPGEN]) == tg, bar);
            __builtin_amdgcn_fence(__ATOMIC_ACQUIRE, "agent");
            xb_add(&bar[XB_XGEN(b.x)], 1u);
            asm volatile("s_waitcnt vmcnt(0)" ::: "memory");
        } else {
            XB_SPIN(xb_ld(&bar[XB_XGEN(b.x)]) == gen, bar);
            __builtin_amdgcn_fence(__ATOMIC_ACQUIRE, "agent");
            asm volatile("s_waitcnt vmcnt(0)" ::: "memory");
        }
    }
    __syncthreads();
}
struct Frame {
    LAS unsigned char* lds;
    volatile LAS unsigned* MISC;
    gu32* ctl;
    int tid, lane, wave;
    int vcu, G, cid, xcc, uni;
    const float *x, *c, *ctx, *c_ctx, *w_mod, *b_mod, *norm_mix, *norm_ffn, *w_in, *q_gain, *k_gain, *attn_sink, *gate_gain, *w_spatial, *b_spatial, *attn_out_gain, *mlp_out_gain, *w_out, *w_gate_up, *w_down;
    float* out;
    float *mod, *rope, *bias_t, *ssq3, *ssq2, *rstd3;
    bf16 *Win_t, *Wout_t, *Wgu_t, *Wdn_t, *XN, *Y, *Yc, *H, *A2, *A3, *Wsp, *KV;
};
__device__ __forceinline__ float bf2f(unsigned h) { return __builtin_bit_cast(float, h << 16); }
__device__ __forceinline__ float wave_sum(float v) {
#pragma unroll
    for (int o = 1; o < 64; o <<= 1) v += __shfl_xor(v, o);
    return v;
}
__device__ __forceinline__ float wave_max(float v) {
#pragma unroll
    for (int o = 1; o < 64; o <<= 1) v = fmaxf(v, __shfl_xor(v, o));
    return v;
}

__device__ __forceinline__ int dst_row(int mat, int n) {
    if (mat == 0) {
        const int head = n >> 6, d = n & 63, bj = d >> 5, l = d & 31;
        const bool rp = head < 2 || (head >= 4 && head < 12);
        const int p = rp ? (8 * ((l >> 2) & 3) + 4 * (l >> 4) + (l & 3)) : l;
        return 256 * (head >> 2) + 128 * bj + 32 * (head & 3) + p;
    }
    if (mat == 2) { const int bj = n >= FFH ? 1 : 0, j = n - FFH * bj; return 256 * (j >> 7) + 128 * bj + (j & 127); }
    return n;
}
__device__ __forceinline__ void p0_transpose_item(const float* W, int K, int N, bf16* WT, int mat, const float* g0, const float* g1, LAS float* scr, int item, int lane) {
    const int nblk = N / 32, kb = item / nblk, nb = item % nblk, k0 = 64 * kb, n0 = 32 * nb;
    const unsigned loff = (unsigned)((lane >> 5) * N + (lane & 31)); const float* wb = W + (size_t)k0 * N + n0;
#pragma unroll
    for (int i0 = 0; i0 < 32; i0 += 16) {
        float v[16];
#pragma unroll
        for (int i = 0; i < 16; ++i) v[i] = __builtin_nontemporal_load(wb + (size_t)(2 * (i0 + i)) * N + loff);
        __builtin_amdgcn_sched_barrier(0);
#pragma unroll
        for (int i = 0; i < 16; ++i) scr[(2 * (i0 + i) + (lane >> 5)) * 33 + (lane & 31)] = v[i];
        __builtin_amdgcn_sched_barrier(0);
    }
    LDS_WAIT(); asm volatile("" ::: "memory");
    const int c = lane & 7;
    float gk[8];
#pragma unroll
    for (int i = 0; i < 8; ++i) { const int k = k0 + 8 * c + i; gk[i] = (mat == 1) ? (k < 512 ? g0[k] : g1[k - 512]) : 1.0f; }
#pragma unroll
    for (int j = 0; j < 4; ++j) { const int n = (lane >> 3) + 8 * j; const LAS float* s = scr + (8 * c) * 33 + n;
        v4u o; o.x = pk2(s[0 * 33] * gk[0], s[1 * 33] * gk[1]); o.y = pk2(s[2 * 33] * gk[2], s[3 * 33] * gk[3]); o.z = pk2(s[4 * 33] * gk[4], s[5 * 33] * gk[5]); o.w = pk2(s[6 * 33] * gk[6], s[7 * 33] * gk[7]);
        *(GAS v4u*)(WT + pg8::tiled_off(dst_row(mat, n0 + n), k0 + 8 * c, K / 64)) = o; }
    LDS_WAIT(); asm volatile("" ::: "memory");
}
__device__ __forceinline__ void p0_prologue(Frame& F) {
#ifdef MK_P0A_TWICE
    for (int repa = 0; repa < 2; ++repa)
#endif
    if (F.vcu < NMOD / 32) {
        LAS float* sc = (LAS float*)(F.lds);
        LAS float* red = (LAS float*)(F.lds + 36864);
        { float cv[18];
#pragma unroll
          for (int j = 0; j < 18; ++j) { const int k = 512 * (j & 1) + F.tid; cv[j] = (j < 16) ? F.c[(j >> 1) * DM + k] : F.c_ctx[k]; }
          __builtin_amdgcn_sched_barrier(0);
#pragma unroll
          for (int j = 0; j < 18; ++j) { const float v = cv[j]; sc[512 * j + F.tid] = v / (1.0f + __expf(-v)); } }
        __syncthreads();
        for (int item = F.vcu; item < NMOD / 32; item += F.G) {
            const int kg = F.tid >> 5; const unsigned loff = (unsigned)(kg * NMOD + (F.tid & 31));
            const float* wb = F.w_mod + item * 32;
            float a[9];
#pragma unroll
            for (int n = 0; n < 9; ++n) a[n] = 0.f;
#pragma unroll
            for (int i0 = 0; i0 < DM / 16; i0 += 16) {
                float w[16];
#pragma unroll
                for (int i = 0; i < 16; ++i) w[i] = __builtin_nontemporal_load(wb + (size_t)(i0 + i) * 16 * NMOD + loff);
                __builtin_amdgcn_sched_barrier(0);
#pragma unroll
                for (int i = 0; i < 16; ++i) { const int k = 16 * (i0 + i) + kg;
#pragma unroll
                    for (int n = 0; n < 9; ++n) a[n] += sc[n * DM + k] * w[i]; }
                __builtin_amdgcn_sched_barrier(0);
            }
#pragma unroll
            for (int n = 0; n < 9; ++n) red[(kg * 9 + n) * 32 + (F.tid & 31)] = a[n];
            __syncthreads();
            if (F.tid < 288) { const int n = F.tid >> 5, cc = F.tid & 31; float s = 0.f;
#pragma unroll
                for (int g = 0; g < 16; ++g) s += red[(g * 9 + n) * 32 + cc];
                F.mod[n * NMOD + item * 32 + cc] = s + F.b_mod[item * 32 + cc]; }
            __syncthreads();
        }
    }
    { const int gt = F.vcu * NWAVES * 64 + F.tid;
      if (gt < 1024) { const int pos = gt >> 4, f = gt & 15; const float inv = powf(10000.0f, -(float)(2 * f) / 32.0f); const float ang = (float)pos * inv; F.rope[2 * gt] = cosf(ang); F.rope[2 * gt + 1] = sinf(ang); } }
    for (int it = F.vcu * NWAVES * 64 + F.tid; it < 8 * 128 * 16; it += F.G * NWAVES * 64) {
        const int hp = it >> 4, ks = (it >> 1) & 7, hi = it & 1;
        const float* srcp = F.w_spatial + (size_t)hp * 128 + 16 * ks + 4 * hi;
        const f32x4 a0 = *(const f32x4*)srcp, a1 = *(const f32x4*)(srcp + 8);
        v4u o; o.x = pk2(a0[0], a0[1]); o.y = pk2(a0[2], a0[3]); o.z = pk2(a1[0], a1[1]); o.w = pk2(a1[2], a1[3]);
        *(GAS v4u*)(F.Wsp + (size_t)hp * 128 + 16 * ks + 8 * hi) = o; }
    __syncthreads();
    LAS float* scr = (LAS float*)(F.lds + RING_OFF + F.wave * 16384);
    const int gw = F.vcu * NWAVES + F.wave, NGW = F.G * NWAVES;
    constexpr int I_IN = (DM / 64) * (INW / 32), I_OUT = (DM / 64) * (DM / 32), I_GU = (DM / 64) * (2 * FFH / 32), I_DN = (FFH / 64) * (DM / 32);
    constexpr int NITEMS = I_IN + I_OUT + I_GU + I_DN;
#ifdef MK_P0C_TWICE
    for (int repc = 0; repc < 2; ++repc)
#endif
    for (int it = gw; it < NITEMS; it += NGW) {
        int r = it;
        if (r < I_IN) { p0_transpose_item(F.w_in, DM, INW, F.Win_t, 0, nullptr, nullptr, scr, r, F.lane); continue; } r -= I_IN;
        if (r < I_OUT) { p0_transpose_item(F.w_out, DM, DM, F.Wout_t, 1, F.attn_out_gain, F.mlp_out_gain, scr, r, F.lane); continue; } r -= I_OUT;
        if (r < I_GU) { p0_transpose_item(F.w_gate_up, DM, 2 * FFH, F.Wgu_t, 2, nullptr, nullptr, scr, r, F.lane); continue; } r -= I_GU;
        p0_transpose_item(F.w_down, FFH, DM, F.Wdn_t, 3, nullptr, nullptr, scr, r, F.lane);
    }
}
#ifndef MK_NA
#define MK_NA 14
#endif
constexpr int P12_NA = MK_NA;
constexpr int P12_RANK_L = 17, P12_NWL = (32 - P12_RANK_L) * NWAVES;
constexpr int P12_NB = (17 - P12_NA) * 256;
__device__ __forceinline__ void p1_two_rows(Frame& F, int r0, int r1, bool has1) {
    const float* src0 = r0 < MROWS ? F.x + (size_t)r0 * DM : F.ctx + (size_t)(r0 - MROWS) * DM;
    const float* src1 = r1 < MROWS ? F.x + (size_t)r1 * DM : F.ctx + (size_t)(r1 - MROWS) * DM;
    f32x4 v0[4], v1[4]; float s0 = 0.f, s1 = 0.f;
#pragma unroll
    for (int j = 0; j < 4; ++j) { v0[j] = __builtin_nontemporal_load((const GAS f32x4*)src0 + F.lane + 64 * j); v1[j] = __builtin_nontemporal_load((const GAS f32x4*)src1 + F.lane + 64 * j); }
#pragma unroll
    for (int j = 0; j < 4; ++j) { s0 += (v0[j].x * v0[j].x + v0[j].y * v0[j].y) + (v0[j].z * v0[j].z + v0[j].w * v0[j].w); s1 += (v1[j].x * v1[j].x + v1[j].y * v1[j].y) + (v1[j].z * v1[j].z + v1[j].w * v1[j].w); }
    const float rstd0 = 1.0f / sqrtf(wave_sum(s0) * (1.0f / DM) + 1e-6f), rstd1 = 1.0f / sqrtf(wave_sum(s1) * (1.0f / DM) + 1e-6f);
#pragma unroll
    for (int rr = 0; rr < 2; ++rr) { if (rr == 1 && !has1) break;
        const int r = rr ? r1 : r0; const float rstd = rr ? rstd1 : rstd0;
        const float* md = F.mod + (r < MROWS ? (r >> 12) : 8) * NMOD;
#pragma unroll
        for (int j = 0; j < 4; ++j) { const int cidx = 4 * F.lane + 256 * j;
            const f32x4 g = *(const f32x4*)(F.norm_mix + cidx), sh = *(const f32x4*)(md + cidx), sc = *(const f32x4*)(md + DM + cidx);
            const f32x4 y = ((rr ? v1[j] : v0[j]) * rstd) * g * (sc + 1.0f) + sh;
            *(GAS unsigned long long*)(F.XN + pg8::tiled_off(r, cidx, 16)) = (unsigned long long)pk2(y.x, y.y) | ((unsigned long long)pk2(y.z, y.w) << 32); } }
}
__device__ __forceinline__ void p1_norm_rows(Frame& F) {
    const int gw = F.vcu * NWAVES + F.wave, NGW = F.G * NWAVES;
    if (F.uni) {
        const int rank = F.vcu & 31, wl = rank * NWAVES + F.wave;
        unsigned* cnt = (unsigned*)F.ctl + CW_RT + F.xcc * 32;
#pragma unroll 1
        for (int k0 = 0; k0 < P12_NA; k0 += 2) { const bool has1 = k0 + 1 < P12_NA; p1_two_rows(F, F.xcc * SEQ + wl + 256 * k0, F.xcc * SEQ + wl + 256 * (has1 ? k0 + 1 : k0), has1); }
        asm volatile("s_waitcnt vmcnt(0)" ::: "memory");
        if (F.lane == 0) __hip_atomic_fetch_add(cnt, 1u, __ATOMIC_RELAXED, __HIP_MEMORY_SCOPE_AGENT);
        if (rank >= P12_RANK_L) {
            const int wlL = (rank - P12_RANK_L) * NWAVES + F.wave;
#pragma unroll 1
            for (int j0 = wlL; j0 < P12_NB; j0 += 2 * P12_NWL) {
                const int j1 = j0 + P12_NWL; const bool has1 = j1 < P12_NB; const int jc = has1 ? j1 : j0;
                const int r0 = j0 < (16 - P12_NA) * 256 ? F.xcc * SEQ + P12_NA * 256 + j0 : MROWS + F.xcc * CTXL + (j0 - (16 - P12_NA) * 256);
                const int r1 = jc < (16 - P12_NA) * 256 ? F.xcc * SEQ + P12_NA * 256 + jc : MROWS + F.xcc * CTXL + (jc - (16 - P12_NA) * 256);
                p1_two_rows(F, r0, r1, has1);
            }
            asm volatile("s_waitcnt vmcnt(0)" ::: "memory");
            if (F.lane == 0) __hip_atomic_fetch_add(cnt + 1, 1u, __ATOMIC_RELAXED, __HIP_MEMORY_SCOPE_AGENT);
        }
    } else {
        const int nk = (MROWS + CROWS - gw + NGW - 1) / NGW;
#pragma unroll 1
        for (int k0 = 0; k0 < nk; k0 += 2) { const bool has1 = k0 + 1 < nk; p1_two_rows(F, gw + NGW * k0, has1 ? gw + NGW * (k0 + 1) : gw + NGW * k0, has1); }
    }
#ifdef MK_BIAS_TWICE
    for (int brep = 0; brep < 2; ++brep)
#endif
#pragma unroll 1
    for (int R0 = gw; R0 < 2 * FFH; R0 += 3 * NGW) {
        v4u w0[3], w1[3]; f32x4 shv[BATCH][4];
#pragma unroll
        for (int k = 0; k < 3; ++k) { const int R = R0 + NGW * k, Rc = R < 2 * FFH ? R : R0;
            w0[k] = *(const GAS v4u*)(F.Wgu_t + pg8::tiled_off(Rc, 16 * F.lane, 16)); w1[k] = *(const GAS v4u*)(F.Wgu_t + pg8::tiled_off(Rc, 16 * F.lane, 16) + 8); }
#pragma unroll
        for (int b = 0; b < BATCH; ++b)
#pragma unroll
            for (int i = 0; i < 4; ++i) shv[b][i] = *(const f32x4*)(F.mod + b * NMOD + 3 * DM + 16 * F.lane + 4 * i);
        __builtin_amdgcn_sched_barrier(0);
#pragma unroll
        for (int k = 0; k < 3; ++k) { float wf[16]; const int R = R0 + NGW * k;
#pragma unroll
            for (int i = 0; i < 4; ++i) { wf[2 * i] = bf2f(w0[k][i] & 0xffffu); wf[2 * i + 1] = bf2f(w0[k][i] >> 16); wf[8 + 2 * i] = bf2f(w1[k][i] & 0xffffu); wf[8 + 2 * i + 1] = bf2f(w1[k][i] >> 16); }
            float s[BATCH];
#pragma unroll
            for (int b = 0; b < BATCH; ++b) { s[b] = 0.f;
#pragma unroll
                for (int i = 0; i < 4; ++i) { const f32x4 t = shv[b][i]; s[b] += (t[0] * wf[4 * i] + t[1] * wf[4 * i + 1]) + (t[2] * wf[4 * i + 2] + t[3] * wf[4 * i + 3]); } }
#pragma unroll
            for (int o = 1; o < 64; o <<= 1) {
#pragma unroll
                for (int b = 0; b < BATCH; ++b) s[b] += __shfl_xor(s[b], o); }
            if (F.lane == 0 && R < 2 * FFH) {
#pragma unroll
                for (int b = 0; b < BATCH; ++b) __hip_atomic_store(F.bias_t + b * 2 * FFH + R, s[b], __ATOMIC_RELAXED, __HIP_MEMORY_SCOPE_AGENT); } }
    }
    asm volatile("s_waitcnt vmcnt(0)" ::: "memory");
    if (F.lane == 0) __hip_atomic_fetch_add((unsigned*)F.ctl + CW_BIASF, 1u, __ATOMIC_RELAXED, __HIP_MEMORY_SCOPE_AGENT);
}

namespace mix {
typedef short bf16x8 __attribute__((ext_vector_type(8)));
typedef short s16x4 __attribute__((ext_vector_type(4)));
typedef float f32x16 __attribute__((ext_vector_type(16)));
typedef LAS const char* lcp;
constexpr int SLOT = 32768;
constexpr int L_OST = 98304, L_WSF = LDSCTL_OFF + 1024;
constexpr int L_GT = 0;
__device__ __forceinline__ int crow(int r, int hi) { return (r & 3) + 8 * (r >> 2) + 4 * hi; }
__device__ __forceinline__ void glds16(const void* gsrc, unsigned lds_dst) { unsigned keep;
    asm volatile("s_mov_b32 %0, m0\n\ts_mov_b32 m0, %2\n\ts_nop 0\n\tglobal_load_lds_dwordx4 %1, off\n\ts_mov_b32 m0, %0" : "=&s"(keep) : "v"(gsrc), "s"(lds_dst) : "memory"); }
typedef float f32x2_t __attribute__((ext_vector_type(2))); typedef __bf16 bf16x2_t __attribute__((ext_vector_type(2)));
__device__ __forceinline__ unsigned cvtpk_s(float lo, float hi) { f32x2_t v = {lo, hi}; bf16x2_t b = __builtin_convertvector(v, bf16x2_t); return __builtin_bit_cast(unsigned, b); }
#define MIX_SBAR() __builtin_amdgcn_sched_barrier(0)
#define MIX_WAIT_BAR() asm volatile("s_waitcnt vmcnt(0) lgkmcnt(0)\n\ts_barrier" ::: "memory")
__device__ __forceinline__ void qkt(f32x16& p0, f32x16& p1, lcp Kslot, const bf16x8* qr, int r32, int hi) {
    lcp kb = Kslot + hi * 1024 + r32 * 16;
    f32x16 z0 = {}, z1 = {};
#pragma unroll
    for (int d0 = 0; d0 < 4; ++d0) {
        const bf16x8 b0 = *(LAS const bf16x8*)(kb + d0 * 2048), b1 = *(LAS const bf16x8*)(kb + d0 * 2048 + 512);
        z0 = __builtin_amdgcn_mfma_f32_32x32x16_bf16(b0, qr[d0], z0, 0, 0, 0); z1 = __builtin_amdgcn_mfma_f32_32x32x16_bf16(b1, qr[d0], z1, 0, 0, 0); }
    p0 = z0; p1 = z1;
}
__device__ __forceinline__ void pv(f32x16* o, int vb, bf16x8 pa0, bf16x8 pa1, bf16x8 pa2, bf16x8 pa3) {
#pragma unroll
    for (int d0 = 0; d0 < 2; ++d0) { s16x4 lo[4], hi[4];
#pragma unroll
        for (int ks = 0; ks < 4; ++ks) {
            asm volatile("ds_read_b64_tr_b16 %0,%1 offset:%c2" : "=&v"(lo[ks]) : "v"(vb), "i"(d0 * 4096 + ks * 1024) : "memory");
            asm volatile("ds_read_b64_tr_b16 %0,%1 offset:%c2" : "=&v"(hi[ks]) : "v"(vb), "i"(d0 * 4096 + ks * 1024 + 512) : "memory"); }
        asm volatile("s_waitcnt lgkmcnt(0)" ::: "memory"); MIX_SBAR();
#define MIX_PK(k) (bf16x8){lo[k][0], lo[k][1], lo[k][2], lo[k][3], hi[k][0], hi[k][1], hi[k][2], hi[k][3]}
        o[d0] = __builtin_amdgcn_mfma_f32_32x32x16_bf16(pa0, MIX_PK(0), o[d0], 0, 0, 0);
        o[d0] = __builtin_amdgcn_mfma_f32_32x32x16_bf16(pa1, MIX_PK(1), o[d0], 0, 0, 0);
        o[d0] = __builtin_amdgcn_mfma_f32_32x32x16_bf16(pa2, MIX_PK(2), o[d0], 0, 0, 0);
        o[d0] = __builtin_amdgcn_mfma_f32_32x32x16_bf16(pa3, MIX_PK(3), o[d0], 0, 0, 0);
#undef MIX_PK
    }
}
__device__ __forceinline__ void store_pair16(bf16* p, unsigned (&wa)[2], unsigned (&wb)[2]) {
    auto r0 = __builtin_amdgcn_permlane32_swap(wa[0], wb[0], false, false); auto r1 = __builtin_amdgcn_permlane32_swap(wa[1], wb[1], false, false);
    v4u w; w.x = r0[0]; w.y = r1[0]; w.z = r0[1]; w.w = r1[1];
    *(GAS v4u*)p = w;
}
typedef short v4i16_t __attribute__((ext_vector_type(4)));
__device__ __forceinline__ s16x4 vtr(lcp p) { return __builtin_bit_cast(s16x4, __builtin_amdgcn_ds_read_tr16_b64_v4i16((LAS v4i16_t*)p)); }
__device__ __forceinline__ bf16x8 pack8(const f32x16& p, int b0) {
    v4u w; w.x = cvtpk_s(p[b0], p[b0 + 1]); w.y = cvtpk_s(p[b0 + 2], p[b0 + 3]); w.z = cvtpk_s(p[b0 + 4], p[b0 + 5]); w.w = cvtpk_s(p[b0 + 6], p[b0 + 7]); return __builtin_bit_cast(bf16x8, w); }

__device__ __forceinline__ void gmlp_dma(Frame& F, int b, int blk) {
    unsigned ln = (unsigned)F.lane; asm volatile("" : "+v"(ln));
    const int h = F.wave; const size_t row0 = (size_t)b * SEQ + blk * 128;
    const unsigned gslot = (unsigned)(uintptr_t)F.lds + L_GT + h * 16384;
    const bf16* base = F.Y + row0 * INW + 1280 + 64 * h + ((ln >> 2) * (unsigned)INW + (ln & 3u) * 8u);
#pragma unroll
    for (int qt = 0; qt < 2; ++qt)
#pragma unroll
        for (int w = 0; w < 8; ++w)
            glds16(base + (size_t)(64 * qt + 16 * (w & 3)) * INW + (w >> 2) * 32, (unsigned)__builtin_amdgcn_readfirstlane(gslot + qt * 8192 + w * 1024));
}
template <bool DO_DMA> __device__ __forceinline__ void gmlp_unit(Frame& F, int b, int blk) {
    const int lane = F.lane, r32 = lane & 31, hi = lane >> 5, h = F.wave;
    const size_t row0 = (size_t)b * SEQ + blk * 128;
    const unsigned lds0 = (unsigned)(uintptr_t)F.lds;
    const unsigned gslot = lds0 + L_GT + h * 16384;
    const int vb0 = (int)gslot + ((lane >> 4) & 1) * 32 + (lane & 3) * 8 + (4 * hi + ((lane & 15) >> 2)) * 64;
    if (DO_DMA) gmlp_dma(F, b, blk);
#pragma unroll 1
    for (int half = 0; half < 2; ++half) {
        int p0 = 64 * half + r32; asm volatile("" : "+v"(p0));
        const bf16* wp = F.Wsp + ((size_t)h * 128 + p0) * 128 + 8 * hi;
        bf16x8 wf[2][2][4];
#pragma unroll
        for (int qt = 0; qt < 2; ++qt)
#pragma unroll
            for (int pbl = 0; pbl < 2; ++pbl)
#pragma unroll
                for (int ks = 0; ks < 4; ++ks) wf[qt][pbl][ks] = *(const GAS bf16x8*)(wp + pbl * 32 * 128 + qt * 64 + ks * 16);
        typedef unsigned u32x2_t __attribute__((ext_vector_type(2)));
        u32x2_t uu[2][2][4]; float bs[2];
#pragma unroll
        for (int pbl = 0; pbl < 2; ++pbl) { bs[pbl] = F.b_spatial[h * 128 + p0 + 32 * pbl];
#pragma unroll
            for (int d0 = 0; d0 < 2; ++d0)
#pragma unroll
                for (int k = 0; k < 4; ++k) uu[pbl][d0][k] = *(const GAS u32x2_t*)(F.Y + (row0 + p0 + 32 * pbl) * INW + 768 + 64 * h + 32 * d0 + 8 * k + 4 * hi); }
        asm volatile("s_waitcnt vmcnt(0)" ::: "memory");
        f32x16 o[2][2]; o[0][0] = f32x16{}; o[0][1] = f32x16{}; o[1][0] = f32x16{}; o[1][1] = f32x16{};
#pragma unroll
        for (int qt = 0; qt < 2; ++qt)
#pragma unroll
            for (int d0 = 0; d0 < 2; ++d0) { s16x4 lo[4], hv[4];
#pragma unroll
                for (int ks = 0; ks < 4; ++ks) {
                    asm volatile("ds_read_b64_tr_b16 %0,%1 offset:%c2" : "=&v"(lo[ks]) : "v"(vb0), "i"(qt * 8192 + d0 * 4096 + ks * 1024) : "memory");
                    asm volatile("ds_read_b64_tr_b16 %0,%1 offset:%c2" : "=&v"(hv[ks]) : "v"(vb0), "i"(qt * 8192 + d0 * 4096 + ks * 1024 + 512) : "memory"); }
                asm volatile("s_waitcnt lgkmcnt(0)" ::: "memory"); MIX_SBAR();
#pragma unroll
                for (int ks = 0; ks < 4; ++ks) { const bf16x8 vf = (bf16x8){lo[ks][0], lo[ks][1], lo[ks][2], lo[ks][3], hv[ks][0], hv[ks][1], hv[ks][2], hv[ks][3]};
                    o[0][d0] = __builtin_amdgcn_mfma_f32_32x32x16_bf16(vf, wf[qt][0][ks], o[0][d0], 0, 0, 0);
                    o[1][d0] = __builtin_amdgcn_mfma_f32_32x32x16_bf16(vf, wf[qt][1][ks], o[1][d0], 0, 0, 0); } }
#pragma unroll
        for (int pbl = 0; pbl < 2; ++pbl) { float sq = 0.f; const size_t prow = row0 + p0 + 32 * pbl;
#pragma unroll
            for (int d0 = 0; d0 < 2; ++d0)
#pragma unroll
                for (int kp = 0; kp < 2; ++kp) { unsigned wa[2], wb[2];
#pragma unroll
                    for (int q = 0; q < 2; ++q) { const int k = 2 * kp + q; const u32x2_t u = uu[pbl][d0][k];
                        const float v0 = bf2f(u[0] & 0xffffu) * (o[pbl][d0][4 * k] + bs[pbl]), v1 = bf2f(u[0] >> 16) * (o[pbl][d0][4 * k + 1] + bs[pbl]);
                        const float v2 = bf2f(u[1] & 0xffffu) * (o[pbl][d0][4 * k + 2] + bs[pbl]), v3 = bf2f(u[1] >> 16) * (o[pbl][d0][4 * k + 3] + bs[pbl]);
                        sq += (v0 * v0 + v1 * v1) + (v2 * v2 + v3 * v3);
                        if (q == 0) { wa[0] = cvtpk_s(v0, v1); wa[1] = cvtpk_s(v2, v3); } else { wb[0] = cvtpk_s(v0, v1); wb[1] = cvtpk_s(v2, v3); } }
                    store_pair16(F.A2 + pg8::tiled_off((int)prow, 512 + 64 * h + 32 * d0 + 16 * kp + 8 * hi, 16), wa, wb); }
            sq += __shfl_xor(sq, 32);
            if (hi == 0) F.ssq2[prow * 16 + 8 + h] = sq; }
    }
}

__device__ __forceinline__ void pv2(f32x16* oA, f32x16* oB, int vb, const bf16x8* paA, const bf16x8* paB) {
#pragma unroll
    for (int d0 = 0; d0 < 2; ++d0) { s16x4 lo[4], hi[4];
#pragma unroll
        for (int ks = 0; ks < 4; ++ks) {
            asm volatile("ds_read_b64_tr_b16 %0,%1 offset:%c2" : "=&v"(lo[ks]) : "v"(vb), "i"(d0 * 4096 + ks * 1024) : "memory");
            asm volatile("ds_read_b64_tr_b16 %0,%1 offset:%c2" : "=&v"(hi[ks]) : "v"(vb), "i"(d0 * 4096 + ks * 1024 + 512) : "memory"); }
        asm volatile("s_waitcnt lgkmcnt(0)" ::: "memory"); MIX_SBAR();
#define MIX_PK(k) (bf16x8){lo[k][0], lo[k][1], lo[k][2], lo[k][3], hi[k][0], hi[k][1], hi[k][2], hi[k][3]}
#pragma unroll
        for (int ks = 0; ks < 4; ++ks) { const bf16x8 vf = MIX_PK(ks);
            oA[d0] = __builtin_amdgcn_mfma_f32_32x32x16_bf16(vf, paA[ks], oA[d0], 0, 0, 0);
            oB[d0] = __builtin_amdgcn_mfma_f32_32x32x16_bf16(vf, paB[ks], oB[d0], 0, 0, 0); }
#undef MIX_PK
    }
}
__device__ __forceinline__ void attn_mask(f32x16& p0, f32x16& p1, int j, int s, int r32, int hi) {
    if (64 * j >= 32 * s + 31 && 64 * j + 63 <= 32 * s + 256) return;
    const int q_rel = 32 * s + r32, kb = 64 * j + 4 * hi;
#pragma unroll
    for (int r = 0; r < 16; ++r) { const int ko = kb + (r & 3) + 8 * (r >> 2);
        if (ko < q_rel || ko > q_rel + 256) p0[r] = -INFINITY;
        if (ko + 32 < q_rel || ko + 32 > q_rel + 256) p1[r] = -INFINITY; }
}
__device__ __forceinline__ void attn_epi(Frame& F, const f32x16* o, float l_reg, float sink2, int s, size_t row0, int h) {
    int lane = F.lane; asm volatile("" : "+v"(lane)); const int r32 = lane & 31, hi = lane >> 5;
    l_reg += __shfl_xor(l_reg, 32); l_reg += sink2;
    const float inv = 1.0f / l_reg; float sq = 0.f; const size_t prow = row0 + 32 * s + r32;
#pragma unroll
    for (int d0 = 0; d0 < 2; ++d0)
#pragma unroll
        for (int kp = 0; kp < 2; ++kp) { unsigned wa[2], wb[2];
#pragma unroll
            for (int q = 0; q < 2; ++q) { const int k = 2 * kp + q; unsigned w0 = cvtpk_s(o[d0][4 * k] * inv, o[d0][4 * k + 1] * inv), w1 = cvtpk_s(o[d0][4 * k + 2] * inv, o[d0][4 * k + 3] * inv);
                const float a0 = bf2f(w0 & 0xffffu), a1 = bf2f(w0 >> 16), a2 = bf2f(w1 & 0xffffu), a3 = bf2f(w1 >> 16);
                sq += (a0 * a0 + a1 * a1) + (a2 * a2 + a3 * a3);
                if (q == 0) { wa[0] = w0; wa[1] = w1; } else { wb[0] = w0; wb[1] = w1; } }
            store_pair16(F.A2 + pg8::tiled_off((int)prow, 64 * h + 32 * d0 + 16 * kp + 8 * hi, 16), wa, wb); }
    sq += __shfl_xor(sq, 32);
    if (hi == 0) F.ssq2[prow * 16 + h] = sq;
}
__device__ __forceinline__ void attn_tile(lcp kb, lcp vp, const int (&koffs)[4], const bf16x8 (&qA)[4], const bf16x8 (&qB)[4], f32x16 (&oA)[2], f32x16 (&oB)[2],
                                          float& lA, float& lB, int jm, int sA, int r32, int hi) {
    f32x16 pA0 = {}, pA1 = {}, pB0 = {}, pB1 = {};
    if (jm >= 0) { const int dA = 64 * jm + 4 * hi - (32 * sA + r32), dB = dA - 32;
#pragma unroll
        for (int r = 0; r < 16; ++r) { const int c = (r & 3) + 8 * (r >> 2);
            pA0[r] = ((unsigned)(dA + c) > 256u) ? -INFINITY : 0.f; pA1[r] = ((unsigned)(dA + c + 32) > 256u) ? -INFINITY : 0.f;
            pB0[r] = ((unsigned)(dB + c) > 256u) ? -INFINITY : 0.f; pB1[r] = ((unsigned)(dB + c + 32) > 256u) ? -INFINITY : 0.f; } }
    MIX_SBAR();
    bf16x8 kf[8];
#pragma unroll
    for (int d0 = 0; d0 < 4; ++d0) { kf[2 * d0] = *(LAS const bf16x8*)(kb + koffs[d0]); kf[2 * d0 + 1] = *(LAS const bf16x8*)(kb + koffs[d0] + 4096); }
#pragma unroll
    for (int d0 = 0; d0 < 4; ++d0) { pA0 = __builtin_amdgcn_mfma_f32_32x32x16_bf16(kf[2 * d0], qA[d0], pA0, 0, 0, 0); pA1 = __builtin_amdgcn_mfma_f32_32x32x16_bf16(kf[2 * d0 + 1], qA[d0], pA1, 0, 0, 0); }
    MIX_SBAR();
#pragma unroll
    for (int d0 = 0; d0 < 4; ++d0) { pB0 = __builtin_amdgcn_mfma_f32_32x32x16_bf16(kf[2 * d0], qB[d0], pB0, 0, 0, 0); pB1 = __builtin_amdgcn_mfma_f32_32x32x16_bf16(kf[2 * d0 + 1], qB[d0], pB1, 0, 0, 0); }
    float sa = 0.f;
#pragma unroll
    for (int r = 0; r < 16; ++r) { pA0[r] = __builtin_amdgcn_exp2f(pA0[r]); pA1[r] = __builtin_amdgcn_exp2f(pA1[r]); sa += pA0[r] + pA1[r]; }
    lA += sa;
    bf16x8 paA[4], paB[4], vf0[4], vf1[4];
    paA[0] = pack8(pA0, 0); paA[1] = pack8(pA0, 8); paA[2] = pack8(pA1, 0); paA[3] = pack8(pA1, 8);
#pragma unroll
    for (int i = 0; i < 8; ++i) { __builtin_amdgcn_sched_group_barrier(0x008, 1, 0); __builtin_amdgcn_sched_group_barrier(0x402, 10, 0); }
    MIX_SBAR();
    {
#pragma unroll
        for (int ks = 0; ks < 4; ++ks) { const s16x4 lo = vtr(vp + ks * 1024), hv = vtr(vp + ks * 1024 + 512); vf0[ks] = (bf16x8){lo[0], lo[1], lo[2], lo[3], hv[0], hv[1], hv[2], hv[3]}; }
#pragma unroll
        for (int ks = 0; ks < 4; ++ks) { const s16x4 lo = vtr(vp + 4096 + ks * 1024), hv = vtr(vp + 4096 + ks * 1024 + 512); vf1[ks] = (bf16x8){lo[0], lo[1], lo[2], lo[3], hv[0], hv[1], hv[2], hv[3]}; }
#pragma unroll
        for (int ks = 0; ks < 4; ++ks) oA[0] = __builtin_amdgcn_mfma_f32_32x32x16_bf16(vf0[ks], paA[ks], oA[0], 0, 0, 0);
#pragma unroll
        for (int ks = 0; ks < 4; ++ks) oA[1] = __builtin_amdgcn_mfma_f32_32x32x16_bf16(vf1[ks], paA[ks], oA[1], 0, 0, 0);
    }
    float sb = 0.f;
#pragma unroll
    for (int r = 0; r < 16; ++r) { pB0[r] = __builtin_amdgcn_exp2f(pB0[r]); pB1[r] = __builtin_amdgcn_exp2f(pB1[r]); sb += pB0[r] + pB1[r]; }
    lB += sb;
    paB[0] = pack8(pB0, 0); paB[1] = pack8(pB0, 8); paB[2] = pack8(pB1, 0); paB[3] = pack8(pB1, 8);
    __builtin_amdgcn_sched_group_barrier(0x100, 16, 0);
#pragma unroll
    for (int i = 0; i < 8; ++i) { __builtin_amdgcn_sched_group_barrier(0x008, 1, 0); __builtin_amdgcn_sched_group_barrier(0x402, 10, 0); }
    MIX_SBAR();
    {
        bf16x8 wf0[4], wf1[4];
#pragma unroll
        for (int ks = 0; ks < 4; ++ks) { const s16x4 lo = vtr(vp + ks * 1024), hv = vtr(vp + ks * 1024 + 512); wf0[ks] = (bf16x8){lo[0], lo[1], lo[2], lo[3], hv[0], hv[1], hv[2], hv[3]}; }
#pragma unroll
        for (int ks = 0; ks < 4; ++ks) { const s16x4 lo = vtr(vp + 4096 + ks * 1024), hv = vtr(vp + 4096 + ks * 1024 + 512); wf1[ks] = (bf16x8){lo[0], lo[1], lo[2], lo[3], hv[0], hv[1], hv[2], hv[3]}; }
#pragma unroll
        for (int ks = 0; ks < 4; ++ks) oB[0] = __builtin_amdgcn_mfma_f32_32x32x16_bf16(wf0[ks], paB[ks], oB[0], 0, 0, 0);
#pragma unroll
        for (int ks = 0; ks < 4; ++ks) oB[1] = __builtin_amdgcn_mfma_f32_32x32x16_bf16(wf1[ks], paB[ks], oB[1], 0, 0, 0);
    }
    MIX_SBAR();
}
__device__ __forceinline__ void attn_unit(Frame& F, int b, int blk) {
    const int lane = F.lane, r32 = lane & 31, hi = lane >> 5, h = F.wave, g = h >> 2, wid = F.wave;
    const size_t row0 = (size_t)b * SEQ + blk * 128;
    const unsigned lds0 = (unsigned)(uintptr_t)F.lds;
    const float sink2 = exp2f(F.attn_sink[h] * LOG2E);
    int koffs[4];
#pragma unroll
    for (int d0 = 0; d0 < 4; ++d0) koffs[d0] = (r32 >> 3) * 1024 + (r32 & 7) * 128 + (((2 * d0 + hi) ^ ((r32 >> 1) & 7)) * 16);
    const int vbl = ((lane >> 4) & 1) * 32 + (lane & 3) * 8 + (4 * hi + ((lane & 15) >> 2)) * 64;
    const int jf_blk = (blk == 0) ? 2 : 0, jl_blk = (blk == 31) ? 3 : 5;
    const int jf0 = jf_blk, jl0 = 4 < jl_blk ? 4 : jl_blk, nw0 = jl0 - jf0 + 1, n0 = nw0 + 4;
    const int jf1 = 1 > jf_blk ? 1 : jf_blk, jl1 = jl_blk, nw1 = jl1 - jf1 + 1, n1 = nw1 + 4;
    const int ntot = n0 + n1;
#define MIX_DMA(gi, slot) do { const int gi_ = (gi); const int ps_ = gi_ >= n0 ? 1 : 0, ti_ = gi_ - ps_ * n0, nw_ = ps_ ? nw1 : nw0, jf_ = ps_ ? jf1 : jf0; const bf16* base_; unsigned pitch_; \
        if (ti_ < nw_) { base_ = F.KV + ((size_t)b * SEQ + (size_t)(128 * (blk - 1) + 64 * (jf_ + ti_))) * 256; pitch_ = 256; } \
        else { base_ = F.Yc + ((size_t)b * CTXL + 64 * (ti_ - nw_)) * 256; pitch_ = 256; } \
        const unsigned sl_ = lds0 + (slot) * SLOT; \
        unsigned ln_ = (unsigned)lane; asm volatile("" : "+v"(ln_));     \
        const unsigned kk_ = 8u * (unsigned)wid + (ln_ >> 3); \
        const unsigned ko_ = kk_ * pitch_ + 8u * ((ln_ & 7u) ^ ((kk_ >> 1) & 7u)), vo_ = (16u * (unsigned)(wid & 3) + (ln_ >> 2)) * pitch_ + 128u + (unsigned)(wid >> 2) * 32u + (ln_ & 3u) * 8u; \
        glds16(base_ + ko_, (unsigned)__builtin_amdgcn_readfirstlane(sl_ + wid * 1024)); \
        glds16(base_ + ko_ + 64, (unsigned)__builtin_amdgcn_readfirstlane(sl_ + 8192 + wid * 1024)); \
        glds16(base_ + vo_, (unsigned)__builtin_amdgcn_readfirstlane(sl_ + 16384 + wid * 1024)); \
        glds16(base_ + vo_ + 64, (unsigned)__builtin_amdgcn_readfirstlane(sl_ + 24576 + wid * 1024)); } while (0)
    bf16x8 qA[4], qB[4];
#define MIX_LOADQ(ps) do { unsigned lq_ = (unsigned)lane; asm volatile("" : "+v"(lq_)); const bf16* qp_ = F.Y + (row0 + 64 * (ps)) * INW + 256 + 64 * h + ((lq_ & 31u) * (unsigned)INW + 8u * (lq_ >> 5)); \
        _Pragma("unroll") for (int d0 = 0; d0 < 4; ++d0) { qA[d0] = *(const GAS bf16x8*)(qp_ + 16 * d0); qB[d0] = *(const GAS bf16x8*)(qp_ + (size_t)32 * INW + 16 * d0); } } while (0)
    MIX_LOADQ(0);
    MIX_DMA(0, 0); MIX_DMA(1, 1);
    int gi = 0, slot = 0; bool gpend = false;
    for (int ps = 0; ps < 2; ++ps) {
        const int np = ps ? n1 : n0, nwp = ps ? nw1 : nw0, jfp = ps ? jf1 : jf0, sA = 2 * ps, sB = 2 * ps + 1;
        if (ps) MIX_LOADQ(1);
        f32x16 oA[2], oB[2]; oA[0] = f32x16{}; oA[1] = f32x16{}; oB[0] = f32x16{}; oB[1] = f32x16{};
        float lA = 0.f, lB = 0.f;
        for (int ti = 0; ti < np; ++ti, ++gi) {
            if (gi + 1 < ntot) asm volatile("s_waitcnt vmcnt(4) lgkmcnt(0)\n\ts_barrier" ::: "memory");
            else if (gpend) asm volatile("s_waitcnt vmcnt(16) lgkmcnt(0)\n\ts_barrier" ::: "memory");
            else asm volatile("s_waitcnt vmcnt(0) lgkmcnt(0)\n\ts_barrier" ::: "memory");
            { const int s2 = slot + 2 >= 3 ? slot - 1 : slot + 2;
              if (gi == 1 && (h >> 1) == 3) gmlp_dma(F, b, blk);
              if (gi + 2 < ntot) MIX_DMA(gi + 2, s2);
              else if ((h >> 1) == s2) { gmlp_dma(F, b, blk); gpend = true; } }
            lcp kb = (lcp)(F.lds + slot * SLOT + g * 8192);
            lcp vp = (lcp)(F.lds + slot * SLOT + 16384 + g * 8192) + vbl;
            const int jt = ti < nwp ? jfp + ti : -1;
            attn_tile(kb, vp, koffs, qA, qB, oA, oB, lA, lB, (jt >= 0 && (jt == (ps ? 1 : 0) || jt == (ps ? 5 : 4))) ? jt : -1, sA, r32, hi);
            slot = slot == 2 ? 0 : slot + 1;
        }
        attn_epi(F, oA, lA, sink2, sA, row0, h);
        attn_epi(F, oB, lB, sink2, sB, row0, h);
    }
    asm volatile("s_waitcnt lgkmcnt(0)\n\ts_barrier" ::: "memory");
    { const int sl = slot == 0 ? 2 : slot - 1; if ((h >> 1) == sl) gmlp_dma(F, b, blk); }
#undef MIX_DMA
#undef MIX_LOADQ
}

__device__ __forceinline__ void p3_mixer(Frame& F) {
    for (int item = F.vcu; item < BATCH * 32; item += F.G) {
        const int b = item >> 5, blk = item & 31;
#ifdef MK_ATTN_TWICE
        for (int rep_ = 0; rep_ < 2; ++rep_) { asm volatile("s_waitcnt vmcnt(0) lgkmcnt(0)" ::: "memory"); __syncthreads();
#endif
        attn_unit(F, b, blk);
#ifdef MK_ATTN_TWICE
        }
#endif
        gmlp_unit<false>(F, b, blk);
        asm volatile("s_waitcnt vmcnt(0) lgkmcnt(0)" ::: "memory"); __syncthreads();
    }
}
#undef MIX_SBAR
#undef MIX_WAIT_BAR
}
struct Args { const float* in[20]; float* out; unsigned char* ws; int ph_lo, ph_hi, li, pad; };
__global__ void __launch_bounds__(NWAVES * 64, 2) fwd_mega(Args args) {
    extern __shared__ __attribute__((aligned(16))) unsigned char lds[];
    Frame F;
    F.lds = (LAS unsigned char*)lds;
    F.MISC = (volatile LAS unsigned*)(F.lds + MISC_OFF);
    F.tid = threadIdx.x; F.lane = F.tid & 63; F.wave = __builtin_amdgcn_readfirstlane(F.tid >> 6);
    F.G = gridDim.x; { const int bx = blockIdx.x; F.vcu = (F.G % 8 == 0) ? (bx % 8) * (F.G / 8) + bx / 8 : bx; }
    unsigned char* ws = args.ws;
    F.ctl = (gu32*)(ws + WS_CTL);
    F.x = args.in[0]; F.c = args.in[1]; F.ctx = args.in[2]; F.c_ctx = args.in[3]; F.w_mod = args.in[4]; F.b_mod = args.in[5]; F.norm_mix = args.in[6]; F.norm_ffn = args.in[7];
    F.w_in = args.in[8]; F.q_gain = args.in[9]; F.k_gain = args.in[10]; F.attn_sink = args.in[11]; F.gate_gain = args.in[12]; F.w_spatial = args.in[13]; F.b_spatial = args.in[14];
    F.attn_out_gain = args.in[15]; F.mlp_out_gain = args.in[16]; F.w_out = args.in[17]; F.w_gate_up = args.in[18]; F.w_down = args.in[19]; F.out = args.out;
    F.mod = (float*)(ws + WS_MOD); F.rope = (float*)(ws + WS_ROPE); F.bias_t = (float*)(ws + WS_BIAS); F.ssq3 = (float*)(ws + WS_SSQ3); F.ssq2 = (float*)(ws + WS_SSQ2); F.rstd3 = (float*)(ws + WS_RSTD3);
    F.Win_t = (bf16*)(ws + WS_WIN); F.Wout_t = (bf16*)(ws + WS_WOUT); F.Wgu_t = (bf16*)(ws + WS_WGU); F.Wdn_t = (bf16*)(ws + WS_WDN);
    F.XN = (bf16*)(ws + WS_XN); F.Y = (bf16*)(ws + WS_Y); F.Yc = (bf16*)(ws + WS_YC); F.H = (bf16*)(ws + WS_H); F.A2 = (bf16*)(ws + WS_A2); F.A3 = (bf16*)(ws + WS_A3); F.Wsp = (bf16*)(ws + WS_WSP); F.KV = (bf16*)(ws + WS_KV);
    for (int u = F.tid; u < (LDS_BYTES - LDSCTL_OFF) / 4; u += NWAVES * 64) ((LAS unsigned*)(F.lds + LDSCTL_OFF))[u] = 0u;
    __syncthreads();
    XcdBarrier bar = xcd_barrier_post((unsigned*)(F.ctl + CW_BAR) + args.li * XCD_BAR_WORDS, F.MISC + 8);
    if (F.tid == 0) { unsigned nloc, nx, uni; xcd_barrier_complete(bar.bar, bar.x, nloc, nx, uni); bar.st[0] = nloc; bar.st[1] = nx; bar.st[2] = uni; }
    __syncthreads();
    F.xcc = (int)bar.x; F.uni = (F.MISC[10] == 1u && F.G == 256) ? 1 : 0;
#ifdef MK_FORCE_NONUNI
    F.uni = 0;
#endif
    F.cid = (int)blockIdx.x;
    if (F.uni) { const int rank = (int)F.MISC[11]; F.cid = rank * 8 + F.xcc; F.vcu = F.xcc * 32 + rank; }
    const int lo = args.ph_lo, hi = args.ph_hi;
#define IN(k) (lo <= (k) && (k) < hi)
#define SEAM(k) do { if (IN(k) && IN((k) + 1)) xcd_barrier(bar, F.uni && (k) >= 1); } while (0)

#ifndef MK_DUP
#define MK_DUP 0
#endif
#define REP(k) for (int rep_ = 0; rep_ < (((MK_DUP >> (k)) & 1) ? 2 : 1); ++rep_)
    if (IN(0)) { REP(0) { p0_prologue(F); __syncthreads(); } SEAM(0); }
#ifdef MK_XBAR
    for (int xb = 0; xb < MK_XBAR; ++xb) xcd_barrier(bar);
#endif
    if (IN(1)) { REP(1) p1_norm_rows(F); if (!F.uni) SEAM(1); }
#if defined(MK_SLEEP_H) || defined(MK_SLEEP_L)
    { const int rank_ = F.vcu & 31; int us_ = 0;
#ifdef MK_SLEEP_H
      if (rank_ < P12_RANK_L) us_ = MK_SLEEP_H;
#endif
#ifdef MK_SLEEP_L
      if (rank_ >= P12_RANK_L) us_ = MK_SLEEP_L;
#endif
      const unsigned long long t0_ = rt(); while (rt() - t0_ < (unsigned long long)us_ * 100ull) __builtin_amdgcn_s_sleep(8); }
#endif
    if (IN(2)) {
        LAS float* ropeL = (LAS float*)(F.lds + LDSCTL_OFF + 1024); LAS float* gainL = ropeL + 2048;
        for (int i = F.tid; i < 2048; i += NWAVES * 64) ropeL[i] = F.rope[i];
        for (int i = F.tid; i < 640; i += NWAVES * 64) gainL[i] = i < 64 ? F.q_gain[i] * pg8::C2Q : i < 128 ? F.k_gain[i - 64] : F.gate_gain[i - 128];
        __syncthreads();
        pg8::Gemm g{F.XN, F.Win_t, MROWS, INW, DM}; pg8::InProjOrder S; S.so.init(MROWS, INW, F.G, F.cid); S.cnt = F.uni ? (const unsigned*)F.ctl + CW_RT + F.xcc * 32 : nullptr; S.flagp = (LAS unsigned*)(F.lds + LDSCTL_OFF + 512); S.na = P12_NA; S.nb = P12_NWL;
        pg8::EpiInProj E{F.Y, F.Yc, F.KV, ropeL, gainL};
        REP(2) pg8::gemm_phase<pg8::EpiInProj, pg8::InProjOrder, true, true>(F.lds + RING_OFF, g, S, E);
        SEAM(2);
    }
    if (IN(3)) { REP(3) mix::p3_mixer(F); SEAM(3); }
    if (IN(4)) {
        pg8::Gemm g{F.A2, F.Wout_t, MROWS, DM, DM}; pg8::OutProjOrder S; S.init(MROWS, DM, F.G, F.cid);
        S.ssq2 = F.ssq2; S.mod = F.mod; S.norm_ffn = F.norm_ffn; S.tab = (LAS float*)(F.lds + LDSCTL_OFF + 1024);
        pg8::EpiOutProj E{F.x, F.A3, F.ssq3, S.tab};
        REP(4) pg8::gemm_phase<pg8::EpiOutProj, pg8::OutProjOrder, true, true>(F.lds + RING_OFF, g, S, E);
        SEAM(4);
    }
    if (IN(5)) {
        { const int wv = F.uni ? (F.vcu & 31) * NWAVES + F.wave : F.vcu * NWAVES + F.wave, nwv = F.uni ? 256 : F.G * NWAVES; const size_t rbase = F.uni ? (size_t)F.xcc * SEQ : 0, rend = F.uni ? rbase + SEQ : MROWS;
          for (size_t rowb = rbase + 16 * (size_t)wv + (F.lane >> 2); rowb < rend; rowb += 16 * (size_t)nwv) {
              const f32x4 p = *(const f32x4*)(F.ssq3 + rowb * 16 + 4 * (F.lane & 3)); float ss = (p[0] + p[1]) + (p[2] + p[3]);
              ss += __shfl_xor(ss, 1); ss += __shfl_xor(ss, 2);
              if ((F.lane & 3) == 0) F.rstd3[rowb] = 1.0f / sqrtf(ss * (1.0f / 1024.0f) + 1e-6f); } }
        if (F.tid == 0) { unsigned* fl = (unsigned*)F.ctl + CW_BIASF; const unsigned want = (unsigned)(F.G * NWAVES); XB_SPIN(xb_ld(fl) < want, bar.bar); }
        xcd_barrier(bar, F.uni);
        pg8::Gemm g{F.A3, F.Wgu_t, MROWS, 2 * FFH, DM}; pg8::GateUpOrder S; S.init(MROWS, 2 * FFH, F.G, F.cid);
        S.rstd3 = F.rstd3; S.bias_t = F.bias_t; S.tab = (LAS float*)(F.lds + LDSCTL_OFF + 1024);
        pg8::EpiGateUp E{F.H, S.tab};
        REP(5) pg8::gemm_phase<pg8::EpiGateUp, pg8::GateUpOrder, true, true>(F.lds + RING_OFF, g, S, E);
        SEAM(5);
    }
    if (IN(6)) {
#ifdef MK_SLEEP_P6
        if (F.vcu & 16) { const unsigned long long t0_ = rt(); while (rt() - t0_ < (unsigned long long)(MK_SLEEP_P6) * 100ull) __builtin_amdgcn_s_sleep(8); }
#endif
        pg8::Gemm g{F.H, F.Wdn_t, MROWS, DM, FFH}; pg8::DownOrder S; S.init(MROWS, DM, F.G, F.cid);
        S.mod = F.mod; S.norm_ffn = F.norm_ffn; S.tab = (LAS float*)(F.lds + LDSCTL_OFF + 1024);
        pg8::EpiDown E{F.A3, F.out, S.tab};
        pg8::gemm_phase<pg8::EpiDown, pg8::DownOrder, true, true>(F.lds + RING_OFF, g, S, E);
    }
#undef IN
#undef SEAM
}

extern "C" void kernel_launch(void* const* d_in, const int* in_sizes, int n_in, void* d_out, int out_size, void* d_ws, size_t ws_size, hipStream_t stream) {
    static int grid = 0;
    if (grid == 0) {
        if (n_in != 20 || in_sizes[0] != MROWS * DM || out_size != MROWS * DM || ws_size < WS_END) { fprintf(stderr, "kernel_launch: unexpected shapes: n_in %d in0 %d out %d ws %zu\n", n_in, n_in > 0 ? in_sizes[0] : -1, out_size, ws_size); grid = -1; return; }
        int dev = 0, cus = 0, per_cu = 0;
        if (hipGetDevice(&dev) != hipSuccess || hipDeviceGetAttribute(&cus, hipDeviceAttributeMultiprocessorCount, dev) != hipSuccess) { grid = -1; return; }
        if (hipFuncSetAttribute((const void*)fwd_mega, hipFuncAttributeMaxDynamicSharedMemorySize, LDS_BYTES) != hipSuccess) { fprintf(stderr, "kernel_launch: hipFuncSetAttribute failed\n"); grid = -1; return; }
        if (hipOccupancyMaxActiveBlocksPerMultiprocessor(&per_cu, (const void*)fwd_mega, NWAVES * 64, LDS_BYTES) != hipSuccess || per_cu < 1) fprintf(stderr, "kernel_launch: occupancy query says %d\n", per_cu);
        (void)hipGetLastError();
        grid = cus - (cus % 8);
        if (grid < 8) grid = cus;
    }
    if (grid < 0) return;
    if (hipMemsetAsync((char*)d_ws + WS_CTL, 0, CTL_ZERO_BYTES, stream) != hipSuccess) return;
    Args a{};
    for (int i = 0; i < 20; ++i) a.in[i] = (const float*)d_in[i];
    a.out = (float*)d_out; a.ws = (unsigned char*)d_ws;
#ifdef MK_PROBE_PHASE
    const int plan[3][2] = {{0, MK_PROBE_PHASE + 1}, {MK_PROBE_PHASE, MK_PROBE_PHASE + 1}, {MK_PROBE_PHASE + 1, N_PHASES}};
    for (int li = 0; li < 3; ++li) { if (plan[li][0] >= plan[li][1]) continue; a.ph_lo = plan[li][0]; a.ph_hi = plan[li][1]; a.li = li;
        hipLaunchKernelGGL(fwd_mega, dim3(grid), dim3(NWAVES * 64), LDS_BYTES, stream, a); }
#else
    int lo = 0, li = 0;
    for (int k = 0; k < N_PHASES; ++k) {
        const bool cut = (k == N_PHASES - 1) || ((MK_CUTS >> k) & 1);
        if (!cut) continue;
        a.ph_lo = lo; a.ph_hi = k + 1; a.li = li++;
        hipLaunchKernelGGL(fwd_mega, dim3(grid), dim3(NWAVES * 64), LDS_BYTES, stream, a);
        lo = k + 1;
    }
#endif
}
```

```cpp
#include <hip/hip_runtime.h>
#include <cstdio>
#include <cstdint>
#include <cmath>
namespace pg8 {
#define PG8_LAS __attribute__((address_space(3)))
typedef unsigned short bf16_t;
typedef short bf16x8 __attribute__((ext_vector_type(8)));
typedef float f32x4 __attribute__((ext_vector_type(4)));
typedef unsigned u32x4 __attribute__((ext_vector_type(4)));
constexpr int BM = 256, BK = 64, HALF = 128, HTB = HALF * BK * 2  , STAGE_BYTES = 8 * HTB, NXCD = 8, WGM = 4;

__host__ __device__ __forceinline__ int lds_byte(int r, int c) { const int st = (r >> 4) * 2 + (c >> 5), rr = r & 15, cc = c & 31, ob = rr * 64 + cc * 2; return st * 1024 + (ob ^ (((ob >> 9) & 1) << 5)); }
__host__ __device__ __forceinline__ void stage_rc(int b, int& R, int& C) { const int st = b / 1024, sb = b % 1024, swz = sb ^ (((sb >> 9) & 1) << 5); R = (st >> 1) * 16 + swz / 64; C = (st & 1) * 32 + (swz % 64) / 2; }
__host__ __device__ __forceinline__ int perm32(int rho) { const int n = rho >> 4, i = rho & 15; return 8 * (i >> 2) + 4 * n + (i & 3); }

__host__ __device__ __forceinline__ size_t tiled_off(int row, int col, int nt) { return (((size_t)(row >> 8) * nt + (col >> 6)) * 256 + (row & 255)) * 64 + (col & 63); }
struct Unit { int pm, pn; };
struct Gemm { const bf16_t* A; const bf16_t* Bt; int M, N, K; };

struct StaticOrder {
    int nM, nN, nwg, G, c;
    __host__ __device__ void init(int M, int N, int G_, int c_) { nM = M / BM; nN = N / BM; nwg = nM * nN; G = G_; c = c_; }
    __host__ __device__ bool next(int i, Unit& u) const {
        const long L = (long)i * G + c; if (L >= nwg) return false;
        int wgid = (int)L; { const int q = nwg / NXCD, r = nwg % NXCD, xcd = wgid % NXCD, off = wgid / NXCD; wgid = (xcd < r ? xcd * (q + 1) : r * (q + 1) + (xcd - r) * q) + off; }
        const int nig = WGM * nN, gid = wgid / nig, fm = gid * WGM, gsz = (nM - fm) < WGM ? (nM - fm) : WGM;
        u.pm = fm + ((wgid % nig) % gsz); u.pn = (wgid % nig) / gsz; return true;
    }
    __device__ __forceinline__ void a_ready(const Unit&, int) const {}
    __device__ __forceinline__ void a_poll(const Unit&) const {}
    __device__ __forceinline__ void done(const Unit&) const {}
};
typedef float cvt_f32x2_t __attribute__((ext_vector_type(2))); typedef __bf16 cvt_bf16x2_t __attribute__((ext_vector_type(2)));
__device__ __forceinline__ unsigned cvt_pk_bf16(float lo, float hi) { cvt_f32x2_t v = {lo, hi}; cvt_bf16x2_t b = __builtin_convertvector(v, cvt_bf16x2_t); return __builtin_bit_cast(unsigned, b); }
typedef float f32x2 __attribute__((ext_vector_type(2)));
typedef unsigned u32x2 __attribute__((ext_vector_type(2)));
constexpr float C2Q = 0.125f * 1.4426950408889634f;
constexpr float RMS_EPS = 1e-6f;
__device__ __forceinline__ float gelu_tanh(float x) {
    const float z2 = x * (1.5957691216057308f + 0.07135481627244473f * x * x);
    const float e = __builtin_amdgcn_exp2f(-1.4426950408889634f * z2);
    return x * __builtin_amdgcn_rcpf(1.0f + e);
}
__device__ __forceinline__ float silu_f(float x) { return x * __builtin_amdgcn_rcpf(1.0f + __builtin_amdgcn_exp2f(-1.4426950408889634f * x)); }

struct EpiInProj {
    static constexpr bool PERM = true, AFTER_DRAIN = false, MIDSCALE = false; static constexpr int A_AUX = 0;
    bf16_t* Y; bf16_t* Yc; bf16_t* KV; PG8_LAS const float* ropeL; PG8_LAS const float* gainL;
    __device__ __forceinline__ void operator()(const f32x4 (&acc)[2][2][4][2], const Unit& u, int wr, int wc, int fr, int fq, int) const {
        const bool ctx = u.pm >= 128;
        const int head = __builtin_amdgcn_readfirstlane(4 * u.pn + wc);
        const int type = head < 2 ? 0 : head < 4 ? 1 : head < 12 ? 2 : head < 20 ? 3 : 4;
        bf16_t* base; int ld, rowb;
        if (ctx) { base = Yc; ld = 256; rowb = (u.pm - 128) * 256; } else if (head < 4) { base = KV; ld = 256; rowb = u.pm * 256; }
        else { base = Y; ld = 1792; rowb = u.pm * 256; }
        const int colb = head * 64 + 8 * fq;
        f32x4 g[2][2];
#pragma unroll
        for (int bj = 0; bj < 2; ++bj)
#pragma unroll
            for (int n = 0; n < 2; ++n) {
                if (type == 0) g[bj][n] = *(PG8_LAS const f32x4*)(gainL + 64 + 32 * bj + 16 * n + 4 * fq);
                else if (type == 2) g[bj][n] = *(PG8_LAS const f32x4*)(gainL + 32 * bj + 16 * n + 4 * fq);
                else if (type == 4) g[bj][n] = *(PG8_LAS const f32x4*)(gainL + 128 + (head - 20) * 64 + 32 * bj + 8 * fq + 4 * n);
                else g[bj][n] = (f32x4){1.f, 1.f, 1.f, 1.f};
            }
        const bool do_norm = (type == 0 || type == 2 || type == 4), do_rope = (type == 2) || (type == 0 && !ctx), do_gelu = type >= 3;
#pragma unroll
        for (int ai = 0; ai < 2; ++ai)
#pragma unroll
            for (int m = 0; m < 4; ++m) {
                const int row = rowb + ai * HALF + wr * 64 + m * 16 + fr;
                f32x4 v[2][2];
#pragma unroll
                for (int bj = 0; bj < 2; ++bj)
#pragma unroll
                    for (int n = 0; n < 2; ++n) v[bj][n] = acc[ai][bj][m][n];
                if (do_gelu) {
#pragma unroll
                    for (int bj = 0; bj < 2; ++bj)
#pragma unroll
                        for (int n = 0; n < 2; ++n) { const f32x4 xx = v[bj][n]; const f32x4 t = xx * ((xx * xx) * (-1.4426950408889634f * 0.07135481627244473f) + (-1.4426950408889634f * 1.5957691216057308f)); f32x4 d;
#pragma unroll
                            for (int e = 0; e < 4; ++e) d[e] = __builtin_amdgcn_exp2f(t[e]);
                            d = d + 1.0f; f32x4 r;
#pragma unroll
                            for (int e = 0; e < 4; ++e) r[e] = __builtin_amdgcn_rcpf(d[e]);
                            v[bj][n] = xx * r; }
                }
                if (do_norm) {
                    float ss = 0.f;
#pragma unroll
                    for (int bj = 0; bj < 2; ++bj)
#pragma unroll
                        for (int n = 0; n < 2; ++n) { const f32x4 t = v[bj][n]; ss += (t[0] * t[0] + t[1] * t[1]) + (t[2] * t[2] + t[3] * t[3]); }
                    ss += __shfl_xor(ss, 16); ss += __shfl_xor(ss, 32);
                    const float rstd = __builtin_amdgcn_rsqf(ss * (1.0f / 64.0f) + RMS_EPS);
#pragma unroll
                    for (int bj = 0; bj < 2; ++bj)
#pragma unroll
                        for (int n = 0; n < 2; ++n) v[bj][n] = v[bj][n] * rstd * g[bj][n];
                }
                if (do_rope) {
                    const int t = row & 4095;
#pragma unroll
                    for (int bj = 0; bj < 2; ++bj) {
                        const int pos = bj ? (t & 63) : (t >> 6);
                        const f32x4 cs0 = *(PG8_LAS const f32x4*)(ropeL + pos * 36 + 8 * fq), cs1 = *(PG8_LAS const f32x4*)(ropeL + pos * 36 + 8 * fq + 4);
                        const f32x4 c = {cs0[0], cs0[2], cs1[0], cs1[2]}, s = {cs0[1], cs0[3], cs1[1], cs1[3]};
                        const f32x4 x1 = v[bj][0], x2 = v[bj][1]; v[bj][0] = x1 * c - x2 * s; v[bj][1] = x1 * s + x2 * c;
                    }
                }
                bf16_t* rowp = base + (size_t)row * ld + colb;
#pragma unroll
                for (int bj = 0; bj < 2; ++bj) { u32x4 w; w.x = cvt_pk_bf16(v[bj][0][0], v[bj][0][1]); w.y = cvt_pk_bf16(v[bj][0][2], v[bj][0][3]); w.z = cvt_pk_bf16(v[bj][1][0], v[bj][1][1]); w.w = cvt_pk_bf16(v[bj][1][2], v[bj][1][3]);
                    *(u32x4*)(rowp + 32 * bj) = w; }
            }
    }
};

__device__ __forceinline__ f32x4 gf_eff(f32x4 g) {
#pragma unroll
    for (int e = 0; e < 4; ++e) g[e] = (__builtin_fabsf(g[e]) < 1e-30f) ? 1e-30f : g[e];
    return g; }
struct EpiOutProj {
    static constexpr bool PERM = true, AFTER_DRAIN = false, MIDSCALE = true; static constexpr int A_AUX = 0;
    const float* x; bf16_t* A3; float* ssq3; PG8_LAS const float* tab;
    __device__ __forceinline__ void midscale(f32x4 (&acc)[2][2][4][2], int wr, int fr, int ui) const {
        PG8_LAS const float* t = tab + (ui & 1) * 1024;
#pragma unroll
        for (int ai = 0; ai < 2; ++ai)
#pragma unroll
            for (int m = 0; m < 4; ++m) { const float f = t[ai * HALF + wr * 64 + m * 16 + fr];
#pragma unroll
                for (int bj = 0; bj < 2; ++bj)
#pragma unroll
                    for (int n = 0; n < 2; ++n) acc[ai][bj][m][n] = acc[ai][bj][m][n] * f; }
    }
    __device__ __forceinline__ void operator()(const f32x4 (&acc)[2][2][4][2], const Unit& u, int wr, int wc, int fr, int fq, int ui) const {
        PG8_LAS const float* t = tab + (ui & 1) * 1024;
        const int col0 = u.pn * BM + wc * 32 + 8 * fq, cl0 = wc * 32 + 8 * fq;
#pragma unroll
        for (int ai = 0; ai < 2; ++ai) {
            f32x4 xv[4][2][2];
#pragma unroll
            for (int m = 0; m < 4; ++m)
#pragma unroll
                for (int bj = 0; bj < 2; ++bj)
#pragma unroll
                    for (int n = 0; n < 2; ++n) xv[m][bj][n] = *(const f32x4*)(x + (size_t)(u.pm * BM + ai * HALF + wr * 64 + m * 16 + fr) * 1024 + col0 + bj * HALF + n * 4);
#pragma unroll
            for (int m = 0; m < 4; ++m) {
                const int rl = ai * HALF + wr * 64 + m * 16 + fr, row = u.pm * BM + rl; float ss = 0.f; const float f2 = t[256 + rl];
#pragma unroll
                for (int bj = 0; bj < 2; ++bj) { u32x4 w;
#pragma unroll
                    for (int n = 0; n < 2; ++n) {
                        const f32x4 gtv = *(PG8_LAS const f32x4*)(t + 512 + cl0 + bj * HALF + n * 4), gfv = *(PG8_LAS const f32x4*)(t + 768 + cl0 + bj * HALF + n * 4);
                        const f32x4 h = xv[m][bj][n] + gtv * (acc[ai][bj][m][n] * f2);
                        ss += (h[0] * h[0] + h[1] * h[1]) + (h[2] * h[2] + h[3] * h[3]);
                        const f32x4 a = h * gfv; if (n == 0) { w.x = cvt_pk_bf16(a[0], a[1]); w.y = cvt_pk_bf16(a[2], a[3]); } else { w.z = cvt_pk_bf16(a[0], a[1]); w.w = cvt_pk_bf16(a[2], a[3]); } }
                    *(u32x4*)(A3 + tiled_off(row, col0 + bj * HALF, 16)) = w; }
                ss += __shfl_xor(ss, 16); ss += __shfl_xor(ss, 32);
                if (fq == 0) ssq3[(size_t)row * 16 + u.pn * 4 + wc] = ss;
            }
        }
    }
};
struct OutProjOrder : StaticOrder {
    const float* ssq2; const float* mod; const float* norm_ffn; PG8_LAS float* tab;
    __device__ __forceinline__ void a_ready(const Unit& u, int ui) const {
        int tid = threadIdx.x; asm volatile("" : "+v"(tid));
        PG8_LAS float* t = tab + (ui & 1) * 1024;
        const int r = tid >> 1, hf = tid & 1;
        const f32x4* sp = (const f32x4*)(ssq2 + ((size_t)u.pm * BM + r) * 16 + hf * 8);
        const f32x4 s0 = sp[0], s1 = sp[1];
        const float ss = ((s0[0] + s0[1]) + (s0[2] + s0[3])) + ((s1[0] + s1[1]) + (s1[2] + s1[3]));
        const float rs = 1.0f / sqrtf(ss * (1.0f / 512.0f) + RMS_EPS);
        const float ro = __shfl_xor(rs, 1);
        if (hf == 0) { t[r] = rs / ro; t[256 + r] = ro; }
        if (tid < 256) { const int b = u.pm >> 4, c = u.pn * BM + tid; t[512 + tid] = mod[b * 6144 + 2 * 1024 + c];
            const float g = norm_ffn[c] * (mod[b * 6144 + 4 * 1024 + c] + 1.0f); t[768 + tid] = (__builtin_fabsf(g) < 1e-30f) ? 1e-30f : g; }
    }
};

struct EpiGateUp {
    static constexpr bool PERM = true, AFTER_DRAIN = false, MIDSCALE = false; static constexpr int A_AUX = 0;
    bf16_t* H; PG8_LAS const float* tab;
    __device__ __forceinline__ void operator()(const f32x4 (&acc)[2][2][4][2], const Unit& u, int wr, int wc, int fr, int fq, int ui) const {
        PG8_LAS const float* t = tab + (ui & 1) * 512;
        f32x4 ba[2], bb[2];
#pragma unroll
        for (int n = 0; n < 2; ++n) { ba[n] = *(PG8_LAS const f32x4*)(t + 256 + wc * 32 + 8 * fq + 4 * n); bb[n] = *(PG8_LAS const f32x4*)(t + 256 + HALF + wc * 32 + 8 * fq + 4 * n); }
        const int hc0 = u.pn * HALF + wc * 32 + 8 * fq;
#pragma unroll
        for (int ai = 0; ai < 2; ++ai)
#pragma unroll
            for (int m = 0; m < 4; ++m) {
                const int rl = ai * HALF + wr * 64 + m * 16 + fr;
                const float rstd = t[rl], rsg = rstd * (-1.4426950408889634f), rsu = rstd * (-0.6931471805599453f);
                f32x4 hv[2];
#pragma unroll
                for (int n = 0; n < 2; ++n) {
                    const f32x4 ta = acc[ai][0][m][n] * rsg + ba[n], tb = acc[ai][1][m][n] * rsu + bb[n];
                    f32x4 d;
#pragma unroll
                    for (int e = 0; e < 4; ++e) d[e] = __builtin_amdgcn_exp2f(ta[e]);
                    d = d + 1.0f; f32x4 r;
#pragma unroll
                    for (int e = 0; e < 4; ++e) r[e] = __builtin_amdgcn_rcpf(d[e]);
                    hv[n] = (ta * tb) * r; }
                u32x4 w; w.x = cvt_pk_bf16(hv[0][0], hv[0][1]); w.y = cvt_pk_bf16(hv[0][2], hv[0][3]); w.z = cvt_pk_bf16(hv[1][0], hv[1][1]); w.w = cvt_pk_bf16(hv[1][2], hv[1][3]);

#ifdef MK_NT_H
                __builtin_nontemporal_store(w, (u32x4*)(H + tiled_off(u.pm * BM + rl, hc0, 44)));
#else
                *(u32x4*)(H + tiled_off(u.pm * BM + rl, hc0, 44)) = w;
#endif

            }
    }
};
__device__ __forceinline__ void pg8_glds16(const void* gsrc, unsigned lds_dst) { unsigned keep;
    asm volatile("s_mov_b32 %0, m0\n\ts_mov_b32 m0, %2\n\ts_nop 0\n\tglobal_load_lds_dwordx4 %1, off\n\ts_mov_b32 m0, %0" : "=&s"(keep) : "v"(gsrc), "s"(lds_dst) : "memory"); }
struct GateUpOrder : StaticOrder {
    const float* rstd3; const float* bias_t; PG8_LAS float* tab;
    __device__ __forceinline__ void a_ready(const Unit& u, int ui) const {
        if (__builtin_amdgcn_readfirstlane((int)threadIdx.x) < 64) {
            int lane = threadIdx.x; asm volatile("" : "+v"(lane));
            const unsigned dst = (unsigned)(uintptr_t)(tab + (ui & 1) * 512);
            pg8_glds16(rstd3 + (size_t)u.pm * BM + 4 * lane, (unsigned)__builtin_amdgcn_readfirstlane(dst));
            pg8_glds16(bias_t + (u.pm >> 4) * 5632 + u.pn * BM + 4 * lane, (unsigned)__builtin_amdgcn_readfirstlane(dst + 1024));
        }
    }
};

#ifndef MK_DOWN_AAUX
#define MK_DOWN_AAUX 0
#endif
struct EpiDown {
    static constexpr bool PERM = true, AFTER_DRAIN = false, MIDSCALE = false; static constexpr int A_AUX = MK_DOWN_AAUX;
    const bf16_t* A3; float* out; PG8_LAS const float* tab;
    __device__ __forceinline__ void operator()(const f32x4 (&acc)[2][2][4][2], const Unit& u, int wr, int wc, int fr, int fq, int ui) const {
        PG8_LAS const float* t = tab + (ui & 1) * 512;
        const int col0 = u.pn * BM + wc * 32 + 8 * fq, cl0 = wc * 32 + 8 * fq;
#pragma unroll
        for (int ai = 0; ai < 2; ++ai) {
            u32x4 hv[4][2];
#pragma unroll
            for (int m = 0; m < 4; ++m)
#pragma unroll
                for (int bj = 0; bj < 2; ++bj) hv[m][bj] = __builtin_nontemporal_load((const u32x4*)(A3 + tiled_off(u.pm * BM + ai * HALF + wr * 64 + m * 16 + fr, col0 + bj * HALF, 16)));
#pragma unroll
            for (int m = 0; m < 4; ++m) {
                const int row = u.pm * BM + ai * HALF + wr * 64 + m * 16 + fr;
#pragma unroll
                for (int bj = 0; bj < 2; ++bj)
#pragma unroll
                    for (int n = 0; n < 2; ++n) { const size_t off = (size_t)row * 1024 + col0 + bj * HALF + n * 4; const unsigned w0 = n ? hv[m][bj].z : hv[m][bj].x, w1 = n ? hv[m][bj].w : hv[m][bj].y;
                        const f32x4 gtv = *(PG8_LAS const f32x4*)(t + cl0 + bj * HALF + n * 4), giv = *(PG8_LAS const f32x4*)(t + 256 + cl0 + bj * HALF + n * 4);
                        const f32x4 h1 = (f32x4){__builtin_bit_cast(float, w0 << 16), __builtin_bit_cast(float, w0 & 0xffff0000u), __builtin_bit_cast(float, w1 << 16), __builtin_bit_cast(float, w1 & 0xffff0000u)} * giv;
                        { const f32x4 ov = h1 + gtv * acc[ai][bj][m][n];
#ifdef MK_NT_OUT
                        __builtin_nontemporal_store(ov, (f32x4*)(out + off));
#else
                        *(f32x4*)(out + off) = ov;
#endif
                        } }
            }
        }
    }
};
struct DownOrder : StaticOrder {
    const float* mod; const float* norm_ffn; PG8_LAS float* tab;
    __device__ __forceinline__ bool next(int i, Unit& u) const { const int nc = c < nwg ? (nwg - 1 - c) / G + 1 : 0; if (i >= nc) return false; return StaticOrder::next(nc - 1 - i, u); }
    __device__ __forceinline__ void a_ready(const Unit& u, int ui) const {
        int tid = threadIdx.x; asm volatile("" : "+v"(tid));
        PG8_LAS float* t = tab + (ui & 1) * 512;
        if (tid < 256) { const int b = u.pm >> 4, c = u.pn * BM + tid; t[tid] = mod[b * 6144 + 5 * 1024 + c];
            const float g = norm_ffn[c] * (mod[b * 6144 + 4 * 1024 + c] + 1.0f); t[256 + tid] = 1.0f / ((__builtin_fabsf(g) < 1e-30f) ? 1e-30f : g); }
    }
};

__device__ __forceinline__ void pg8_glds4_sc1(const void* gsrc, unsigned lds_dst) { unsigned keep;
    asm volatile("s_mov_b32 %0, m0\n\ts_mov_b32 m0, %2\n\ts_nop 0\n\tglobal_load_lds_dword %1, off sc1\n\ts_mov_b32 m0, %0" : "=&s"(keep) : "v"(gsrc), "s"(lds_dst) : "memory"); }
struct InProjOrder {
    StaticOrder so;
    const unsigned* cnt; PG8_LAS unsigned* flagp; int na; unsigned nb;
    __device__ __forceinline__ bool next(int i, Unit& u) const {
        const long L = (long)i * so.G + so.c;
        if (L < so.nwg) return so.next(i, u);
        const long r = L - so.nwg; if (r >= 8) return false;
        u.pm = 128 + (int)r; u.pn = 0; return true;
    }
    __device__ __forceinline__ int stage_of(const Unit& u) const { return (u.pm < 128 && (u.pm & 15) < na) ? 0 : 1; }
    __device__ __forceinline__ void spin(const Unit& u) const {
        const int st = stage_of(u); const unsigned* p = cnt + st; const unsigned want = st ? nb : 256u;
        for (unsigned sp = 0; __hip_atomic_load(p, __ATOMIC_RELAXED, __HIP_MEMORY_SCOPE_AGENT) < want && sp < (1u << 22); ++sp) __builtin_amdgcn_s_sleep(1);
    }
    __device__ __forceinline__ void a_poll(const Unit& u) const {
        if (cnt == nullptr) return;
        if (__builtin_amdgcn_readfirstlane((int)threadIdx.x) < 64) { int lane = threadIdx.x; asm volatile("" : "+v"(lane));
            if (lane == 0) pg8_glds4_sc1(cnt + stage_of(u), (unsigned)__builtin_amdgcn_readfirstlane((unsigned)(uintptr_t)flagp)); }
    }
    __device__ __forceinline__ void a_ready(const Unit& u, int ui) const {
        if (cnt == nullptr) return;
        if (ui == 0) { spin(u); return; }
        const unsigned seen = *(volatile PG8_LAS const unsigned*)flagp;
        if ((unsigned)__builtin_amdgcn_readfirstlane(seen) < (stage_of(u) ? nb : 256u)) spin(u);
    }
    __device__ __forceinline__ void done(const Unit&) const {}
};
template <class Epi, class Sched, bool ALIGN_EPI = false, bool SP2 = false>
__device__ __forceinline__ void gemm_phase(PG8_LAS unsigned char* lds, const Gemm g, const Sched& S, const Epi& E) {
    const int tid = threadIdx.x, wid = __builtin_amdgcn_readfirstlane(tid >> 6), lane = tid & 63, wr = wid >> 2, wc = wid & 3, fr = lane & 15, fq = lane >> 4;
    const int K = g.K, nt = K / BK;
    unsigned voffA[2], voffB[2];
#pragma unroll
    for (int i = 0; i < 2; ++i) { int R, C; stage_rc(tid * 16 + i * 8192, R, C); const int Rb = Epi::PERM ? ((R & ~31) + perm32(R & 31)) : R;
        voffA[i] = (unsigned)(R * BK + C) * 2u; voffB[i] = (unsigned)(Rb * BK + C) * 2u; }
    const size_t kstep = (size_t)(BM * BK * 2);
    const size_t hstep = (size_t)HALF * BK * 2;
    const size_t tstep = (size_t)BM * K * 2;
    const unsigned ldsw = (unsigned)wid * 1024u;
    const int aoff = lds_byte(wr * 64 + fr, fq * 8), boff = lds_byte(wc * 32 + fr, fq * 8);
#define PG8_SA(b, h) (((b) * 2 + (h)) * HTB)
#define PG8_SB(b, h) ((4 + (b) * 2 + (h)) * HTB)
#define PG8_STAGE(bufoff, gbase, voff) do { _Pragma("unroll") for (int _i = 0; _i < 2; ++_i) \
        __builtin_amdgcn_global_load_lds((const unsigned*)((const char*)(gbase) + (voff)[_i]), (PG8_LAS unsigned*)(lds + (bufoff) + ldsw + _i * 8192), 16, 0, 0); } while (0)
#define PG8_STAGE_A(bufoff, gbase, voff) do { _Pragma("unroll") for (int _i = 0; _i < 2; ++_i) \
        __builtin_amdgcn_global_load_lds((const unsigned*)((const char*)(gbase) + (voff)[_i]), (PG8_LAS unsigned*)(lds + (bufoff) + ldsw + _i * 8192), 16, 0, Epi::A_AUX); } while (0)
#define PG8_LDA(dst, b, h) do { _Pragma("unroll") for (int m = 0; m < 4; ++m) _Pragma("unroll") for (int k = 0; k < 2; ++k) dst[m][k] = *(const PG8_LAS bf16x8*)(lds + PG8_SA(b, h) + aoff + m * 2048 + k * 1024); } while (0)
#define PG8_LDB(dst, b, h) do { _Pragma("unroll") for (int n = 0; n < 2; ++n) _Pragma("unroll") for (int k = 0; k < 2; ++k) dst[n][k] = *(const PG8_LAS bf16x8*)(lds + PG8_SB(b, h) + boff + n * 2048 + k * 1024); } while (0)
#define PG8_MMA(ai, bj, At, Bt) do { __builtin_amdgcn_s_setprio(1); _Pragma("unroll") for (int m = 0; m < 4; ++m) _Pragma("unroll") for (int n = 0; n < 2; ++n) _Pragma("unroll") for (int k = 0; k < 2; ++k) \
        acc[ai][bj][m][n] = __builtin_amdgcn_mfma_f32_16x16x32_bf16(Bt[n][k], At[m][k], acc[ai][bj][m][n], 0, 0, 0); __builtin_amdgcn_s_setprio(0); } while (0)
#define PG8_WAIT_V(n) asm volatile("s_waitcnt vmcnt(" #n ")" ::: "memory")
#define PG8_WAIT_L(n) asm volatile("s_waitcnt lgkmcnt(" #n ")" ::: "memory")
#define PG8_BAR __builtin_amdgcn_s_barrier()
#define PG8_SCHED __builtin_amdgcn_sched_barrier(0)
    Unit cur, nxt; int ui = 0;
    if (!S.next(0, cur)) return;
    f32x4 acc[2][2][4][2];
#pragma unroll
    for (int a = 0; a < 2; ++a)
#pragma unroll
        for (int b = 0; b < 2; ++b)
#pragma unroll
            for (int m = 0; m < 4; ++m)
#pragma unroll
                for (int n = 0; n < 2; ++n) acc[a][b][m][n] = (f32x4){0.f, 0.f, 0.f, 0.f};
    bf16x8 At[4][2], B0[2][2], B1[2][2];
    const char* cA = (const char*)g.A + (size_t)cur.pm * tstep; const char* cB = (const char*)g.Bt + (size_t)cur.pn * tstep;
    S.a_ready(cur, 0);
    if constexpr (SP2) {
        PG8_STAGE(PG8_SB(0, 0), cB, voffB); PG8_STAGE(PG8_SB(0, 1), cB + hstep, voffB); PG8_STAGE_A(PG8_SA(0, 0), cA, voffA); PG8_STAGE_A(PG8_SA(0, 1), cA + hstep, voffA);
        if (wr == 1) PG8_BAR;
        PG8_WAIT_V(2); PG8_BAR;
        PG8_STAGE(PG8_SB(1, 0), cB + kstep, voffB); PG8_STAGE_A(PG8_SA(1, 0), cA + kstep, voffA); PG8_STAGE(PG8_SB(1, 1), cB + hstep + kstep, voffB);
        PG8_WAIT_V(6); PG8_BAR;
    } else {
        PG8_STAGE(PG8_SB(0, 0), cB, voffB); PG8_STAGE_A(PG8_SA(0, 0), cA, voffA); PG8_STAGE(PG8_SB(0, 1), cB + hstep, voffB); PG8_STAGE_A(PG8_SA(0, 1), cA + hstep, voffA);
        if (wr == 1) PG8_BAR;
        PG8_WAIT_V(4); PG8_BAR;
        PG8_STAGE(PG8_SB(1, 0), cB + kstep, voffB); PG8_STAGE_A(PG8_SA(1, 0), cA + kstep, voffA); PG8_STAGE(PG8_SB(1, 1), cB + hstep + kstep, voffB);
        PG8_WAIT_V(6); PG8_BAR;
    }
    for (;;) {
        const bool has_next = S.next(ui + 1, nxt);
        const char* nA = has_next ? (const char*)g.A + (size_t)nxt.pm * tstep : cA; const char* nB = has_next ? (const char*)g.Bt + (size_t)nxt.pn * tstep : cB;
        for (int t = 0; t < nt; t += 2) {
            if constexpr (Epi::MIDSCALE) { if (t == (nt >> 1)) E.midscale(acc, wr, fr, ui); }
            if (t == nt - 4 && has_next) S.a_poll(nxt);
            const bool last = (t == nt - 2);
            const char* a1 = cA + (size_t)(t + 1) * kstep;
            const char* a2 = last ? nA : cA + (size_t)(t + 2) * kstep; const char* b2 = last ? nB : cB + (size_t)(t + 2) * kstep;
            const char* a3 = a2 + kstep; const char* b3 = b2 + kstep;
            if (last && has_next) { S.a_ready(nxt, ui + 1);
#ifdef MK_HOOK_TWICE
            S.a_ready(nxt, ui + 1);
#endif
            }
            if constexpr (SP2) {
            PG8_LDB(B0, 0, 0); PG8_LDB(B1, 0, 1); PG8_SCHED; PG8_LDA(At, 0, 0); PG8_STAGE_A(PG8_SA(1, 1), a1 + hstep, voffA);
            PG8_WAIT_V(8); PG8_WAIT_L(0); PG8_BAR; PG8_MMA(0, 0, At, B0); PG8_MMA(0, 1, At, B1); PG8_BAR; PG8_SCHED;
            PG8_LDA(At, 0, 1); PG8_STAGE(PG8_SB(0, 0), b2, voffB); PG8_STAGE(PG8_SB(0, 1), b2 + hstep, voffB); PG8_STAGE_A(PG8_SA(0, 0), a2, voffA);
            PG8_WAIT_V(8); PG8_WAIT_L(0); PG8_BAR; PG8_MMA(1, 0, At, B0); PG8_MMA(1, 1, At, B1); PG8_BAR; PG8_SCHED;
            PG8_LDB(B0, 1, 0); PG8_LDB(B1, 1, 1); PG8_SCHED; PG8_LDA(At, 1, 0); PG8_STAGE_A(PG8_SA(0, 1), a2 + hstep, voffA);
            PG8_WAIT_V(8); PG8_WAIT_L(0); PG8_BAR; PG8_MMA(0, 0, At, B0); PG8_MMA(0, 1, At, B1); PG8_BAR; PG8_SCHED;
            PG8_LDA(At, 1, 1); PG8_STAGE(PG8_SB(1, 0), b3, voffB); PG8_STAGE(PG8_SB(1, 1), b3 + hstep, voffB); PG8_STAGE_A(PG8_SA(1, 0), a3, voffA);
            PG8_WAIT_V(8); PG8_WAIT_L(0); PG8_BAR; PG8_MMA(1, 0, At, B0); PG8_MMA(1, 1, At, B1); PG8_BAR; PG8_SCHED;
            } else {
            PG8_LDB(B0, 0, 0); PG8_SCHED; PG8_LDA(At, 0, 0); PG8_STAGE_A(PG8_SA(1, 1), a1 + hstep, voffA);
            PG8_WAIT_L(8); PG8_BAR; PG8_WAIT_L(0); PG8_MMA(0, 0, At, B0); PG8_BAR; PG8_SCHED;
            PG8_LDB(B1, 0, 1); PG8_STAGE(PG8_SB(0, 0), b2, voffB);
            PG8_BAR; PG8_WAIT_L(0); PG8_MMA(0, 1, At, B1); PG8_BAR;
            PG8_LDA(At, 0, 1); PG8_STAGE_A(PG8_SA(0, 0), a2, voffA);
            PG8_BAR; PG8_WAIT_L(0); PG8_MMA(1, 0, At, B0); PG8_BAR; PG8_SCHED;
            PG8_STAGE(PG8_SB(0, 1), b2 + hstep, voffB);
            PG8_WAIT_V(6); PG8_BAR; PG8_MMA(1, 1, At, B1); PG8_BAR;
            PG8_LDB(B0, 1, 0); PG8_SCHED; PG8_LDA(At, 1, 0); PG8_STAGE_A(PG8_SA(0, 1), a2 + hstep, voffA);
            PG8_WAIT_L(8); PG8_BAR; PG8_WAIT_L(0); PG8_MMA(0, 0, At, B0); PG8_BAR; PG8_SCHED;
            PG8_LDB(B1, 1, 1); PG8_STAGE(PG8_SB(1, 0), b3, voffB);
            PG8_BAR; PG8_WAIT_L(0); PG8_MMA(0, 1, At, B1); PG8_BAR;
            PG8_LDA(At, 1, 1); PG8_STAGE_A(PG8_SA(1, 0), a3, voffA);
            PG8_BAR; PG8_WAIT_L(0); PG8_MMA(1, 0, At, B0); PG8_BAR; PG8_SCHED;
            PG8_STAGE(PG8_SB(1, 1), b3 + hstep, voffB);
            PG8_WAIT_V(6); PG8_BAR; PG8_MMA(1, 1, At, B1); PG8_BAR;
            }
        }
        if constexpr (ALIGN_EPI) { if (wr == 0) PG8_BAR; }
        if constexpr (!Epi::AFTER_DRAIN) { E(acc, cur, wr, wc, fr, fq, ui); S.done(cur); }
        if (!has_next) break;
#pragma unroll
        for (int a = 0; a < 2; ++a)
#pragma unroll
            for (int b = 0; b < 2; ++b)
#pragma unroll
                for (int m = 0; m < 4; ++m)
#pragma unroll
                    for (int n = 0; n < 2; ++n) acc[a][b][m][n] = (f32x4){0.f, 0.f, 0.f, 0.f};
        cur = nxt; cA = nA; cB = nB; ++ui;
        if constexpr (ALIGN_EPI) { if (wr == 1) PG8_BAR; }
    }
    PG8_WAIT_V(0);
    if constexpr (!ALIGN_EPI) { if (wr == 0) PG8_BAR; }
    PG8_BAR;
    if constexpr (Epi::AFTER_DRAIN) { E.fused(acc, cur, wr, wc, fr, fq, lds, wid, lane); S.done(cur); }
#undef PG8_SA
#undef PG8_SB
#undef PG8_STAGE
#undef PG8_STAGE_A
#undef PG8_LDA
#undef PG8_LDB
#undef PG8_MMA
#undef PG8_WAIT_V
#undef PG8_WAIT_L
#undef PG8_BAR
#undef PG8_SCHED
}
}
constexpr int NWAVES = 8;
#ifndef MK_CUTS
#define MK_CUTS 0
#endif
constexpr int N_PHASES = 7;

constexpr int BATCH = 8, SEQ = 4096, DM = 1024, CTXL = 256;
constexpr int MROWS = BATCH * SEQ;
constexpr int CROWS = BATCH * CTXL;
constexpr int INW = 1792, FFH = 2816, NMOD = 6 * DM;
constexpr float LOG2E = 1.4426950408889634f;

constexpr size_t MiB = 1u << 20;
constexpr size_t WS_CTL = 0, CTL_ZERO_BYTES = 128 * 1024;
constexpr size_t WS_MOD = 1 * MiB;
constexpr size_t WS_ROPE = WS_MOD + 256 * 1024;
constexpr size_t WS_BIAS = WS_ROPE + 64 * 1024;
constexpr size_t WS_SSQ3 = 2 * MiB;
constexpr size_t WS_WIN = 4 * MiB, WS_WOUT = 8 * MiB, WS_WGU = 10 * MiB, WS_WDN = 21 * MiB;
constexpr size_t WS_SSQ2 = 27 * MiB;
constexpr size_t WS_WSP = 29 * MiB;
constexpr size_t WS_RSTD3 = 30 * MiB;
constexpr size_t WS_XN = 32 * MiB;
constexpr size_t WS_A2 = WS_XN;
constexpr size_t WS_Y = 100 * MiB;
constexpr size_t WS_YC = 212 * MiB;
constexpr size_t WS_A3 = 216 * MiB;
constexpr size_t WS_H = 280 * MiB;
constexpr size_t WS_KV = 456 * MiB;
constexpr size_t WS_END = 472 * MiB;
static_assert(WS_BIAS + 8 * 5632 * 4 <= WS_SSQ3 && WS_WDN + (size_t)1024 * 2816 * 2 <= WS_SSQ2 && WS_SSQ2 + 2 * MiB <= WS_WSP && WS_WSP + 262144 <= WS_XN && WS_XN + (size_t)34816 * 2048 <= WS_Y && WS_Y + (size_t)MROWS * INW * 2 <= WS_YC && WS_YC + (size_t)CROWS * 512 <= WS_A3 && WS_A3 + (size_t)MROWS * 2048 <= WS_H && WS_H + (size_t)MROWS * FFH * 2 <= WS_END, "d_ws map");
constexpr int CW_TMO = 0, CW_CODE = 1;
constexpr int CW_BIASF = 28800;
constexpr int CW_RT = 28928;
constexpr int CW_BAR = 4096;

constexpr int RING_OFF = 0, RING_BYTES = 131072;
constexpr int LDSCTL_OFF = RING_BYTES, MISC_OFF = LDSCTL_OFF + 320;
constexpr int LDS_BYTES = 147456;

#define GAS __attribute__((address_space(1)))
#define LAS __attribute__((address_space(3)))
typedef unsigned short bf16;
typedef unsigned v4u __attribute__((ext_vector_type(4)));
typedef float f32x4 __attribute__((ext_vector_type(4)));
typedef short bf16x8 __attribute__((ext_vector_type(8)));
typedef GAS unsigned gu32;
typedef GAS unsigned long long gu64;
#define RLX_AGENT __ATOMIC_RELAXED, __HIP_MEMORY_SCOPE_AGENT
#define LDS_WAIT() asm volatile("s_waitcnt lgkmcnt(0)" ::: "memory")
#define VM_WAIT() asm volatile("s_waitcnt vmcnt(0)" ::: "memory")
__device__ __forceinline__ unsigned long long rt() { return __builtin_amdgcn_s_memrealtime(); }
__device__ __forceinline__ unsigned f2bf(float f) { unsigned u = __builtin_bit_cast(unsigned, f); return (u + 0x7fffu + ((u >> 16) & 1u)) >> 16; }
typedef float f32x2_pk __attribute__((ext_vector_type(2))); typedef __bf16 bf16x2_pk __attribute__((ext_vector_type(2)));
__device__ __forceinline__ unsigned pk2(float lo, float hi) { f32x2_pk v = {lo, hi}; bf16x2_pk b = __builtin_convertvector(v, bf16x2_pk); return __builtin_bit_cast(unsigned, b); }
#define XB_TMO      128
#define XB_XCNT(j)  (256  + 64 * (j))
#define XB_XSUB(j)  (1280 + 64 * (j))
#define XB_XGEN(j)  (2304 + 64 * (j))
#define XB_TOP      3328
#define XB_TOPGEN   3392
#define XCD_BAR_WORDS 3456
#define XB_SPIN_CAP (1u << 22)

__device__ __forceinline__ unsigned xb_ld(unsigned* p)              { return __hip_atomic_load(p, __ATOMIC_RELAXED, __HIP_MEMORY_SCOPE_AGENT); }
__device__ __forceinline__ unsigned xb_add(unsigned* p, unsigned v) { return __hip_atomic_fetch_add(p, v, __ATOMIC_RELAXED, __HIP_MEMORY_SCOPE_AGENT); }
__device__ __forceinline__ unsigned xb_xcc_id() { return (unsigned)__builtin_amdgcn_s_getreg((3 << 11) | 20) & 0xFu; }
#define XB_SPIN(cond, bar) do { unsigned _sp = 0; while (cond) { __builtin_amdgcn_s_sleep(1); \
    if ((++_sp & 255u) == 0u) { if (xb_ld(&(bar)[XB_TMO])) break; if (_sp > XB_SPIN_CAP) { atomicAdd(&(bar)[XB_TMO], 1u); break; } } } } while (0)

struct XcdBarrier {
    unsigned* bar; unsigned x;
    volatile LAS unsigned* st;
};

__device__ __forceinline__ XcdBarrier xcd_barrier_post(unsigned* bar, volatile LAS unsigned* st) {
    XcdBarrier b; b.bar = bar; b.x = xb_xcc_id(); b.st = st;
    if (threadIdx.x == 0) st[3] = xb_add(&bar[XB_XCNT(b.x)], 1u);
    return b;
}
__device__ __forceinline__ void xcd_barrier_complete(unsigned* bar, unsigned x, unsigned& nloc, unsigned& nx, unsigned& uni) {
    const unsigned G = gridDim.x * gridDim.y * gridDim.z;
    unsigned sum, cnt, mine, even, sp = 0u;
    for (;;) {
        sum = 0u; cnt = 0u; mine = 0u; even = 1u;
#pragma unroll
        for (unsigned j = 0; j < 16; ++j) { const unsigned c = xb_ld(&bar[XB_XCNT(j)]); sum += c; cnt += (c > 0u) ? 1u : 0u; mine = (j == x) ? c : mine; even &= (c == ((j < 8u) ? (G >> 3) : 0u)) ? 1u : 0u; }
        if (sum == G) break;
        __builtin_amdgcn_s_sleep(1);
        if ((++sp & 255u) == 0u) { if (xb_ld(&bar[XB_TMO])) break; if (sp > XB_SPIN_CAP) { atomicAdd(&bar[XB_TMO], 1u); break; } }
    }
    nloc = mine > 0u ? mine : 1u; nx = cnt > 0u ? cnt : 1u; uni = (sum == G && (G & 7u) == 0u && even) ? 1u : 2u;
}

__device__ __forceinline__ void xcd_barrier(const XcdBarrier& b, bool local = false) {
    asm volatile("s_waitcnt vmcnt(0)" ::: "memory");
    __syncthreads();
    if (threadIdx.x == 0) {
        unsigned* bar = b.bar;
        __builtin_amdgcn_s_waitcnt(0);
        unsigned nloc = b.st[0], nx = b.st[1];
        if (nloc == 0u) { unsigned uni; xcd_barrier_complete(bar, b.x, nloc, nx, uni); b.st[0] = nloc; b.st[1] = nx; b.st[2] = uni; }
        const unsigned old = xb_add(&bar[XB_XSUB(b.x)], 1u);
        const unsigned gen = old / nloc;
        if (old + 1u == (gen + 1u) * nloc && local) {
            __builtin_amdgcn_fence(__ATOMIC_ACQUIRE, "agent");
            xb_add(&bar[XB_XGEN(b.x)], 1u);
            asm volatile("s_waitcnt vmcnt(0)" ::: "memory");
        } else if (old + 1u == (gen + 1u) * nloc) {
            __builtin_amdgcn_fence(__ATOMIC_RELEASE, "agent");
            asm volatile("s_waitcnt vmcnt(0)" ::: "memory");
            const unsigned og = xb_add(&bar[XB_TOP], 1u);
            const unsigned tg = og / nx;
            if (og + 1u == (tg + 1u) * nx) xb_add(&bar[XB_TOPGEN], 1u);
            else XB_SPIN(xb_ld(&bar[XB_TOPGEN]) == tg, bar);
            __builtin_amdgcn_fence(__ATOMIC_ACQUIRE, "agent");
            xb_add(&bar[XB_XGEN(b.x)], 1u);
            asm volatile("s_waitcnt vmcnt(0)" ::: "memory");
        } else {
            XB_SPIN(xb_ld(&bar[XB_XGEN(b.x)]) == gen, bar);
            __builtin_amdgcn_fence(__ATOMIC_ACQUIRE, "agent");
            asm volatile("s_waitcnt vmcnt(0)" ::: "memory");
        }
    }
    __syncthreads();
}
struct Frame {
    LAS unsigned char* lds;
    volatile LAS unsigned* MISC;
    gu32* ctl;
    int tid, lane, wave;
    int vcu, G, cid, xcc, uni;
    const float *x, *c, *ctx, *c_ctx, *w_mod, *b_mod, *norm_mix, *norm_ffn, *w_in, *q_gain, *k_gain, *attn_sink, *gate_gain, *w_spatial, *b_spatial, *attn_out_gain, *mlp_out_gain, *w_out, *w_gate_up, *w_down;
    float* out;
    float *mod, *rope, *bias_t, *ssq3, *ssq2, *rstd3;
    bf16 *Win_t, *Wout_t, *Wgu_t, *Wdn_t, *XN, *Y, *Yc, *H, *A2, *A3, *Wsp, *KV;
};
__device__ __forceinline__ float bf2f(unsigned h) { return __builtin_bit_cast(float, h << 16); }
__device__ __forceinline__ float wave_sum(float v) {
#pragma unroll
    for (int o = 1; o < 64; o <<= 1) v += __shfl_xor(v, o);
    return v;
}
__device__ __forceinline__ float wave_max(float v) {
#pragma unroll
    for (int o = 1; o < 64; o <<= 1) v = fmaxf(v, __shfl_xor(v, o));
    return v;
}

__device__ __forceinline__ int dst_row(int mat, int n) {
    if (mat == 0) {
        const int head = n >> 6, d = n & 63, bj = d >> 5, l = d & 31;
        const bool rp = head < 2 || (head >= 4 && head < 12);
        const int p = rp ? (8 * ((l >> 2) & 3) + 4 * (l >> 4) + (l & 3)) : l;
        return 256 * (head >> 2) + 128 * bj + 32 * (head & 3) + p;
    }
    if (mat == 2) { const int bj = n >= FFH ? 1 : 0, j = n - FFH * bj; return 256 * (j >> 7) + 128 * bj + (j & 127); }
    return n;
}
__device__ __forceinline__ void p0_transpose_item(const float* W, int K, int N, bf16* WT, int mat, const float* g0, const float* g1, LAS float* scr, int item, int lane) {
    const int nblk = N / 32, kb = item / nblk, nb = item % nblk, k0 = 64 * kb, n0 = 32 * nb;
    const unsigned loff = (unsigned)((lane >> 5) * N + (lane & 31)); const float* wb = W + (size_t)k0 * N + n0;
    { float v[32];
#pragma unroll
      for (int i = 0; i < 32; ++i) v[i] = __builtin_nontemporal_load(wb + (size_t)(2 * i) * N + loff);
      __builtin_amdgcn_sched_barrier(0);
#pragma unroll
      for (int i = 0; i < 32; ++i) scr[(2 * i + (lane >> 5)) * 33 + (lane & 31)] = v[i];
      __builtin_amdgcn_sched_barrier(0); }
    LDS_WAIT(); asm volatile("" ::: "memory");
    const int c = lane & 7;
    float gk[8];
#pragma unroll
    for (int i = 0; i < 8; ++i) { const int k = k0 + 8 * c + i; gk[i] = (mat == 1) ? (k < 512 ? g0[k] : g1[k - 512]) : 1.0f; }
#pragma unroll
    for (int j = 0; j < 4; ++j) { const int n = (lane >> 3) + 8 * j; const LAS float* s = scr + (8 * c) * 33 + n;
        v4u o; o.x = pk2(s[0 * 33] * gk[0], s[1 * 33] * gk[1]); o.y = pk2(s[2 * 33] * gk[2], s[3 * 33] * gk[3]); o.z = pk2(s[4 * 33] * gk[4], s[5 * 33] * gk[5]); o.w = pk2(s[6 * 33] * gk[6], s[7 * 33] * gk[7]);
        *(GAS v4u*)(WT + pg8::tiled_off(dst_row(mat, n0 + n), k0 + 8 * c, K / 64)) = o; }
    LDS_WAIT(); asm volatile("" ::: "memory");
}
__device__ __forceinline__ void p0_prologue(Frame& F) {
#ifdef MK_P0A_TWICE
    for (int repa = 0; repa < 2; ++repa)
#endif
    if (F.vcu < NMOD / 32) {
        LAS float* sc = (LAS float*)(F.lds);
        LAS float* red = (LAS float*)(F.lds + 36864);
        { float cv[18];
#pragma unroll
          for (int j = 0; j < 18; ++j) { const int k = 512 * (j & 1) + F.tid; cv[j] = (j < 16) ? F.c[(j >> 1) * DM + k] : F.c_ctx[k]; }
          __builtin_amdgcn_sched_barrier(0);
#pragma unroll
          for (int j = 0; j < 18; ++j) { const float v = cv[j]; sc[512 * j + F.tid] = v / (1.0f + __expf(-v)); } }
        __syncthreads();
        for (int item = F.vcu; item < NMOD / 32; item += F.G) {
            const int kg = F.tid >> 3, c4 = (F.tid & 7) * 4;
            const float* wb = F.w_mod + item * 32 + (size_t)kg * NMOD + c4;
            f32x4 w[16];
#pragma unroll
            for (int i = 0; i < 16; ++i) w[i] = __builtin_nontemporal_load((const GAS f32x4*)(wb + (size_t)(64 * i) * NMOD));
            __builtin_amdgcn_sched_barrier(0);
            f32x4 a[9];
#pragma unroll
            for (int n = 0; n < 9; ++n) a[n] = (f32x4){0.f, 0.f, 0.f, 0.f};
#pragma unroll
            for (int i = 0; i < 16; ++i) { const int k = 64 * i + kg;
#pragma unroll
                for (int n = 0; n < 9; ++n) a[n] += w[i] * sc[n * DM + k]; }
#pragma unroll
            for (int n = 0; n < 9; ++n) *(LAS f32x4*)(red + (kg * 9 + n) * 32 + c4) = a[n];
            __syncthreads();
            if (F.tid < 288) { const int n = F.tid >> 5, cc = F.tid & 31; float s = 0.f;
#pragma unroll 16
                for (int g = 0; g < 64; ++g) s += red[(g * 9 + n) * 32 + cc];
                F.mod[n * NMOD + item * 32 + cc] = s + F.b_mod[item * 32 + cc]; }
            __syncthreads();
        }
    }
    { const int gt = F.vcu * NWAVES * 64 + F.tid;
      if (gt < 1024) { const int pos = gt >> 4, f = gt & 15; const float inv = __builtin_amdgcn_exp2f(-(float)f * 0.8304820237218406f);
        const float ang = (float)pos * inv; F.rope[2 * gt] = __cosf(ang); F.rope[2 * gt + 1] = __sinf(ang); } }
    for (int it = F.vcu * NWAVES * 64 + F.tid; it < 8 * 128 * 16; it += F.G * NWAVES * 64) {
        const int hp = it >> 4, ks = (it >> 1) & 7, hi = it & 1;
        const float* srcp = F.w_spatial + (size_t)hp * 128 + 16 * ks + 4 * hi;
        const f32x4 a0 = *(const f32x4*)srcp, a1 = *(const f32x4*)(srcp + 8);
        v4u o; o.x = pk2(a0[0], a0[1]); o.y = pk2(a0[2], a0[3]); o.z = pk2(a1[0], a1[1]); o.w = pk2(a1[2], a1[3]);
        { const int h_ = hp >> 7, p_ = hp & 127, half_ = p_ >> 6, pbl_ = (p_ >> 5) & 1, r32_ = p_ & 31, qt_ = ks >> 2, ksl_ = ks & 3;
          *(GAS v4u*)(F.Wsp + ((size_t)((h_ * 2 + half_) * 16 + qt_ * 8 + pbl_ * 4 + ksl_) * 64 + hi * 32 + r32_) * 8) = o; } }
    __syncthreads();
    LAS float* scr = (LAS float*)(F.lds + RING_OFF + F.wave * 16384);
    const int gw = F.vcu * NWAVES + F.wave, NGW = F.G * NWAVES;
    constexpr int I_IN = (DM / 64) * (INW / 32), I_OUT = (DM / 64) * (DM / 32), I_GU = (DM / 64) * (2 * FFH / 32), I_DN = (FFH / 64) * (DM / 32);
    constexpr int NITEMS = I_IN + I_OUT + I_GU + I_DN;
#ifdef MK_P0C_TWICE
    for (int repc = 0; repc < 2; ++repc)
#endif
    const bool heavy_ = F.vcu >= NMOD / 32; const int n_light_ = F.G < NMOD / 32 ? F.G : NMOD / 32;
    const int nvw_ = n_light_ * NWAVES + (F.G - n_light_) * 2 * NWAVES;
    const int vw0_ = heavy_ ? n_light_ * NWAVES + (F.vcu - NMOD / 32) * 2 * NWAVES + F.wave : gw;
    for (int jj = 0; ; ++jj) {
        const int it = heavy_ ? vw0_ + ((jj & 1) ? NWAVES : 0) + (jj >> 1) * nvw_ : vw0_ + jj * nvw_;
        if (it >= NITEMS) break;
        int r = it;
        if (r < I_IN) { p0_transpose_item(F.w_in, DM, INW, F.Win_t, 0, nullptr, nullptr, scr, r, F.lane); continue; } r -= I_IN;
        if (r < I_OUT) { p0_transpose_item(F.w_out, DM, DM, F.Wout_t, 1, F.attn_out_gain, F.mlp_out_gain, scr, r, F.lane); continue; } r -= I_OUT;
        if (r < I_GU) { p0_transpose_item(F.w_gate_up, DM, 2 * FFH, F.Wgu_t, 2, nullptr, nullptr, scr, r, F.lane); continue; } r -= I_GU;
        p0_transpose_item(F.w_down, FFH, DM, F.Wdn_t, 3, nullptr, nullptr, scr, r, F.lane);
    }
}
#ifndef MK_NA
#define MK_NA 14
#endif
#ifndef MK_P1_NR
#define MK_P1_NR 5
#endif
constexpr int P12_NA = MK_NA;
constexpr int P12_RANK_L = 17, P12_NWL = (32 - P12_RANK_L) * NWAVES;
constexpr int P12_NB = (17 - P12_NA) * 256;
__device__ __forceinline__ void p1_two_rows(Frame& F, int r0, int r1, bool has1) {
    const float* src0 = r0 < MROWS ? F.x + (size_t)r0 * DM : F.ctx + (size_t)(r0 - MROWS) * DM;
    const float* src1 = r1 < MROWS ? F.x + (size_t)r1 * DM : F.ctx + (size_t)(r1 - MROWS) * DM;
    f32x4 v0[4], v1[4]; float s0 = 0.f, s1 = 0.f;
#pragma unroll
    for (int j = 0; j < 4; ++j) { v0[j] = __builtin_nontemporal_load((const GAS f32x4*)src0 + F.lane + 64 * j); v1[j] = __builtin_nontemporal_load((const GAS f32x4*)src1 + F.lane + 64 * j); }
#pragma unroll
    for (int j = 0; j < 4; ++j) { s0 += (v0[j].x * v0[j].x + v0[j].y * v0[j].y) + (v0[j].z * v0[j].z + v0[j].w * v0[j].w); s1 += (v1[j].x * v1[j].x + v1[j].y * v1[j].y) + (v1[j].z * v1[j].z + v1[j].w * v1[j].w); }
    const float rstd0 = 1.0f / sqrtf(wave_sum(s0) * (1.0f / DM) + 1e-6f), rstd1 = 1.0f / sqrtf(wave_sum(s1) * (1.0f / DM) + 1e-6f);
#pragma unroll
    for (int rr = 0; rr < 2; ++rr) { if (rr == 1 && !has1) break;
        const int r = rr ? r1 : r0; const float rstd = rr ? rstd1 : rstd0;
        const float* md = F.mod + (r < MROWS ? (r >> 12) : 8) * NMOD;
#pragma unroll
        for (int j = 0; j < 4; ++j) { const int cidx = 4 * F.lane + 256 * j;
            const f32x4 g = *(const f32x4*)(F.norm_mix + cidx), sh = *(const f32x4*)(md + cidx), sc = *(const f32x4*)(md + DM + cidx);
            const f32x4 y = ((rr ? v1[j] : v0[j]) * rstd) * g * (sc + 1.0f) + sh;
#ifdef MK_XN_NT
            __builtin_nontemporal_store((unsigned long long)pk2(y.x, y.y) | ((unsigned long long)pk2(y.z, y.w) << 32), (GAS unsigned long long*)(F.XN + pg8::tiled_off(r, cidx, 16))); } }
#else
            *(GAS unsigned long long*)(F.XN + pg8::tiled_off(r, cidx, 16)) = (unsigned long long)pk2(y.x, y.y) | ((unsigned long long)pk2(y.z, y.w) << 32); } }
#endif
}
template <int NR>
__device__ __forceinline__ void p1_n_rows(Frame& F, const int (&r)[NR], const bool (&ok)[NR], int mrow) {
    f32x4 v[NR][4]; float rstd[NR];
#pragma unroll
    for (int q = 0; q < NR; ++q) { const float* src = F.x + (size_t)r[q] * DM;
#pragma unroll
        for (int j = 0; j < 4; ++j) v[q][j] = __builtin_nontemporal_load((const GAS f32x4*)src + F.lane + 64 * j); }
#pragma unroll
    for (int q = 0; q < NR; ++q) { float s = 0.f;
#pragma unroll
        for (int j = 0; j < 4; ++j) s += (v[q][j].x * v[q][j].x + v[q][j].y * v[q][j].y) + (v[q][j].z * v[q][j].z + v[q][j].w * v[q][j].w);
        rstd[q] = 1.0f / sqrtf(wave_sum(s) * (1.0f / DM) + 1e-6f); }
    const float* md = F.mod + mrow * NMOD;
#pragma unroll
    for (int j = 0; j < 4; ++j) { const int cidx = 4 * F.lane + 256 * j;
        const f32x4 g = *(const f32x4*)(F.norm_mix + cidx), sh = *(const f32x4*)(md + cidx), sc = *(const f32x4*)(md + DM + cidx);
#pragma unroll
        for (int q = 0; q < NR; ++q) if (ok[q]) { const f32x4 y = (v[q][j] * rstd[q]) * g * (sc + 1.0f) + sh;
            *(GAS unsigned long long*)(F.XN + pg8::tiled_off(r[q], cidx, 16)) = (unsigned long long)pk2(y.x, y.y) | ((unsigned long long)pk2(y.z, y.w) << 32); } }
}
__device__ __forceinline__ void p1_norm_rows(Frame& F) {
    const int gw = F.vcu * NWAVES + F.wave, NGW = F.G * NWAVES;
    if (F.uni) {
        const int rank = F.vcu & 31, wl = rank * NWAVES + F.wave;
        unsigned* cnt = (unsigned*)F.ctl + CW_RT + F.xcc * 32;
#pragma unroll 1
        for (int k0 = 0; k0 < P12_NA; k0 += MK_P1_NR) { int r[MK_P1_NR]; bool ok[MK_P1_NR];
#pragma unroll
            for (int q = 0; q < MK_P1_NR; ++q) { ok[q] = k0 + q < P12_NA; r[q] = F.xcc * SEQ + wl + 256 * (ok[q] ? k0 + q : k0); }
            p1_n_rows<MK_P1_NR>(F, r, ok, F.xcc); }
        asm volatile("s_waitcnt vmcnt(0)" ::: "memory");
        if (F.lane == 0) __hip_atomic_fetch_add(cnt, 1u, __ATOMIC_RELAXED, __HIP_MEMORY_SCOPE_AGENT);
        if (rank >= P12_RANK_L) {
            const int wlL = (rank - P12_RANK_L) * NWAVES + F.wave;
            constexpr int NLAT = (16 - P12_NA) * 256;
#pragma unroll 1
            for (int j0 = wlL; j0 < NLAT; j0 += 5 * P12_NWL) { int r[5]; bool ok[5];
#pragma unroll
                for (int q = 0; q < 5; ++q) { const int j = j0 + q * P12_NWL; ok[q] = j < NLAT; r[q] = F.xcc * SEQ + P12_NA * 256 + (ok[q] ? j : j0); }
                p1_n_rows<5>(F, r, ok, F.xcc); }
#pragma unroll 1
            for (int j0 = wlL; j0 < CTXL; j0 += 2 * P12_NWL) { const int j1 = j0 + P12_NWL; const bool has1 = j1 < CTXL;
                p1_two_rows(F, MROWS + F.xcc * CTXL + j0, MROWS + F.xcc * CTXL + (has1 ? j1 : j0), has1); }
            asm volatile("s_waitcnt vmcnt(0)" ::: "memory");
            if (F.lane == 0) __hip_atomic_fetch_add(cnt + 1, 1u, __ATOMIC_RELAXED, __HIP_MEMORY_SCOPE_AGENT);
        }
    } else {
        const int nk = (MROWS + CROWS - gw + NGW - 1) / NGW;
#pragma unroll 1
        for (int k0 = 0; k0 < nk; k0 += 2) { const bool has1 = k0 + 1 < nk; p1_two_rows(F, gw + NGW * k0, has1 ? gw + NGW * (k0 + 1) : gw + NGW * k0, has1); }
    }
    float rp_[4], gp_[2];
#pragma unroll
    for (int i = 0; i < 4; ++i) rp_[i] = F.rope[F.tid + 512 * i];
#pragma unroll
    for (int i = 0; i < 2; ++i) { const int gi_ = F.tid + 512 * i; gp_[i] = gi_ < 64 ? F.q_gain[gi_] * pg8::C2Q : gi_ < 128 ? F.k_gain[gi_ - 64] : gi_ < 640 ? F.gate_gain[gi_ - 128] : 0.f; }
#ifdef MK_BIAS_TWICE
    for (int brep = 0; brep < 2; ++brep)
#endif
#pragma unroll 1
    for (int R0 = gw; R0 < 2 * FFH; R0 += 3 * NGW) {
        v4u w0[3], w1[3]; f32x4 shv[BATCH][4];
#pragma unroll
        for (int k = 0; k < 3; ++k) { const int R = R0 + NGW * k, Rc = R < 2 * FFH ? R : R0;
            w0[k] = *(const GAS v4u*)(F.Wgu_t + pg8::tiled_off(Rc, 16 * F.lane, 16)); w1[k] = *(const GAS v4u*)(F.Wgu_t + pg8::tiled_off(Rc, 16 * F.lane, 16) + 8); }
#pragma unroll
        for (int b = 0; b < BATCH; ++b)
#pragma unroll
            for (int i = 0; i < 4; ++i) shv[b][i] = *(const f32x4*)(F.mod + b * NMOD + 3 * DM + 16 * F.lane + 4 * i);
        __builtin_amdgcn_sched_barrier(0);
#pragma unroll
        for (int k = 0; k < 3; ++k) { float wf[16]; const int R = R0 + NGW * k;
#pragma unroll
            for (int i = 0; i < 4; ++i) { wf[2 * i] = bf2f(w0[k][i] & 0xffffu); wf[2 * i + 1] = bf2f(w0[k][i] >> 16); wf[8 + 2 * i] = bf2f(w1[k][i] & 0xffffu); wf[8 + 2 * i + 1] = bf2f(w1[k][i] >> 16); }
            float s[BATCH];
#pragma unroll
            for (int b = 0; b < BATCH; ++b) { s[b] = 0.f;
#pragma unroll
                for (int i = 0; i < 4; ++i) { const f32x4 t = shv[b][i]; s[b] += (t[0] * wf[4 * i] + t[1] * wf[4 * i + 1]) + (t[2] * wf[4 * i + 2] + t[3] * wf[4 * i + 3]); } }
#pragma unroll
            for (int o = 1; o < 64; o <<= 1) {
#pragma unroll
                for (int b = 0; b < BATCH; ++b) s[b] += __shfl_xor(s[b], o); }
            if (F.lane == 0 && R < 2 * FFH) {
                const float bsc = (R & 128) ? -0.6931471805599453f : -1.4426950408889634f;
#pragma unroll
                for (int b = 0; b < BATCH; ++b) __hip_atomic_store(F.bias_t + b * 2 * FFH + R, s[b] * bsc, __ATOMIC_RELAXED, __HIP_MEMORY_SCOPE_AGENT); } }
    }
    { LAS float* ropeL_ = (LAS float*)(F.lds + LDSCTL_OFF + 1024); LAS float* gainL_ = ropeL_ + 64 * 36;
#pragma unroll
      for (int i = 0; i < 4; ++i) { const int ix_ = F.tid + 512 * i; ropeL_[(ix_ >> 5) * 36 + (ix_ & 31)] = rp_[i]; }
#pragma unroll
      for (int i = 0; i < 2; ++i) { const int gi_ = F.tid + 512 * i; if (gi_ < 640) gainL_[gi_] = gp_[i]; } }
    asm volatile("s_waitcnt vmcnt(0)" ::: "memory");
    if (F.lane == 0) __hip_atomic_fetch_add((unsigned*)F.ctl + CW_BIASF, 1u, __ATOMIC_RELAXED, __HIP_MEMORY_SCOPE_AGENT);
}

namespace mix {
typedef short bf16x8 __attribute__((ext_vector_type(8)));
typedef short s16x4 __attribute__((ext_vector_type(4)));
typedef float f32x16 __attribute__((ext_vector_type(16)));
typedef LAS const char* lcp;
constexpr int SLOT = 32768;
constexpr int L_OST = 98304, L_WSF = LDSCTL_OFF + 1024;
constexpr int L_GT = 0;
__device__ __forceinline__ int crow(int r, int hi) { return (r & 3) + 8 * (r >> 2) + 4 * hi; }
__device__ __forceinline__ void glds16(const void* gsrc, unsigned lds_dst) { unsigned keep;
    asm volatile("s_mov_b32 %0, m0\n\ts_mov_b32 m0, %2\n\ts_nop 0\n\tglobal_load_lds_dwordx4 %1, off\n\ts_mov_b32 m0, %0" : "=&s"(keep) : "v"(gsrc), "s"(lds_dst) : "memory"); }
typedef float f32x2_t __attribute__((ext_vector_type(2))); typedef __bf16 bf16x2_t __attribute__((ext_vector_type(2)));
__device__ __forceinline__ unsigned cvtpk_s(float lo, float hi) { f32x2_t v = {lo, hi}; bf16x2_t b = __builtin_convertvector(v, bf16x2_t); return __builtin_bit_cast(unsigned, b); }
#define MIX_SBAR() __builtin_amdgcn_sched_barrier(0)
#define MIX_WAIT_BAR() asm volatile("s_waitcnt vmcnt(0) lgkmcnt(0)\n\ts_barrier" ::: "memory")
__device__ __forceinline__ void qkt(f32x16& p0, f32x16& p1, lcp Kslot, const bf16x8* qr, int r32, int hi) {
    lcp kb = Kslot + hi * 1024 + r32 * 16;
    f32x16 z0 = {}, z1 = {};
#pragma unroll
    for (int d0 = 0; d0 < 4; ++d0) {
        const bf16x8 b0 = *(LAS const bf16x8*)(kb + d0 * 2048), b1 = *(LAS const bf16x8*)(kb + d0 * 2048 + 512);
        z0 = __builtin_amdgcn_mfma_f32_32x32x16_bf16(b0, qr[d0], z0, 0, 0, 0); z1 = __builtin_amdgcn_mfma_f32_32x32x16_bf16(b1, qr[d0], z1, 0, 0, 0); }
    p0 = z0; p1 = z1;
}
__device__ __forceinline__ void pv(f32x16* o, int vb, bf16x8 pa0, bf16x8 pa1, bf16x8 pa2, bf16x8 pa3) {
#pragma unroll
    for (int d0 = 0; d0 < 2; ++d0) { s16x4 lo[4], hi[4];
#pragma unroll
        for (int ks = 0; ks < 4; ++ks) {
            asm volatile("ds_read_b64_tr_b16 %0,%1 offset:%c2" : "=&v"(lo[ks]) : "v"(vb), "i"(d0 * 4096 + ks * 1024) : "memory");
            asm volatile("ds_read_b64_tr_b16 %0,%1 offset:%c2" : "=&v"(hi[ks]) : "v"(vb), "i"(d0 * 4096 + ks * 1024 + 512) : "memory"); }
        asm volatile("s_waitcnt lgkmcnt(0)" ::: "memory"); MIX_SBAR();
#define MIX_PK(k) (bf16x8){lo[k][0], lo[k][1], lo[k][2], lo[k][3], hi[k][0], hi[k][1], hi[k][2], hi[k][3]}
        o[d0] = __builtin_amdgcn_mfma_f32_32x32x16_bf16(pa0, MIX_PK(0), o[d0], 0, 0, 0);
        o[d0] = __builtin_amdgcn_mfma_f32_32x32x16_bf16(pa1, MIX_PK(1), o[d0], 0, 0, 0);
        o[d0] = __builtin_amdgcn_mfma_f32_32x32x16_bf16(pa2, MIX_PK(2), o[d0], 0, 0, 0);
        o[d0] = __builtin_amdgcn_mfma_f32_32x32x16_bf16(pa3, MIX_PK(3), o[d0], 0, 0, 0);
#undef MIX_PK
    }
}
__device__ __forceinline__ void store_pair16(bf16* p, unsigned (&wa)[2], unsigned (&wb)[2]) {
    auto r0 = __builtin_amdgcn_permlane32_swap(wa[0], wb[0], false, false); auto r1 = __builtin_amdgcn_permlane32_swap(wa[1], wb[1], false, false);
    v4u w; w.x = r0[0]; w.y = r1[0]; w.z = r0[1]; w.w = r1[1];
    *(GAS v4u*)p = w;
}
typedef short v4i16_t __attribute__((ext_vector_type(4)));
__device__ __forceinline__ s16x4 vtr(lcp p) { return __builtin_bit_cast(s16x4, __builtin_amdgcn_ds_read_tr16_b64_v4i16((LAS v4i16_t*)p)); }
__device__ __forceinline__ bf16x8 pack8(const f32x16& p, int b0) {
    v4u w; w.x = cvtpk_s(p[b0], p[b0 + 1]); w.y = cvtpk_s(p[b0 + 2], p[b0 + 3]); w.z = cvtpk_s(p[b0 + 4], p[b0 + 5]); w.w = cvtpk_s(p[b0 + 6], p[b0 + 7]); return __builtin_bit_cast(bf16x8, w); }

__device__ __forceinline__ void gmlp_dma(Frame& F, int b, int blk) {
    unsigned ln = (unsigned)F.lane; asm volatile("" : "+v"(ln));
    const int h = F.wave; const size_t row0 = (size_t)b * SEQ + blk * 128;
    const unsigned gslot = (unsigned)(uintptr_t)F.lds + L_GT + h * 16384;
    const bf16* base = F.Y + row0 * INW + 1280 + 64 * h + ((ln >> 2) * (unsigned)INW + (ln & 3u) * 8u);
#pragma unroll
    for (int qt = 0; qt < 2; ++qt)
#pragma unroll
        for (int w = 0; w < 8; ++w)
            glds16(base + (size_t)(64 * qt + 16 * (w & 3)) * INW + (w >> 2) * 32, (unsigned)__builtin_amdgcn_readfirstlane(gslot + qt * 8192 + w * 1024));
}
template <bool DO_DMA> __device__ __forceinline__ void gmlp_unit(Frame& F, int b, int blk) {
    const int lane = F.lane, r32 = lane & 31, hi = lane >> 5, h = F.wave;
    const size_t row0 = (size_t)b * SEQ + blk * 128;
    const unsigned lds0 = (unsigned)(uintptr_t)F.lds;
    const unsigned gslot = lds0 + L_GT + h * 16384;
    const int vb0 = (int)gslot + ((lane >> 4) & 1) * 32 + (lane & 3) * 8 + (4 * hi + ((lane & 15) >> 2)) * 64;
    if (DO_DMA) gmlp_dma(F, b, blk);
#pragma unroll 1
    for (int half = 0; half < 2; ++half) {
        int p0 = 64 * half + r32; asm volatile("" : "+v"(p0));
        const bf16* wp = F.Wsp + ((size_t)(h * 2 + half) * 16 * 64 + lane) * 8;
        bf16x8 wf[2][2][4];
#pragma unroll
        for (int qt = 0; qt < 2; ++qt)
#pragma unroll
            for (int pbl = 0; pbl < 2; ++pbl)
#pragma unroll
                for (int ks = 0; ks < 4; ++ks) wf[qt][pbl][ks] = *(const GAS bf16x8*)(wp + (qt * 8 + pbl * 4 + ks) * 512);
        v4u uu[2][2][2]; float bs[2];
#pragma unroll
        for (int pbl = 0; pbl < 2; ++pbl) { bs[pbl] = F.b_spatial[h * 128 + p0 + 32 * pbl];
#pragma unroll
            for (int d0 = 0; d0 < 2; ++d0)
#pragma unroll
                for (int kp = 0; kp < 2; ++kp) uu[pbl][d0][kp] = *(const GAS v4u*)(F.Y + (row0 + p0 + 32 * pbl) * INW + 768 + 64 * h + 32 * d0 + 16 * kp + 8 * hi); }
        asm volatile("s_waitcnt vmcnt(0)" ::: "memory");
        f32x16 o[2][2]; o[0][0] = f32x16{}; o[0][1] = f32x16{}; o[1][0] = f32x16{}; o[1][1] = f32x16{};
#pragma unroll
        for (int qt = 0; qt < 2; ++qt)
#pragma unroll
            for (int d0 = 0; d0 < 2; ++d0) { s16x4 lo[4], hv[4];
#pragma unroll
                for (int ks = 0; ks < 4; ++ks) {
                    asm volatile("ds_read_b64_tr_b16 %0,%1 offset:%c2" : "=&v"(lo[ks]) : "v"(vb0), "i"(qt * 8192 + d0 * 4096 + ks * 1024) : "memory");
                    asm volatile("ds_read_b64_tr_b16 %0,%1 offset:%c2" : "=&v"(hv[ks]) : "v"(vb0), "i"(qt * 8192 + d0 * 4096 + ks * 1024 + 512) : "memory"); }
                asm volatile("s_waitcnt lgkmcnt(0)" ::: "memory"); MIX_SBAR();
#pragma unroll
                for (int ks = 0; ks < 4; ++ks) { const bf16x8 vf = (bf16x8){lo[ks][0], lo[ks][1], lo[ks][2], lo[ks][3], hv[ks][0], hv[ks][1], hv[ks][2], hv[ks][3]};
                    o[0][d0] = __builtin_amdgcn_mfma_f32_32x32x16_bf16(vf, wf[qt][0][ks], o[0][d0], 0, 0, 0);
                    o[1][d0] = __builtin_amdgcn_mfma_f32_32x32x16_bf16(vf, wf[qt][1][ks], o[1][d0], 0, 0, 0); } }
#pragma unroll
        for (int pbl = 0; pbl < 2; ++pbl) { float sq = 0.f; const size_t prow = row0 + p0 + 32 * pbl;
#pragma unroll
            for (int d0 = 0; d0 < 2; ++d0)
#pragma unroll
                for (int kp = 0; kp < 2; ++kp) {
                    float av[4], bv[4];
#pragma unroll
                    for (int e = 0; e < 4; ++e) { const float a0 = o[pbl][d0][8 * kp + e] + bs[pbl], b0 = o[pbl][d0][8 * kp + 4 + e] + bs[pbl];
                        auto r = __builtin_amdgcn_permlane32_swap(__builtin_bit_cast(unsigned, a0), __builtin_bit_cast(unsigned, b0), false, false);
                        const unsigned ra = r[0], rb = r[1]; av[e] = __builtin_bit_cast(float, ra); bv[e] = __builtin_bit_cast(float, rb); }
                    const v4u u = uu[pbl][d0][kp];
                    const float v0 = bf2f(u[0] & 0xffffu) * av[0], v1 = bf2f(u[0] >> 16) * av[1], v2 = bf2f(u[1] & 0xffffu) * av[2], v3 = bf2f(u[1] >> 16) * av[3];
                    const float v4 = bf2f(u[2] & 0xffffu) * bv[0], v5 = bf2f(u[2] >> 16) * bv[1], v6 = bf2f(u[3] & 0xffffu) * bv[2], v7 = bf2f(u[3] >> 16) * bv[3];
                    sq += ((v0 * v0 + v1 * v1) + (v2 * v2 + v3 * v3)) + ((v4 * v4 + v5 * v5) + (v6 * v6 + v7 * v7));
                    v4u w; w.x = cvtpk_s(v0, v1); w.y = cvtpk_s(v2, v3); w.z = cvtpk_s(v4, v5); w.w = cvtpk_s(v6, v7);
                    *(GAS v4u*)(F.A2 + pg8::tiled_off((int)prow, 512 + 64 * h + 32 * d0 + 16 * kp + 8 * hi, 16)) = w; }
            sq += __shfl_xor(sq, 32);
            if (hi == 0) F.ssq2[prow * 16 + 8 + h] = sq; }
    }
}

__device__ __forceinline__ void pv2(f32x16* oA, f32x16* oB, int vb, const bf16x8* paA, const bf16x8* paB) {
#pragma unroll
    for (int d0 = 0; d0 < 2; ++d0) { s16x4 lo[4], hi[4];
#pragma unroll
        for (int ks = 0; ks < 4; ++ks) {
            asm volatile("ds_read_b64_tr_b16 %0,%1 offset:%c2" : "=&v"(lo[ks]) : "v"(vb), "i"(d0 * 4096 + ks * 1024) : "memory");
            asm volatile("ds_read_b64_tr_b16 %0,%1 offset:%c2" : "=&v"(hi[ks]) : "v"(vb), "i"(d0 * 4096 + ks * 1024 + 512) : "memory"); }
        asm volatile("s_waitcnt lgkmcnt(0)" ::: "memory"); MIX_SBAR();
#define MIX_PK(k) (bf16x8){lo[k][0], lo[k][1], lo[k][2], lo[k][3], hi[k][0], hi[k][1], hi[k][2], hi[k][3]}
#pragma unroll
        for (int ks = 0; ks < 4; ++ks) { const bf16x8 vf = MIX_PK(ks);
            oA[d0] = __builtin_amdgcn_mfma_f32_32x32x16_bf16(vf, paA[ks], oA[d0], 0, 0, 0);
            oB[d0] = __builtin_amdgcn_mfma_f32_32x32x16_bf16(vf, paB[ks], oB[d0], 0, 0, 0); }
#undef MIX_PK
    }
}
__device__ __forceinline__ void attn_mask(f32x16& p0, f32x16& p1, int j, int s, int r32, int hi) {
    if (64 * j >= 32 * s + 31 && 64 * j + 63 <= 32 * s + 256) return;
    const int q_rel = 32 * s + r32, kb = 64 * j + 4 * hi;
#pragma unroll
    for (int r = 0; r < 16; ++r) { const int ko = kb + (r & 3) + 8 * (r >> 2);
        if (ko < q_rel || ko > q_rel + 256) p0[r] = -INFINITY;
        if (ko + 32 < q_rel || ko + 32 > q_rel + 256) p1[r] = -INFINITY; }
}
__device__ __forceinline__ void attn_epi(Frame& F, const f32x16* o, float l_reg, float sink2, int s, size_t row0, int h) {
    int lane = F.lane; asm volatile("" : "+v"(lane)); const int r32 = lane & 31, hi = lane >> 5;
    l_reg += __shfl_xor(l_reg, 32); l_reg += sink2;
    const float inv = 1.0f / l_reg; float sq = 0.f; const size_t prow = row0 + 32 * s + r32;
#pragma unroll
    for (int d0 = 0; d0 < 2; ++d0)
#pragma unroll
        for (int kp = 0; kp < 2; ++kp) { unsigned wa[2], wb[2];
#pragma unroll
            for (int q = 0; q < 2; ++q) { const int k = 2 * kp + q; unsigned w0 = cvtpk_s(o[d0][4 * k] * inv, o[d0][4 * k + 1] * inv), w1 = cvtpk_s(o[d0][4 * k + 2] * inv, o[d0][4 * k + 3] * inv);
                const float a0 = bf2f(w0 & 0xffffu), a1 = bf2f(w0 >> 16), a2 = bf2f(w1 & 0xffffu), a3 = bf2f(w1 >> 16);
                sq += (a0 * a0 + a1 * a1) + (a2 * a2 + a3 * a3);
                if (q == 0) { wa[0] = w0; wa[1] = w1; } else { wb[0] = w0; wb[1] = w1; } }
            store_pair16(F.A2 + pg8::tiled_off((int)prow, 64 * h + 32 * d0 + 16 * kp + 8 * hi, 16), wa, wb); }
    sq += __shfl_xor(sq, 32);
    if (hi == 0) F.ssq2[prow * 16 + h] = sq;
}
__device__ __forceinline__ void attn_tile(lcp kb, lcp vp, const int (&koffs)[4], const bf16x8 (&qA)[4], const bf16x8 (&qB)[4], f32x16 (&oA)[2], f32x16 (&oB)[2],
                                          float& lA, float& lB, int jm, int sA, int r32, int hi) {
    f32x16 pA0 = {}, pA1 = {}, pB0 = {}, pB1 = {};
    if (jm >= 0) { const int dA = 64 * jm + 4 * hi - (32 * sA + r32), dB = dA - 32;
#pragma unroll
        for (int r = 0; r < 16; ++r) { const int c = (r & 3) + 8 * (r >> 2);
            pA0[r] = ((unsigned)(dA + c) > 256u) ? -INFINITY : 0.f; pA1[r] = ((unsigned)(dA + c + 32) > 256u) ? -INFINITY : 0.f;
            pB0[r] = ((unsigned)(dB + c) > 256u) ? -INFINITY : 0.f; pB1[r] = ((unsigned)(dB + c + 32) > 256u) ? -INFINITY : 0.f; } }
    MIX_SBAR();
    bf16x8 kf[8];
#pragma unroll
    for (int d0 = 0; d0 < 4; ++d0) { kf[2 * d0] = *(LAS const bf16x8*)(kb + koffs[d0]); kf[2 * d0 + 1] = *(LAS const bf16x8*)(kb + koffs[d0] + 4096); }
#pragma unroll
    for (int d0 = 0; d0 < 4; ++d0) { pA0 = __builtin_amdgcn_mfma_f32_32x32x16_bf16(kf[2 * d0], qA[d0], pA0, 0, 0, 0); pA1 = __builtin_amdgcn_mfma_f32_32x32x16_bf16(kf[2 * d0 + 1], qA[d0], pA1, 0, 0, 0); }
    MIX_SBAR();
#pragma unroll
    for (int d0 = 0; d0 < 4; ++d0) { pB0 = __builtin_amdgcn_mfma_f32_32x32x16_bf16(kf[2 * d0], qB[d0], pB0, 0, 0, 0); pB1 = __builtin_amdgcn_mfma_f32_32x32x16_bf16(kf[2 * d0 + 1], qB[d0], pB1, 0, 0, 0); }
    float sa = 0.f;
#pragma unroll
    for (int r = 0; r < 16; ++r) { pA0[r] = __builtin_amdgcn_exp2f(pA0[r]); pA1[r] = __builtin_amdgcn_exp2f(pA1[r]); sa += pA0[r] + pA1[r]; }
    lA += sa;
    bf16x8 paA[4], paB[4], vf0[4], vf1[4];
    paA[0] = pack8(pA0, 0); paA[1] = pack8(pA0, 8); paA[2] = pack8(pA1, 0); paA[3] = pack8(pA1, 8);
#pragma unroll
    for (int i = 0; i < 8; ++i) { __builtin_amdgcn_sched_group_barrier(0x008, 1, 0); __builtin_amdgcn_sched_group_barrier(0x402, 10, 0); }
    MIX_SBAR();
    {
#pragma unroll
        for (int ks = 0; ks < 4; ++ks) { const s16x4 lo = vtr(vp + ks * 1024), hv = vtr(vp + ks * 1024 + 512); vf0[ks] = (bf16x8){lo[0], lo[1], lo[2], lo[3], hv[0], hv[1], hv[2], hv[3]}; }
#pragma unroll
        for (int ks = 0; ks < 4; ++ks) { const s16x4 lo = vtr(vp + 4096 + ks * 1024), hv = vtr(vp + 4096 + ks * 1024 + 512); vf1[ks] = (bf16x8){lo[0], lo[1], lo[2], lo[3], hv[0], hv[1], hv[2], hv[3]}; }
#pragma unroll
        for (int ks = 0; ks < 4; ++ks) oA[0] = __builtin_amdgcn_mfma_f32_32x32x16_bf16(vf0[ks], paA[ks], oA[0], 0, 0, 0);
#pragma unroll
        for (int ks = 0; ks < 4; ++ks) oA[1] = __builtin_amdgcn_mfma_f32_32x32x16_bf16(vf1[ks], paA[ks], oA[1], 0, 0, 0);
    }
    float sb = 0.f;
#pragma unroll
    for (int r = 0; r < 16; ++r) { pB0[r] = __builtin_amdgcn_exp2f(pB0[r]); pB1[r] = __builtin_amdgcn_exp2f(pB1[r]); sb += pB0[r] + pB1[r]; }
    lB += sb;
    paB[0] = pack8(pB0, 0); paB[1] = pack8(pB0, 8); paB[2] = pack8(pB1, 0); paB[3] = pack8(pB1, 8);
    __builtin_amdgcn_sched_group_barrier(0x100, 16, 0);
#pragma unroll
    for (int i = 0; i < 8; ++i) { __builtin_amdgcn_sched_group_barrier(0x008, 1, 0); __builtin_amdgcn_sched_group_barrier(0x402, 10, 0); }
    MIX_SBAR();
    {
        bf16x8 wf0[4], wf1[4];
#pragma unroll
        for (int ks = 0; ks < 4; ++ks) { const s16x4 lo = vtr(vp + ks * 1024), hv = vtr(vp + ks * 1024 + 512); wf0[ks] = (bf16x8){lo[0], lo[1], lo[2], lo[3], hv[0], hv[1], hv[2], hv[3]}; }
#pragma unroll
        for (int ks = 0; ks < 4; ++ks) { const s16x4 lo = vtr(vp + 4096 + ks * 1024), hv = vtr(vp + 4096 + ks * 1024 + 512); wf1[ks] = (bf16x8){lo[0], lo[1], lo[2], lo[3], hv[0], hv[1], hv[2], hv[3]}; }
#pragma unroll
        for (int ks = 0; ks < 4; ++ks) oB[0] = __builtin_amdgcn_mfma_f32_32x32x16_bf16(wf0[ks], paB[ks], oB[0], 0, 0, 0);
#pragma unroll
        for (int ks = 0; ks < 4; ++ks) oB[1] = __builtin_amdgcn_mfma_f32_32x32x16_bf16(wf1[ks], paB[ks], oB[1], 0, 0, 0);
    }
    MIX_SBAR();
}
__device__ __forceinline__ void attn_unit(Frame& F, int b, int blk) {
    const int lane = F.lane, r32 = lane & 31, hi = lane >> 5, h = F.wave, g = h >> 2, wid = F.wave;
    const size_t row0 = (size_t)b * SEQ + blk * 128;
    const unsigned lds0 = (unsigned)(uintptr_t)F.lds;
    const float sink2 = exp2f(F.attn_sink[h] * LOG2E);
    int koffs[4];
#pragma unroll
    for (int d0 = 0; d0 < 4; ++d0) koffs[d0] = (r32 >> 3) * 1024 + (r32 & 7) * 128 + (((2 * d0 + hi) ^ ((r32 >> 1) & 7)) * 16);
    const int vbl = ((lane >> 4) & 1) * 32 + (lane & 3) * 8 + (4 * hi + ((lane & 15) >> 2)) * 64;
    const int jf_blk = (blk == 0) ? 2 : 0, jl_blk = (blk == 31) ? 3 : 5;
    const int jf0 = jf_blk, jl0 = 4 < jl_blk ? 4 : jl_blk, nw0 = jl0 - jf0 + 1, n0 = nw0 + 4;
    const int jf1 = 1 > jf_blk ? 1 : jf_blk, jl1 = jl_blk, nw1 = jl1 - jf1 + 1, n1 = nw1 + 4;
    const int ntot = n0 + n1;
#define MIX_DMA(gi, slot) do { const int gi_ = (gi); const int ps_ = gi_ >= n0 ? 1 : 0, ti_ = gi_ - ps_ * n0, nw_ = ps_ ? nw1 : nw0, jf_ = ps_ ? jf1 : jf0; const bf16* base_; unsigned pitch_; \
        if (ti_ < nw_) { base_ = F.KV + ((size_t)b * SEQ + (size_t)(128 * (blk - 1) + 64 * (jf_ + ti_))) * 256; pitch_ = 256; } \
        else { base_ = F.Yc + ((size_t)b * CTXL + 64 * (ti_ - nw_)) * 256; pitch_ = 256; } \
        const unsigned sl_ = lds0 + (slot) * SLOT; \
        unsigned ln_ = (unsigned)lane; asm volatile("" : "+v"(ln_));     \
        const unsigned kk_ = 8u * (unsigned)wid + (ln_ >> 3); \
        const unsigned ko_ = kk_ * pitch_ + 8u * ((ln_ & 7u) ^ ((kk_ >> 1) & 7u)), vo_ = (16u * (unsigned)(wid & 3) + (ln_ >> 2)) * pitch_ + 128u + (unsigned)(wid >> 2) * 32u + (ln_ & 3u) * 8u; \
        glds16(base_ + ko_, (unsigned)__builtin_amdgcn_readfirstlane(sl_ + wid * 1024)); \
        glds16(base_ + ko_ + 64, (unsigned)__builtin_amdgcn_readfirstlane(sl_ + 8192 + wid * 1024)); \
        glds16(base_ + vo_, (unsigned)__builtin_amdgcn_readfirstlane(sl_ + 16384 + wid * 1024)); \
        glds16(base_ + vo_ + 64, (unsigned)__builtin_amdgcn_readfirstlane(sl_ + 24576 + wid * 1024)); } while (0)
    bf16x8 qA[4], qB[4];
#define MIX_LOADQ(ps) do { unsigned lq_ = (unsigned)lane; asm volatile("" : "+v"(lq_)); const bf16* qp_ = F.Y + (row0 + 64 * (ps)) * INW + 256 + 64 * h + ((lq_ & 31u) * (unsigned)INW + 8u * (lq_ >> 5)); \
        _Pragma("unroll") for (int d0 = 0; d0 < 4; ++d0) { qA[d0] = *(const GAS bf16x8*)(qp_ + 16 * d0); qB[d0] = *(const GAS bf16x8*)(qp_ + (size_t)32 * INW + 16 * d0); } } while (0)
    MIX_LOADQ(0);
    MIX_DMA(0, 0); MIX_DMA(1, 1);
    int gi = 0, slot = 0; bool gpend = false;
    for (int ps = 0; ps < 2; ++ps) {
        const int np = ps ? n1 : n0, nwp = ps ? nw1 : nw0, jfp = ps ? jf1 : jf0, sA = 2 * ps, sB = 2 * ps + 1;
        f32x16 oA[2], oB[2]; oA[0] = f32x16{}; oA[1] = f32x16{}; oB[0] = f32x16{}; oB[1] = f32x16{};
        float lA = 0.f, lB = 0.f;
        for (int ti = 0; ti < np; ++ti, ++gi) {
            if (gi + 1 < ntot) asm volatile("s_waitcnt vmcnt(4) lgkmcnt(0)\n\ts_barrier" ::: "memory");
            else if (gpend) asm volatile("s_waitcnt vmcnt(16) lgkmcnt(0)\n\ts_barrier" ::: "memory");
            else asm volatile("s_waitcnt vmcnt(0) lgkmcnt(0)\n\ts_barrier" ::: "memory");
            { const int s2 = slot + 2 >= 3 ? slot - 1 : slot + 2;
              if (gi == 1 && (h >> 1) == 3) gmlp_dma(F, b, blk);
              if (gi + 2 < ntot) MIX_DMA(gi + 2, s2);
              else if ((h >> 1) == s2) { gmlp_dma(F, b, blk); gpend = true; } }
            lcp kb = (lcp)(F.lds + slot * SLOT + g * 8192);
            lcp vp = (lcp)(F.lds + slot * SLOT + 16384 + g * 8192) + vbl;
            const int jt = ti < nwp ? jfp + ti : -1;
            attn_tile(kb, vp, koffs, qA, qB, oA, oB, lA, lB, (jt >= 0 && (jt == (ps ? 1 : 0) || jt == (ps ? 5 : 4))) ? jt : -1, sA, r32, hi);
            slot = slot == 2 ? 0 : slot + 1;
        }
        if (ps == 0) MIX_LOADQ(1);
        attn_epi(F, oA, lA, sink2, sA, row0, h);
        attn_epi(F, oB, lB, sink2, sB, row0, h);
    }
    asm volatile("s_waitcnt lgkmcnt(0)\n\ts_barrier" ::: "memory");
    { const int sl = slot == 0 ? 2 : slot - 1; if ((h >> 1) == sl) gmlp_dma(F, b, blk); }
#undef MIX_DMA
#undef MIX_LOADQ
}

__device__ __forceinline__ void p3_mixer(Frame& F) {
    for (int item = F.vcu; item < BATCH * 32; item += F.G) {
        const int b = item >> 5, blk = item & 31;
#ifdef MK_ATTN_TWICE
        for (int rep_ = 0; rep_ < 2; ++rep_) { asm volatile("s_waitcnt vmcnt(0) lgkmcnt(0)" ::: "memory"); __syncthreads();
#endif
        attn_unit(F, b, blk);
#ifdef MK_ATTN_TWICE
        }
#endif
        gmlp_unit<false>(F, b, blk);
        asm volatile("s_waitcnt vmcnt(0) lgkmcnt(0)" ::: "memory"); __syncthreads();
    }
}
#undef MIX_SBAR
#undef MIX_WAIT_BAR
}
struct Args { const float* in[20]; float* out; unsigned char* ws; int ph_lo, ph_hi, li, pad; };
__global__ void __launch_bounds__(NWAVES * 64, 2) fwd_mega(Args args) {
    extern __shared__ __attribute__((aligned(16))) unsigned char lds[];
    Frame F;
    F.lds = (LAS unsigned char*)lds;
    F.MISC = (volatile LAS unsigned*)(F.lds + MISC_OFF);
    F.tid = threadIdx.x; F.lane = F.tid & 63; F.wave = __builtin_amdgcn_readfirstlane(F.tid >> 6);
    F.G = gridDim.x; { const int bx = blockIdx.x; F.vcu = (F.G % 8 == 0) ? (bx % 8) * (F.G / 8) + bx / 8 : bx; }
    unsigned char* ws = args.ws;
    F.ctl = (gu32*)(ws + WS_CTL);
    F.x = args.in[0]; F.c = args.in[1]; F.ctx = args.in[2]; F.c_ctx = args.in[3]; F.w_mod = args.in[4]; F.b_mod = args.in[5]; F.norm_mix = args.in[6]; F.norm_ffn = args.in[7];
    F.w_in = args.in[8]; F.q_gain = args.in[9]; F.k_gain = args.in[10]; F.attn_sink = args.in[11]; F.gate_gain = args.in[12]; F.w_spatial = args.in[13]; F.b_spatial = args.in[14];
    F.attn_out_gain = args.in[15]; F.mlp_out_gain = args.in[16]; F.w_out = args.in[17]; F.w_gate_up = args.in[18]; F.w_down = args.in[19]; F.out = args.out;
    F.mod = (float*)(ws + WS_MOD); F.rope = (float*)(ws + WS_ROPE); F.bias_t = (float*)(ws + WS_BIAS); F.ssq3 = (float*)(ws + WS_SSQ3); F.ssq2 = (float*)(ws + WS_SSQ2); F.rstd3 = (float*)(ws + WS_RSTD3);
    F.Win_t = (bf16*)(ws + WS_WIN); F.Wout_t = (bf16*)(ws + WS_WOUT); F.Wgu_t = (bf16*)(ws + WS_WGU); F.Wdn_t = (bf16*)(ws + WS_WDN);
    F.XN = (bf16*)(ws + WS_XN); F.Y = (bf16*)(ws + WS_Y); F.Yc = (bf16*)(ws + WS_YC); F.H = (bf16*)(ws + WS_H); F.A2 = (bf16*)(ws + WS_A2); F.A3 = (bf16*)(ws + WS_A3); F.Wsp = (bf16*)(ws + WS_WSP); F.KV = (bf16*)(ws + WS_KV);
    for (int u = F.tid; u < (LDS_BYTES - LDSCTL_OFF) / 4; u += NWAVES * 64) ((LAS unsigned*)(F.lds + LDSCTL_OFF))[u] = 0u;
    __syncthreads();
    XcdBarrier bar = xcd_barrier_post((unsigned*)(F.ctl + CW_BAR) + args.li * XCD_BAR_WORDS, F.MISC + 8);
    if (F.tid == 0) { unsigned nloc, nx, uni; xcd_barrier_complete(bar.bar, bar.x, nloc, nx, uni); bar.st[0] = nloc; bar.st[1] = nx; bar.st[2] = uni; }
    __syncthreads();
    F.xcc = (int)bar.x; F.uni = (F.MISC[10] == 1u && F.G == 256) ? 1 : 0;
#ifdef MK_FORCE_NONUNI
    F.uni = 0;
#endif
    F.cid = (int)blockIdx.x;
    if (F.uni) { const int rank = (int)F.MISC[11]; F.cid = rank * 8 + F.xcc; F.vcu = F.xcc * 32 + rank; }
    const int lo = args.ph_lo, hi = args.ph_hi;
#define IN(k) (lo <= (k) && (k) < hi)
#define SEAM(k) do { if (IN(k) && IN((k) + 1)) xcd_barrier(bar, F.uni && (k) >= 1); } while (0)

#ifndef MK_DUP
#define MK_DUP 0
#endif
#define REP(k) for (int rep_ = 0; rep_ < (((MK_DUP >> (k)) & 1) ? 2 : 1); ++rep_)
    if (IN(0)) { REP(0) { p0_prologue(F); __syncthreads(); } SEAM(0); }
#ifdef MK_XBAR
    for (int xb = 0; xb < MK_XBAR; ++xb) xcd_barrier(bar);
#endif
    if (IN(1)) { REP(1) p1_norm_rows(F); if (!F.uni) SEAM(1); }
#if defined(MK_SLEEP_H) || defined(MK_SLEEP_L)
    { const int rank_ = F.vcu & 31; int us_ = 0;
#ifdef MK_SLEEP_H
      if (rank_ < P12_RANK_L) us_ = MK_SLEEP_H;
#endif
#ifdef MK_SLEEP_L
      if (rank_ >= P12_RANK_L) us_ = MK_SLEEP_L;
#endif
      const unsigned long long t0_ = rt(); while (rt() - t0_ < (unsigned long long)us_ * 100ull) __builtin_amdgcn_s_sleep(8); }
#endif
    if (IN(2)) {
        LAS float* ropeL = (LAS float*)(F.lds + LDSCTL_OFF + 1024); LAS float* gainL = ropeL + 64 * 36;
        if (!IN(1)) {
        for (int i = F.tid; i < 2048; i += NWAVES * 64) ropeL[(i >> 5) * 36 + (i & 31)] = F.rope[i];
        for (int i = F.tid; i < 640; i += NWAVES * 64) gainL[i] = i < 64 ? F.q_gain[i] * pg8::C2Q : i < 128 ? F.k_gain[i - 64] : F.gate_gain[i - 128];
        }
        __syncthreads();
        pg8::Gemm g{F.XN, F.Win_t, MROWS, INW, DM}; pg8::InProjOrder S; S.so.init(MROWS, INW, F.G, F.cid); S.cnt = F.uni ? (const unsigned*)F.ctl + CW_RT + F.xcc * 32 : nullptr; S.flagp = (LAS unsigned*)(F.lds + LDSCTL_OFF + 512); S.na = P12_NA; S.nb = P12_NWL;
        pg8::EpiInProj E{F.Y, F.Yc, F.KV, ropeL, gainL};
        REP(2) pg8::gemm_phase<pg8::EpiInProj, pg8::InProjOrder, true, true>(F.lds + RING_OFF, g, S, E);
        SEAM(2);
    }
    if (IN(3)) { REP(3) mix::p3_mixer(F); SEAM(3); }
    if (IN(4)) {
        pg8::Gemm g{F.A2, F.Wout_t, MROWS, DM, DM}; pg8::OutProjOrder S; S.init(MROWS, DM, F.G, F.cid);
        S.ssq2 = F.ssq2; S.mod = F.mod; S.norm_ffn = F.norm_ffn; S.tab = (LAS float*)(F.lds + LDSCTL_OFF + 1024);
        pg8::EpiOutProj E{F.x, F.A3, F.ssq3, S.tab};
        REP(4) pg8::gemm_phase<pg8::EpiOutProj, pg8::OutProjOrder, true, true>(F.lds + RING_OFF, g, S, E);
        SEAM(4);
    }
    if (IN(5)) {
        { const int wv = F.uni ? (F.vcu & 31) * NWAVES + F.wave : F.vcu * NWAVES + F.wave, nwv = F.uni ? 256 : F.G * NWAVES; const size_t rbase = F.uni ? (size_t)F.xcc * SEQ : 0, rend = F.uni ? rbase + SEQ : MROWS;
          for (size_t rowb = rbase + 16 * (size_t)wv + (F.lane >> 2); rowb < rend; rowb += 16 * (size_t)nwv) {
              const f32x4 p = *(const f32x4*)(F.ssq3 + rowb * 16 + 4 * (F.lane & 3)); float ss = (p[0] + p[1]) + (p[2] + p[3]);
              ss += __shfl_xor(ss, 1); ss += __shfl_xor(ss, 2);
              if ((F.lane & 3) == 0) F.rstd3[rowb] = 1.0f / sqrtf(ss * (1.0f / 1024.0f) + 1e-6f); } }
        if (F.tid == 0) { unsigned* fl = (unsigned*)F.ctl + CW_BIASF; const unsigned want = (unsigned)(F.G * NWAVES); XB_SPIN(xb_ld(fl) < want, bar.bar); }
        xcd_barrier(bar, F.uni);
        pg8::Gemm g{F.A3, F.Wgu_t, MROWS, 2 * FFH, DM}; pg8::GateUpOrder S; S.init(MROWS, 2 * FFH, F.G, F.cid);
        S.rstd3 = F.rstd3; S.bias_t = F.bias_t; S.tab = (LAS float*)(F.lds + LDSCTL_OFF + 1024);
        pg8::EpiGateUp E{F.H, S.tab};
        REP(5) pg8::gemm_phase<pg8::EpiGateUp, pg8::GateUpOrder, true, true>(F.lds + RING_OFF, g, S, E);
        SEAM(5);
    }
    if (IN(6)) {
#ifdef MK_SLEEP_P6
        if (F.vcu & 16) { const unsigned long long t0_ = rt(); while (rt() - t0_ < (unsigned long long)(MK_SLEEP_P6) * 100ull) __builtin_amdgcn_s_sleep(8); }
#endif
        pg8::Gemm g{F.H, F.Wdn_t, MROWS, DM, FFH}; pg8::DownOrder S; S.init(MROWS, DM, F.G, F.cid);
        S.mod = F.mod; S.norm_ffn = F.norm_ffn; S.tab = (LAS float*)(F.lds + LDSCTL_OFF + 1024);
        pg8::EpiDown E{F.A3, F.out, S.tab};
        pg8::gemm_phase<pg8::EpiDown, pg8::DownOrder, true, true>(F.lds + RING_OFF, g, S, E);
    }
#undef IN
#undef SEAM
}

extern "C" void kernel_launch(void* const* d_in, const int* in_sizes, int n_in, void* d_out, int out_size, void* d_ws, size_t ws_size, hipStream_t stream) {
    static int grid = 0;
    if (grid == 0) {
        if (n_in != 20 || in_sizes[0] != MROWS * DM || out_size != MROWS * DM || ws_size < WS_END) { fprintf(stderr, "kernel_launch: unexpected shapes: n_in %d in0 %d out %d ws %zu\n", n_in, n_in > 0 ? in_sizes[0] : -1, out_size, ws_size); grid = -1; return; }
        int dev = 0, cus = 0, per_cu = 0;
        if (hipGetDevice(&dev) != hipSuccess || hipDeviceGetAttribute(&cus, hipDeviceAttributeMultiprocessorCount, dev) != hipSuccess) { grid = -1; return; }
        if (hipFuncSetAttribute((const void*)fwd_mega, hipFuncAttributeMaxDynamicSharedMemorySize, LDS_BYTES) != hipSuccess) { fprintf(stderr, "kernel_launch: hipFuncSetAttribute failed\n"); grid = -1; return; }
        if (hipOccupancyMaxActiveBlocksPerMultiprocessor(&per_cu, (const void*)fwd_mega, NWAVES * 64, LDS_BYTES) != hipSuccess || per_cu < 1) fprintf(stderr, "kernel_launch: occupancy query says %d\n", per_cu);
        (void)hipGetLastError();
        grid = cus - (cus % 8);
        if (grid < 8) grid = cus;
    }
    if (grid < 0) return;
    if (hipMemsetAsync((char*)d_ws + WS_CTL, 0, CTL_ZERO_BYTES, stream) != hipSuccess) return;
    Args a{};
    for (int i = 0; i < 20; ++i) a.in[i] = (const float*)d_in[i];
    a.out = (float*)d_out; a.ws = (unsigned char*)d_ws;
#ifdef MK_PROBE_PHASE
    const int plan[3][2] = {{0, MK_PROBE_PHASE + 1}, {MK_PROBE_PHASE, MK_PROBE_PHASE + 1}, {MK_PROBE_PHASE + 1, N_PHASES}};
    for (int li = 0; li < 3; ++li) { if (plan[li][0] >= plan[li][1]) continue; a.ph_lo = plan[li][0]; a.ph_hi = plan[li][1]; a.li = li;
        hipLaunchKernelGGL(fwd_mega, dim3(grid), dim3(NWAVES * 64), LDS_BYTES, stream, a); }
#else
    int lo = 0, li = 0;
    for (int k = 0; k < N_PHASES; ++k) {
        const bool cut = (k == N_PHASES - 1) || ((MK_CUTS >> k) & 1);
        if (!cut) continue;
        a.ph_lo = lo; a.ph_hi = k + 1; a.li = li++;
        hipLaunchKernelGGL(fwd_mega, dim3(grid), dim3(NWAVES * 64), LDS_BYTES, stream, a);
        lo = k + 1;
    }
#endif
}
```
